# Optimizing an MI355X kernel written in HIP

```python
import jax, jax.numpy as jnp
from jax import lax
import numpy as np

D_MODEL = 4096
BATCH = 4
SEQ = 2048
DEPTH = 1
DEC_BATCH = 128
DEC_SEQ = 4
PAST_LEN = 16384
PAGE_SIZE = 128

N_MEM = 256
D_A = D_MODEL // 2
HEAD_A = 64
H_A = D_A // HEAD_A
LORA_W = 96
LORA_A = 96
LORA_G = 256
GN_EPS = 64e-5
D_B = D_MODEL // 4
CONV_W = 3
H_C = 4
D_C = D_MODEL // 4
HEAD_C = D_C // H_C
D_FF = 11008
EPS = 1e-6
P_A = 3 * D_A + LORA_W + LORA_A + LORA_G
P_B = 3 * D_B
P_C = D_C
P_G = 3 * D_MODEL
P_IN = P_A + P_B + P_C + P_G

kernel_name = "rwkv7_shortconv_memattn_macaron_step"


def rmsnorm(x, g):
    xf = x.astype(jnp.float32)
    y = xf * lax.rsqrt(jnp.mean(xf * xf, axis=-1, keepdims=True) + EPS)
    return (y * g.astype(jnp.float32)).astype(x.dtype)


def swiglu(x, w_in, w_out):
    gate, up = jnp.split(x @ w_in, 2, axis=-1)
    return (jax.nn.silu(gate) * up) @ w_out


def rwkv7_scan(s0, r, w, k, v, a_vec, b_vec):
    def step(s, inp):
        r_t, w_t, k_t, v_t, a_t, b_t = inp
        sa = jnp.einsum('bhij,bhj->bhi', s, a_t)
        s = s * w_t[:, :, None, :] + sa[..., None] * b_t[:, :, None, :] + v_t[..., None] * k_t[:, :, None, :]
        y = jnp.einsum('bhij,bhj->bhi', s, r_t)
        return s, y
    xs = tuple(jnp.moveaxis(t, 1, 0) for t in (r, w, k, v, a_vec, b_vec))
    s, ys = lax.scan(step, s0, xs)
    return jnp.moveaxis(ys, 0, 1), s


def rwkv7_branch(p_a, shift_prev, s_prev, lp):
    bsz, t_len, _ = p_a.shape
    pf = p_a.astype(jnp.float32)
    seq = jnp.concatenate([shift_prev[:, None].astype(jnp.float32), pf], axis=1)
    ps = pf + (seq[:, :-1] - pf) * lp['mu_shift'].astype(jnp.float32)
    new_shift = seq[:, -1]
    r, k, v, xw, xa, xg = jnp.split(ps, [D_A, 2 * D_A, 3 * D_A, 3 * D_A + LORA_W, 3 * D_A + LORA_W + LORA_A], axis=-1)
    w_log = -jax.nn.softplus(-(lp['w0'] + jnp.tanh(xw) @ lp['w_lora_up'])) - 0.5
    decay = jnp.exp(-jnp.exp(w_log))
    a = jax.nn.sigmoid(lp['a0'] + xa @ lp['a_lora_up'])
    g = jax.nn.sigmoid(xg) @ lp['g_lora_up']
    hs = lambda t: t.reshape(bsz, t_len, H_A, HEAD_A)
    kk = hs(k * lp['k_k'])
    kk = kk / jnp.maximum(jnp.sqrt(jnp.sum(kk * kk, axis=-1, keepdims=True)), 1e-12)
    k = k * (1.0 + (a - 1.0) * lp['k_a'])
    rh, kh, vh, ah = hs(r), hs(k), hs(v), hs(a)
    y, s_new = rwkv7_scan(s_prev.astype(jnp.float32), rh, hs(decay), kh, vh, -kk, kk * ah)
    mu = jnp.mean(y, axis=-1, keepdims=True)
    var = jnp.mean(jnp.square(y - mu), axis=-1, keepdims=True)
    y = ((y - mu) * lax.rsqrt(var + GN_EPS)).reshape(bsz, t_len, D_A) * lp['lnx_w'] + lp['lnx_b']
    y = y + (jnp.sum(rh * kh * lp['r_k'], axis=-1, keepdims=True) * vh).reshape(bsz, t_len, D_A)
    return y * g, s_new.astype(s_prev.dtype), new_shift.astype(shift_prev.dtype)


def shortconv_branch(p_b, buf, conv_w):
    gb, gc, u = jnp.split(p_b, 3, axis=-1)
    u = gc * u
    t_len = u.shape[1]
    seq = jnp.concatenate([buf.astype(u.dtype), u], axis=1)
    z = seq[:, 0:t_len] * conv_w[0]
    for j in range(1, CONV_W):
        z = z + seq[:, j:j + t_len] * conv_w[j]
    return gb * z, seq[:, -(CONV_W - 1):].astype(buf.dtype)


def memory_kv(mem, g_mem, w_mem_kv):
    bsz = mem.shape[0]
    mk, mv = jnp.split(rmsnorm(mem, g_mem) @ w_mem_kv, 2, axis=-1)
    return mk.reshape(bsz, N_MEM, H_C, HEAD_C), mv.reshape(bsz, N_MEM, H_C, HEAD_C)


def memory_attention(p_c, mem_k, mem_v):
    bsz, t_len, _ = p_c.shape
    q = p_c.reshape(bsz, t_len, H_C, HEAD_C)
    s = jnp.einsum('bthd,bmhd->bhtm', q, mem_k.astype(q.dtype)).astype(jnp.float32) * (HEAD_C ** -0.5)
    pr = jax.nn.softmax(s, axis=-1).astype(q.dtype)
    o = jnp.einsum('bhtm,bmhd->bthd', pr, mem_v.astype(q.dtype))
    return o.reshape(bsz, t_len, D_C)


def layer_forward(x, mem_k, mem_v, s_rwkv, s_shift, s_conv, lp):
    x = x + 0.5 * swiglu(rmsnorm(x, lp['g_ffn1']), lp['w_ffn1_in'], lp['w_ffn1_out'])
    h = rmsnorm(x, lp['g_mix'])
    p = h @ lp['w_in']
    p_a, p_b, p_c, p_g = jnp.split(p, [P_A, P_A + P_B, P_A + P_B + P_C], axis=-1)
    y_a, s_rwkv_new, s_shift_new = rwkv7_branch(p_a, s_shift, s_rwkv, lp)
    y_b, s_conv_new = shortconv_branch(p_b, s_conv, lp['conv_w'])
    y_c = memory_attention(p_c, mem_k, mem_v)
    g_a, g_b, g_c = jnp.split(jax.nn.sigmoid(p_g), 3, axis=-1)
    merged = (g_a * (y_a.astype(x.dtype) @ lp['w_br_a'])
              + g_b * (y_b @ lp['w_br_b'])
              + g_c * (y_c @ lp['w_br_c']))
    x = x + merged @ lp['w_out']
    x = x + 0.5 * swiglu(rmsnorm(x, lp['g_ffn2']), lp['w_ffn2_in'], lp['w_ffn2_out'])
    return x, s_rwkv_new, s_shift_new, s_conv_new


def setup_inputs(seed: int = 0) -> dict:
    key = jax.random.key(seed)
    ks = iter(jax.random.split(key, 64))
    L = DEPTH
    nrm = lambda shape, scale: jax.random.normal(next(ks), shape, jnp.float32) * scale
    uni = lambda shape, lo, hi: jax.random.uniform(next(ks), shape, jnp.float32, lo, hi)
    gain = lambda shape: 1.0 + nrm(shape, 0.02)
    return {
        'x_prompt': nrm((BATCH, SEQ, D_MODEL), 1.0),
        'x_sample': nrm((DEC_BATCH, DEC_SEQ, D_MODEL), 1.0),
        'mem_prompt': nrm((BATCH, N_MEM, D_MODEL), 1.0),
        'cache_mem_k': nrm((L, DEC_BATCH, N_MEM, H_C, HEAD_C), 1.0),
        'cache_mem_v': nrm((L, DEC_BATCH, N_MEM, H_C, HEAD_C), 1.0),
        'state_rwkv': nrm((L, DEC_BATCH, H_A, HEAD_A, HEAD_A), 1.0),
        'state_shift': nrm((L, DEC_BATCH, P_A), 1.0),
        'state_conv': nrm((L, DEC_BATCH, CONV_W - 1, D_B), 1.0),
        'g_ffn1': gain((L, D_MODEL)),
        'w_ffn1_in': nrm((L, D_MODEL, 2 * D_FF), D_MODEL ** -0.5),
        'w_ffn1_out': nrm((L, D_FF, D_MODEL), D_FF ** -0.5),
        'g_mix': gain((L, D_MODEL)),
        'w_in': nrm((L, D_MODEL, P_IN), D_MODEL ** -0.5),
        'mu_shift': uni((L, P_A), 0.0, 1.0),
        'w0': uni((L, D_A), -5.0, 1.0),
        'w_lora_up': nrm((L, LORA_W, D_A), 0.1),
        'a0': nrm((L, D_A), 0.1),
        'a_lora_up': nrm((L, LORA_A, D_A), 0.5 * LORA_A ** -0.5),
        'g_lora_up': nrm((L, LORA_G, D_A), LORA_G ** -0.5),
        'k_k': 0.85 + nrm((L, D_A), 0.02),
        'k_a': gain((L, D_A)),
        'r_k': nrm((L, H_A, HEAD_A), 0.1),
        'lnx_w': gain((L, D_A)),
        'lnx_b': nrm((L, D_A), 0.01),
        'conv_w': nrm((L, CONV_W, D_B), CONV_W ** -0.5),
        'g_mem': gain((L, D_MODEL)),
        'w_mem_kv': nrm((L, D_MODEL, 2 * D_C), D_MODEL ** -0.5),
        'w_br_a': nrm((L, D_A, D_MODEL), D_A ** -0.5),
        'w_br_b': nrm((L, D_B, D_MODEL), D_B ** -0.5),
        'w_br_c': nrm((L, D_C, D_MODEL), D_C ** -0.5),
        'w_out': nrm((L, D_MODEL, D_MODEL), D_MODEL ** -0.5),
        'g_ffn2': gain((L, D_MODEL)),
        'w_ffn2_in': nrm((L, D_MODEL, 2 * D_FF), D_MODEL ** -0.5),
        'w_ffn2_out': nrm((L, D_FF, D_MODEL), D_FF ** -0.5),
        'g_final': gain((D_MODEL,)),
    }


def reference(x_prompt, x_sample, mem_prompt, cache_mem_k, cache_mem_v, state_rwkv, state_shift, state_conv,
              g_ffn1, w_ffn1_in, w_ffn1_out, g_mix, w_in, mu_shift, w0, w_lora_up, a0, a_lora_up, g_lora_up,
              k_k, k_a, r_k, lnx_w, lnx_b, conv_w, g_mem, w_mem_kv, w_br_a, w_br_b, w_br_c, w_out,
              g_ffn2, w_ffn2_in, w_ffn2_out, g_final):
    xp, xs = x_prompt, x_sample
    bp = xp.shape[0]
    mk_list, mv_list = [], []
    rp_list, shp_list, cp_list = [], [], []
    rs_list, shs_list, cs_list = [], [], []
    for l in range(DEPTH):
        lp = {
            'g_ffn1': g_ffn1[l], 'w_ffn1_in': w_ffn1_in[l], 'w_ffn1_out': w_ffn1_out[l],
            'g_mix': g_mix[l], 'w_in': w_in[l], 'mu_shift': mu_shift[l],
            'w0': w0[l], 'w_lora_up': w_lora_up[l], 'a0': a0[l], 'a_lora_up': a_lora_up[l],
            'g_lora_up': g_lora_up[l], 'k_k': k_k[l], 'k_a': k_a[l], 'r_k': r_k[l],
            'lnx_w': lnx_w[l], 'lnx_b': lnx_b[l], 'conv_w': conv_w[l],
            'w_br_a': w_br_a[l], 'w_br_b': w_br_b[l], 'w_br_c': w_br_c[l], 'w_out': w_out[l],
            'g_ffn2': g_ffn2[l], 'w_ffn2_in': w_ffn2_in[l], 'w_ffn2_out': w_ffn2_out[l],
        }
        mk_p, mv_p = memory_kv(mem_prompt, g_mem[l], w_mem_kv[l])
        s0 = jnp.zeros((bp, H_A, HEAD_A, HEAD_A), xp.dtype)
        sh0 = jnp.zeros((bp, P_A), xp.dtype)
        cb0 = jnp.zeros((bp, CONV_W - 1, D_B), xp.dtype)
        xp, rp, shp, cp = layer_forward(xp, mk_p, mv_p, s0, sh0, cb0, lp)
        xs, rs, shs, cs = layer_forward(xs, cache_mem_k[l], cache_mem_v[l], state_rwkv[l], state_shift[l], state_conv[l], lp)
        mk_list.append(mk_p); mv_list.append(mv_p)
        rp_list.append(rp); shp_list.append(shp); cp_list.append(cp)
        rs_list.append(rs); shs_list.append(shs); cs_list.append(cs)
    y_prompt = rmsnorm(xp, g_final)
    y_sample = rmsnorm(xs, g_final)
    mem_k_prompt = jnp.stack(mk_list, 0)
    mem_v_prompt = jnp.stack(mv_list, 0)
    rwkv_prompt = jnp.stack(rp_list, 0)
    shift_prompt = jnp.stack(shp_list, 0)
    conv_prompt = jnp.stack(cp_list, 0)
    rwkv_sample = jnp.stack(rs_list, 0)
    shift_sample = jnp.stack(shs_list, 0)
    conv_sample = jnp.stack(cs_list, 0)
    return (y_prompt, y_sample, mem_k_prompt, mem_v_prompt, rwkv_prompt, shift_prompt, conv_prompt, rwkv_sample, shift_sample, conv_sample)
```

```cpp
#include <hip/hip_runtime.h>
#include <cstdio>
#include <cstdint>
namespace pg8 {
#define PG8_LAS __attribute__((address_space(3)))
typedef unsigned short bf16_t;
typedef short bf16x8 __attribute__((ext_vector_type(8)));
typedef float f32x4 __attribute__((ext_vector_type(4)));
typedef unsigned u32x4 __attribute__((ext_vector_type(4)));
constexpr int BM = 256, BK = 64, HALF = 128, HTB = HALF * BK * 2  , STAGE_BYTES = 8 * HTB, NXCD = 8, WGM = 8;

__host__ __device__ __forceinline__ int lds_byte(int r, int c) { const int st = (r >> 4) * 2 + (c >> 5), rr = r & 15, cc = c & 31, ob = rr * 64 + cc * 2; return st * 1024 + (ob ^ (((ob >> 9) & 1) << 5)); }
__host__ __device__ __forceinline__ void stage_rc(int b, int& R, int& C) { const int st = b / 1024, sb = b % 1024, swz = sb ^ (((sb >> 9) & 1) << 5); R = (st >> 1) * 16 + swz / 64; C = (st & 1) * 32 + (swz % 64) / 2; }
__host__ __device__ __forceinline__ int perm32(int rho) { const int n = rho >> 4, i = rho & 15; return 8 * (i >> 2) + 4 * n + (i & 3); }

struct Unit { int pm, pn; };
struct Gemm { const bf16_t* A; const bf16_t* Bt; int M, N, K, lda, ldb; };

struct StaticOrder {
    int nM, nN, nwg, G, c;
    __host__ __device__ void init(int M, int N, int G_, int c_) { nM = M / BM; nN = N / BM; nwg = nM * nN; G = G_; c = c_; }
    __host__ __device__ bool next(int i, Unit& u) const {
        const long L = (long)i * G + c; if (L >= nwg) return false;
        int wgid = (int)L; { const int q = nwg / NXCD, r = nwg % NXCD, xcd = wgid % NXCD, off = wgid / NXCD; wgid = (xcd < r ? xcd * (q + 1) : r * (q + 1) + (xcd - r) * q) + off; }
        const int nig = WGM * nN, gid = wgid / nig, fm = gid * WGM, gsz = (nM - fm) < WGM ? (nM - fm) : WGM;
        u.pm = fm + ((wgid % nig) % gsz); u.pn = (wgid % nig) / gsz; return true;
    }
    __device__ __forceinline__ void a_ready(const Unit&) const {}
    __device__ __forceinline__ void done(const Unit&) const {}
};


template <class Epi, class Sched, bool ALIGN_EPI = false, bool SP2 = false>
__device__ __forceinline__ void gemm_phase(PG8_LAS unsigned char* lds, const Gemm g, const Sched& S, const Epi& E) {
    const int tid = threadIdx.x, wid = __builtin_amdgcn_readfirstlane(tid >> 6), lane = tid & 63, wr = wid >> 2, wc = wid & 3, fr = lane & 15, fq = lane >> 4;
    const int K = g.K, nt = K / BK;
    unsigned voffA[2], voffB[2];
#pragma unroll
    for (int i = 0; i < 2; ++i) { int R, C; stage_rc(tid * 16 + i * 8192, R, C); const int Rb = Epi::PERM ? ((R & ~31) + perm32(R & 31)) : R;
        voffA[i] = (unsigned)(R * g.lda + C) * 2u; voffB[i] = (unsigned)(Rb * g.ldb + C) * 2u; }
    const size_t kstep = (size_t)(BK * 2);
    const size_t hstepA = (size_t)HALF * g.lda * 2, hstepB = (size_t)HALF * g.ldb * 2;
    const size_t tstepA = 2 * hstepA, tstepB = 2 * hstepB;
    const unsigned ldsw = (unsigned)wid * 1024u;
    const int aoff = lds_byte(wr * 64 + fr, fq * 8), boff = lds_byte(wc * 32 + fr, fq * 8);
#define PG8_SA(b, h) (((b) * 2 + (h)) * HTB)
#define PG8_SB(b, h) ((4 + (b) * 2 + (h)) * HTB)
#define PG8_STAGE(bufoff, gbase, voff) do { _Pragma("unroll") for (int _i = 0; _i < 2; ++_i) \
        __builtin_amdgcn_global_load_lds((const unsigned*)((const char*)(gbase) + (voff)[_i]), (PG8_LAS unsigned*)(lds + (bufoff) + ldsw + _i * 8192), 16, 0, 0); } while (0)
#define PG8_LDA(dst, b, h) do { _Pragma("unroll") for (int m = 0; m < 4; ++m) _Pragma("unroll") for (int k = 0; k < 2; ++k) dst[m][k] = *(const PG8_LAS bf16x8*)(lds + PG8_SA(b, h) + aoff + m * 2048 + k * 1024); } while (0)
#define PG8_LDB(dst, b, h) do { _Pragma("unroll") for (int n = 0; n < 2; ++n) _Pragma("unroll") for (int k = 0; k < 2; ++k) dst[n][k] = *(const PG8_LAS bf16x8*)(lds + PG8_SB(b, h) + boff + n * 2048 + k * 1024); } while (0)
#define PG8_MMA(ai, bj, At, Bt) do { __builtin_amdgcn_s_setprio(1); _Pragma("unroll") for (int m = 0; m < 4; ++m) _Pragma("unroll") for (int n = 0; n < 2; ++n) _Pragma("unroll") for (int k = 0; k < 2; ++k) \
        acc[ai][bj][m][n] = __builtin_amdgcn_mfma_f32_16x16x32_bf16(Bt[n][k], At[m][k], acc[ai][bj][m][n], 0, 0, 0); __builtin_amdgcn_s_setprio(0); } while (0)
#define PG8_WAIT_V(n) asm volatile("s_waitcnt vmcnt(" #n ")" ::: "memory")
#define PG8_WAIT_L(n) asm volatile("s_waitcnt lgkmcnt(" #n ")" ::: "memory")
#define PG8_BAR __builtin_amdgcn_s_barrier()
#define PG8_SCHED __builtin_amdgcn_sched_barrier(0)
    Unit cur, nxt; int ui = 0;
    if (!S.next(0, cur)) return;
    f32x4 acc[2][2][4][2];
#pragma unroll
    for (int a = 0; a < 2; ++a)
#pragma unroll
        for (int b = 0; b < 2; ++b)
#pragma unroll
            for (int m = 0; m < 4; ++m)
#pragma unroll
                for (int n = 0; n < 2; ++n) acc[a][b][m][n] = (f32x4){0.f, 0.f, 0.f, 0.f};
    bf16x8 At[4][2], B0[2][2], B1[2][2];
    const char* cA = (const char*)g.A + (size_t)cur.pm * tstepA; const char* cB = (const char*)g.Bt + (size_t)cur.pn * tstepB;
    S.a_ready(cur);
    if constexpr (SP2) {
        PG8_STAGE(PG8_SB(0, 0), cB, voffB); PG8_STAGE(PG8_SB(0, 1), cB + hstepB, voffB); PG8_STAGE(PG8_SA(0, 0), cA, voffA); PG8_STAGE(PG8_SA(0, 1), cA + hstepA, voffA);
        if (wr == 1) PG8_BAR;
        PG8_WAIT_V(2); PG8_BAR;
        PG8_STAGE(PG8_SB(1, 0), cB + kstep, voffB); PG8_STAGE(PG8_SA(1, 0), cA + kstep, voffA); PG8_STAGE(PG8_SB(1, 1), cB + hstepB + kstep, voffB);
        PG8_WAIT_V(6); PG8_BAR;
    } else {
        PG8_STAGE(PG8_SB(0, 0), cB, voffB); PG8_STAGE(PG8_SA(0, 0), cA, voffA); PG8_STAGE(PG8_SB(0, 1), cB + hstepB, voffB); PG8_STAGE(PG8_SA(0, 1), cA + hstepA, voffA);
        if (wr == 1) PG8_BAR;
        PG8_WAIT_V(4); PG8_BAR;
        PG8_STAGE(PG8_SB(1, 0), cB + kstep, voffB); PG8_STAGE(PG8_SA(1, 0), cA + kstep, voffA); PG8_STAGE(PG8_SB(1, 1), cB + hstepB + kstep, voffB);
        PG8_WAIT_V(6); PG8_BAR;
    }
    for (;;) {
        const bool has_next = S.next(ui + 1, nxt);
        const char* nA = has_next ? (const char*)g.A + (size_t)nxt.pm * tstepA : cA; const char* nB = has_next ? (const char*)g.Bt + (size_t)nxt.pn * tstepB : cB;
#pragma unroll 1
        for (int t = 0; t < nt; t += 2) {
            const bool last = (t == nt - 2);
            const char* a1 = cA + (size_t)(t + 1) * kstep;
            const char* a2 = last ? nA : cA + (size_t)(t + 2) * kstep; const char* b2 = last ? nB : cB + (size_t)(t + 2) * kstep;
            const char* a3 = a2 + kstep; const char* b3 = b2 + kstep;
            if (last && has_next) S.a_ready(nxt);
            if constexpr (SP2) {
            PG8_LDB(B0, 0, 0); PG8_LDB(B1, 0, 1); PG8_SCHED; PG8_LDA(At, 0, 0); PG8_STAGE(PG8_SA(1, 1), a1 + hstepA, voffA);
            PG8_WAIT_V(8); PG8_WAIT_L(0); PG8_BAR; PG8_MMA(0, 0, At, B0); PG8_MMA(0, 1, At, B1); PG8_BAR; PG8_SCHED;
            PG8_LDA(At, 0, 1); PG8_STAGE(PG8_SB(0, 0), b2, voffB); PG8_STAGE(PG8_SB(0, 1), b2 + hstepB, voffB); PG8_STAGE(PG8_SA(0, 0), a2, voffA);
            PG8_WAIT_V(8); PG8_WAIT_L(0); PG8_BAR; PG8_MMA(1, 0, At, B0); PG8_MMA(1, 1, At, B1); PG8_BAR; PG8_SCHED;
            PG8_LDB(B0, 1, 0); PG8_LDB(B1, 1, 1); PG8_SCHED; PG8_LDA(At, 1, 0); PG8_STAGE(PG8_SA(0, 1), a2 + hstepA, voffA);
            PG8_WAIT_V(8); PG8_WAIT_L(0); PG8_BAR; PG8_MMA(0, 0, At, B0); PG8_MMA(0, 1, At, B1); PG8_BAR; PG8_SCHED;
            PG8_LDA(At, 1, 1); PG8_STAGE(PG8_SB(1, 0), b3, voffB); PG8_STAGE(PG8_SB(1, 1), b3 + hstepB, voffB); PG8_STAGE(PG8_SA(1, 0), a3, voffA);
            PG8_WAIT_V(8); PG8_WAIT_L(0); PG8_BAR; PG8_MMA(1, 0, At, B0); PG8_MMA(1, 1, At, B1); PG8_BAR; PG8_SCHED;
            } else {
            PG8_LDB(B0, 0, 0); PG8_SCHED; PG8_LDA(At, 0, 0); PG8_STAGE(PG8_SA(1, 1), a1 + hstepA, voffA);
            PG8_WAIT_L(8); PG8_BAR; PG8_WAIT_L(0); PG8_MMA(0, 0, At, B0); PG8_BAR; PG8_SCHED;
            PG8_LDB(B1, 0, 1); PG8_STAGE(PG8_SB(0, 0), b2, voffB);
            PG8_BAR; PG8_WAIT_L(0); PG8_MMA(0, 1, At, B1); PG8_BAR;
            PG8_LDA(At, 0, 1); PG8_STAGE(PG8_SA(0, 0), a2, voffA);
            PG8_BAR; PG8_WAIT_L(0); PG8_MMA(1, 0, At, B0); PG8_BAR; PG8_SCHED;
            PG8_STAGE(PG8_SB(0, 1), b2 + hstepB, voffB);
            PG8_WAIT_V(6); PG8_BAR; PG8_MMA(1, 1, At, B1); PG8_BAR;
            PG8_LDB(B0, 1, 0); PG8_SCHED; PG8_LDA(At, 1, 0); PG8_STAGE(PG8_SA(0, 1), a2 + hstepA, voffA);
            PG8_WAIT_L(8); PG8_BAR; PG8_WAIT_L(0); PG8_MMA(0, 0, At, B0); PG8_BAR; PG8_SCHED;
            PG8_LDB(B1, 1, 1); PG8_STAGE(PG8_SB(1, 0), b3, voffB);
            PG8_BAR; PG8_WAIT_L(0); PG8_MMA(0, 1, At, B1); PG8_BAR;
            PG8_LDA(At, 1, 1); PG8_STAGE(PG8_SA(1, 0), a3, voffA);
            PG8_BAR; PG8_WAIT_L(0); PG8_MMA(1, 0, At, B0); PG8_BAR; PG8_SCHED;
            PG8_STAGE(PG8_SB(1, 1), b3 + hstepB, voffB);
            PG8_WAIT_V(6); PG8_BAR; PG8_MMA(1, 1, At, B1); PG8_BAR;
            }
        }
        if constexpr (ALIGN_EPI) { if (wr == 0) PG8_BAR; }
        if constexpr (!Epi::AFTER_DRAIN) { E(acc, cur, wr, wc, fr, fq); S.done(cur); }
        if (!has_next) break;
#pragma unroll
        for (int a = 0; a < 2; ++a)
#pragma unroll
            for (int b = 0; b < 2; ++b)
#pragma unroll
                for (int m = 0; m < 4; ++m)
#pragma unroll
                    for (int n = 0; n < 2; ++n) acc[a][b][m][n] = (f32x4){0.f, 0.f, 0.f, 0.f};
        cur = nxt; cA = nA; cB = nB; ++ui;
        if constexpr (ALIGN_EPI) { if (wr == 1) PG8_BAR; }
    }
    PG8_WAIT_V(0);
    if constexpr (!ALIGN_EPI) { if (wr == 0) PG8_BAR; }
    PG8_BAR;
    if constexpr (Epi::AFTER_DRAIN) { E.fused(acc, cur, wr, wc, fr, fq, lds, wid, lane); S.done(cur); }
#undef PG8_SA
#undef PG8_SB
#undef PG8_STAGE
#undef PG8_LDA
#undef PG8_LDB
#undef PG8_MMA
#undef PG8_WAIT_V
#undef PG8_WAIT_L
#undef PG8_BAR
#undef PG8_SCHED
}
}

#ifndef PG8_SP2
#define PG8_SP2 true
#endif
#ifndef PG8_ALIGN
#define PG8_ALIGN true
#endif

constexpr int DM = 4096, NTP = 8192, NTS = 512, MTOK = 8704, DFF = 11008, SEQ = 2048, NB = 4, NDB = 128, DSEQ = 4;
constexpr int PA = 6592, PA_PAD = 6656, PBW = 3072, PCW = 1024, PGW = 12288, NWIN = 23040, PIN = 22976;
constexpr int DA = 2048, HA = 32, NMEM = 256;
constexpr float EPS = 1e-6f, GN_EPS = 64e-5f;
constexpr float QSCALE = 0.0625f * 1.4426950408889634f;

constexpr size_t O_Y = 0, O_MK = 35651584, O_MV = 36700160, O_RWP = 37748736, O_SHP = 38273024, O_CVP = 38299392, O_RWS = 38307584, O_SHS = 55084800, O_CVS = 55928576, O_END = 56190720;

constexpr size_t al256(size_t x) { return (x + 255) & ~(size_t)255; }
constexpr size_t WS_CTL = 0, CTL_BYTES = 1u << 20;
constexpr size_t WS_W1A = WS_CTL + CTL_BYTES;
constexpr size_t WS_W1B = WS_W1A + (size_t)2 * DFF * DM * 2;
constexpr size_t WS_WIN = WS_W1B + (size_t)DM * DFF * 2;
constexpr size_t WS_WMEM = WS_WIN + (size_t)NWIN * DM * 2;
constexpr size_t WS_WBRA = WS_WMEM + (size_t)2048 * DM * 2;
constexpr size_t WS_WBRB = WS_WBRA + (size_t)DM * 2048 * 2;
constexpr size_t WS_WBRC = WS_WBRB + (size_t)DM * 1024 * 2;
constexpr size_t WS_WOUT = WS_WBRC + (size_t)DM * 1024 * 2;
constexpr size_t WS_W2A = WS_WOUT + (size_t)DM * DM * 2;
constexpr size_t WS_W2B = WS_W2A + (size_t)2 * DFF * DM * 2;
constexpr size_t WS_WLWA = WS_W2B + (size_t)DM * DFF * 2;
constexpr size_t WS_WLG = WS_WLWA + (size_t)4096 * 256 * 2;
constexpr size_t WS_XB = WS_WLG + (size_t)2048 * 256 * 2;
constexpr size_t WS_ACT = WS_XB + (size_t)MTOK * DM * 2;
constexpr size_t WS_PAF = WS_ACT + (size_t)MTOK * DFF * 2;
constexpr size_t WS_PB = WS_PAF + (size_t)MTOK * PA_PAD * 4;
constexpr size_t WS_Q = WS_PB + (size_t)MTOK * PBW * 2;
constexpr size_t WS_GATE = WS_Q + (size_t)MTOK * PCW * 2;
constexpr size_t WS_LIN = WS_GATE + (size_t)MTOK * PGW * 2;
constexpr size_t WS_G = WS_LIN + (size_t)MTOK * 512 * 2;
constexpr size_t WS_YA = WS_G + (size_t)MTOK * 2048 * 2;
constexpr size_t WS_YB = WS_YA + (size_t)MTOK * 2048 * 2;
constexpr size_t WS_YC = WS_YB + (size_t)MTOK * 1024 * 2;
constexpr size_t WS_MRG = WS_YC + (size_t)MTOK * 1024 * 2;
constexpr size_t WS_MEMB = WS_MRG + (size_t)MTOK * DM * 2;
constexpr size_t WS_KB = WS_MEMB + (size_t)1024 * DM * 2;
constexpr size_t WS_VT = WS_KB + (size_t)1024 * 1024 * 2;
constexpr size_t WS_SLOT = WS_VT + (size_t)1024 * 1024 * 2;
constexpr size_t WS_RSTD0 = WS_SLOT + (size_t)MTOK * 64 * 4;
constexpr size_t WS_RSTD1 = WS_RSTD0 + 65536;
constexpr size_t WS_RSTD2 = WS_RSTD1 + 65536;
constexpr size_t WS_RSTDM = WS_RSTD2 + 65536;
constexpr size_t WS_INVN = WS_RSTDM + 65536;
constexpr size_t WS_RK = WS_INVN + (size_t)MTOK * 32 * 4;
constexpr size_t WS_END = WS_RK + (size_t)MTOK * 32 * 4;
static_assert(WS_END <= (size_t)2029 * 1024 * 1024, "d_ws map exceeds the guaranteed workspace");
static_assert((size_t)MTOK * 2048 * 4 <= (size_t)MTOK * DM * 2 && (size_t)MTOK * DM * 4 <= (size_t)MTOK * DFF * 2 && (size_t)2 * MTOK * 2048 * 4 <= (size_t)MTOK * DFF * 2, "overlays");
constexpr size_t WS_YSCAN = WS_XB, WS_WDEC = WS_ACT, WS_AVAL = WS_ACT + (size_t)MTOK * 2048 * 4, WS_MACC = WS_ACT;

constexpr int RING_OFF = 0, RING_BYTES = 131072;
constexpr int LDSCTL_OFF = 135168, MISC_OFF = LDSCTL_OFF + 320;
constexpr int LDS_BYTES = 147456;
constexpr int NWAVES = 8;

#define GAS __attribute__((address_space(1)))
#define LAS __attribute__((address_space(3)))
typedef unsigned short bf16;
typedef unsigned v4u __attribute__((ext_vector_type(4)));
typedef unsigned v2u __attribute__((ext_vector_type(2)));
typedef float f32x4 __attribute__((ext_vector_type(4)));
typedef float f32x2 __attribute__((ext_vector_type(2)));
typedef short bf16x8 __attribute__((ext_vector_type(8)));
#define LDS_WAIT() asm volatile("s_waitcnt lgkmcnt(0)" ::: "memory")
#define VM_WAIT() asm volatile("s_waitcnt vmcnt(0)" ::: "memory")
__device__ __forceinline__ unsigned f2bf(float f) { unsigned u = __builtin_bit_cast(unsigned, f); return (u + 0x7fffu + ((u >> 16) & 1u)) >> 16; }
__device__ __forceinline__ unsigned pk2(float lo, float hi) { return f2bf(lo) | (f2bf(hi) << 16); }
__device__ __forceinline__ float bf_lo(unsigned w) { return __builtin_bit_cast(float, w << 16); }
__device__ __forceinline__ float bf_hi(unsigned w) { return __builtin_bit_cast(float, w & 0xffff0000u); }
__device__ __forceinline__ float fast_exp(float x) { return __builtin_amdgcn_exp2f(x * 1.4426950408889634f); }
__device__ __forceinline__ float fast_sigmoid(float x) { return __builtin_amdgcn_rcpf(1.0f + fast_exp(-x)); }
typedef __bf16 bf16x2_t __attribute__((ext_vector_type(2)));
__device__ __forceinline__ unsigned cvt_pk_bf16(float lo, float hi) { f32x2 v = {lo, hi}; bf16x2_t b = __builtin_convertvector(v, bf16x2_t); return __builtin_bit_cast(unsigned, b); }

namespace epi {
using pg8::Unit;
typedef pg8::f32x4 A4;
#define EPI_ACC const A4 (&acc)[2][2][4][2]

struct SwiGLU {
    static constexpr bool PERM = true, AFTER_DRAIN = false;
    bf16* O; const float* rstd;
    __device__ __forceinline__ void operator()(EPI_ACC, const Unit& u, int wr, int wc, int fr, int fq) const {
        const int row0 = u.pm * 256 + wr * 64 + fr, col0 = u.pn * 128 + wc * 32 + 8 * fq;
#pragma unroll
        for (int ai = 0; ai < 2; ++ai)
#pragma unroll
            for (int m = 0; m < 4; ++m) {
                const int row = row0 + ai * 128 + m * 16; const float rs = rstd[row];
                float o[8];
#pragma unroll
                for (int n = 0; n < 2; ++n)
#pragma unroll
                    for (int e = 0; e < 4; ++e) { const float g = acc[ai][0][m][n][e] * rs, up = acc[ai][1][m][n][e] * rs; o[n * 4 + e] = g * fast_sigmoid(g) * up; }
                v4u w; w.x = cvt_pk_bf16(o[0], o[1]); w.y = cvt_pk_bf16(o[2], o[3]); w.z = cvt_pk_bf16(o[4], o[5]); w.w = cvt_pk_bf16(o[6], o[7]);
                *(v4u*)(O + (size_t)row * DFF + col0) = w;
            }
    }
};

struct Resid {
    static constexpr bool PERM = true, AFTER_DRAIN = false;
    const float* base_p; const float* base_s;
    float* out; bf16* xb; float* slots; float scale;
    __device__ __forceinline__ void operator()(EPI_ACC, const Unit& u, int wr, int wc, int fr, int fq) const {
        const int row0 = u.pm * 256 + wr * 64 + fr, colb = u.pn * 256 + wc * 32 + 8 * fq;
#pragma unroll
        for (int ai = 0; ai < 2; ++ai)
#pragma unroll
            for (int m = 0; m < 4; ++m) {
                const int row = row0 + ai * 128 + m * 16;
                const float* bp = (row < NTP ? base_p : base_s) + (size_t)row * DM + colb;
                float* op = out + (size_t)row * DM + colb; bf16* xp = xb + (size_t)row * DM + colb;
                float ss = 0.f;
#pragma unroll
                for (int bj = 0; bj < 2; ++bj) {
                    const A4 b0 = *(const A4*)(bp + bj * 128), b1 = *(const A4*)(bp + bj * 128 + 4);
                    const A4 v0 = b0 + acc[ai][bj][m][0] * scale, v1 = b1 + acc[ai][bj][m][1] * scale;
                    *(A4*)(op + bj * 128) = v0; *(A4*)(op + bj * 128 + 4) = v1;
                    v4u w; w.x = cvt_pk_bf16(v0[0], v0[1]); w.y = cvt_pk_bf16(v0[2], v0[3]); w.z = cvt_pk_bf16(v1[0], v1[1]); w.w = cvt_pk_bf16(v1[2], v1[3]);
                    *(v4u*)(xp + bj * 128) = w;
                    ss += (v0[0] * v0[0] + v0[1] * v0[1]) + (v0[2] * v0[2] + v0[3] * v0[3]) + (v1[0] * v1[0] + v1[1] * v1[1]) + (v1[2] * v1[2] + v1[3] * v1[3]);
                }
                ss += __shfl_xor(ss, 16); ss += __shfl_xor(ss, 32);
                if (fq == 0) slots[(size_t)row * 64 + u.pn * 4 + wc] = ss;
            }
    }
};

struct Win {
    static constexpr bool PERM = true, AFTER_DRAIN = false;
    float* pa; bf16* pb; bf16* q; bf16* gate; const float* rstd;
    template <bool SG> __device__ __forceinline__ void st16(EPI_ACC, bf16* O, int ld, int colb, float sc, int row0) const {
#pragma unroll
        for (int ai = 0; ai < 2; ++ai)
#pragma unroll
            for (int m = 0; m < 4; ++m) { const int row = row0 + ai * 128 + m * 16; const float rs = rstd[row] * sc; bf16* op = O + (size_t)row * ld + colb;
#pragma unroll
                for (int bj = 0; bj < 2; ++bj) { A4 v0 = acc[ai][bj][m][0] * rs, v1 = acc[ai][bj][m][1] * rs;
                    if (SG) {
#pragma unroll
                        for (int e = 0; e < 4; ++e) { v0[e] = fast_sigmoid(v0[e]); v1[e] = fast_sigmoid(v1[e]); } }
                    v4u w; w.x = cvt_pk_bf16(v0[0], v0[1]); w.y = cvt_pk_bf16(v0[2], v0[3]); w.z = cvt_pk_bf16(v1[0], v1[1]); w.w = cvt_pk_bf16(v1[2], v1[3]);
                    *(v4u*)(op + bj * 128) = w; } }
    }
    __device__ __forceinline__ void operator()(EPI_ACC, const Unit& u, int wr, int wc, int fr, int fq) const {
        const int row0 = u.pm * 256 + wr * 64 + fr, cw = wc * 32 + 8 * fq;
        if (u.pn < 26) {
            const int colb = u.pn * 256 + cw;
#pragma unroll
            for (int ai = 0; ai < 2; ++ai)
#pragma unroll
                for (int m = 0; m < 4; ++m) { const int row = row0 + ai * 128 + m * 16; const float rs = rstd[row]; float* op = pa + (size_t)row * PA_PAD + colb;
#pragma unroll
                    for (int bj = 0; bj < 2; ++bj) { *(A4*)(op + bj * 128) = acc[ai][bj][m][0] * rs; *(A4*)(op + bj * 128 + 4) = acc[ai][bj][m][1] * rs; } }
        } else if (u.pn < 38) st16<false>(acc, pb, PBW, (u.pn - 26) * 256 + cw, 1.f, row0);
        else if (u.pn < 42) st16<false>(acc, q, PCW, (u.pn - 38) * 256 + cw, QSCALE, row0);
        else st16<true>(acc, gate, PGW, (u.pn - 42) * 256 + cw, 1.f, row0);
    }
};

struct MemKV {
    static constexpr bool PERM = true, AFTER_DRAIN = false;
    float* outk; float* outv; bf16* kb; bf16* vt; const float* rstd;
    __device__ __forceinline__ void operator()(EPI_ACC, const Unit& u, int wr, int wc, int fr, int fq) const {
        const int row0 = u.pm * 256 + wr * 64 + fr; const bool isv = u.pn >= 4; const int h = u.pn & 3; const int cw = wc * 32 + 8 * fq;
        float* of = isv ? outv : outk;
#pragma unroll
        for (int ai = 0; ai < 2; ++ai)
#pragma unroll
            for (int m = 0; m < 4; ++m) { const int row = row0 + ai * 128 + m * 16; const float rs = rstd[row];
                const int b = row >> 8, key = row & 255, kk = key & 31; const int pos = (key & ~31) + 8 * ((kk & 15) >> 2) + (kk & 3) + 4 * (kk >> 4);
#pragma unroll
                for (int bj = 0; bj < 2; ++bj) { const A4 v0 = acc[ai][bj][m][0] * rs, v1 = acc[ai][bj][m][1] * rs; const int d0 = bj * 128 + cw;
                    float* op = of + (size_t)row * 1024 + h * 256 + d0; *(A4*)op = v0; *(A4*)(op + 4) = v1;
                    if (!isv) { v4u w; w.x = cvt_pk_bf16(v0[0], v0[1]); w.y = cvt_pk_bf16(v0[2], v0[3]); w.z = cvt_pk_bf16(v1[0], v1[1]); w.w = cvt_pk_bf16(v1[2], v1[3]);
                        *(v4u*)(kb + (size_t)row * 1024 + h * 256 + d0) = w; }
                    else { bf16* vp = vt + ((size_t)(b * 4 + h) * 256 + d0) * 256 + pos;
#pragma unroll
                        for (int e = 0; e < 4; ++e) { vp[(size_t)e * 256] = (bf16)f2bf(v0[e]); vp[(size_t)(4 + e) * 256] = (bf16)f2bf(v1[e]); } }
                } }
    }
};

struct LoraWA {
    static constexpr bool PERM = true, AFTER_DRAIN = false;
    float* wdec; float* aval; const float* w0; const float* a0;
    template <bool ISA> __device__ __forceinline__ void run(EPI_ACC, float* O, const float* bias, int colb, int row0) const {
#pragma unroll
        for (int bj = 0; bj < 2; ++bj)
#pragma unroll
            for (int n = 0; n < 2; ++n) { const A4 bv = *(const A4*)(bias + colb + bj * 128 + 4 * n);
#pragma unroll
                for (int ai = 0; ai < 2; ++ai)
#pragma unroll
                    for (int m = 0; m < 4; ++m) { const int row = row0 + ai * 128 + m * 16; A4 v = acc[ai][bj][m][n] + bv;
#pragma unroll
                        for (int e = 0; e < 4; ++e) { const float x = v[e];
                            if (ISA) v[e] = fast_sigmoid(x);
                            else { const float sp = fmaxf(-x, 0.f) + __logf(1.0f + fast_exp(-fabsf(x)));
                                   v[e] = fast_exp(-fast_exp(-sp - 0.5f)); } }
                        *(A4*)(O + (size_t)row * 2048 + colb + bj * 128 + 4 * n) = v; }
                asm volatile("" ::: "memory"); }
    }
    __device__ __forceinline__ void operator()(EPI_ACC, const Unit& u, int wr, int wc, int fr, int fq) const {
        const int row0 = u.pm * 256 + wr * 64 + fr; const int colb = (u.pn & 7) * 256 + wc * 32 + 8 * fq;
        if (u.pn >= 8) run<true>(acc, aval, a0, colb, row0); else run<false>(acc, wdec, w0, colb, row0);
    }
};
struct LoraG {
    static constexpr bool PERM = true, AFTER_DRAIN = false;
    bf16* O;
    __device__ __forceinline__ void operator()(EPI_ACC, const Unit& u, int wr, int wc, int fr, int fq) const {
        const int row0 = u.pm * 256 + wr * 64 + fr, colb = u.pn * 256 + wc * 32 + 8 * fq;
#pragma unroll
        for (int ai = 0; ai < 2; ++ai)
#pragma unroll
            for (int m = 0; m < 4; ++m) { const int row = row0 + ai * 128 + m * 16; bf16* op = O + (size_t)row * 2048 + colb;
#pragma unroll
                for (int bj = 0; bj < 2; ++bj) { const A4 v0 = acc[ai][bj][m][0], v1 = acc[ai][bj][m][1];
                    v4u w; w.x = cvt_pk_bf16(v0[0], v0[1]); w.y = cvt_pk_bf16(v0[2], v0[3]); w.z = cvt_pk_bf16(v1[0], v1[1]); w.w = cvt_pk_bf16(v1[2], v1[3]);
                    *(v4u*)(op + bj * 128) = w; } }
    }
};
template <int MODE> struct Gate {
    static constexpr bool PERM = true, AFTER_DRAIN = false;
    const bf16* gate; int goff; float* macc; bf16* mrg;
    __device__ __forceinline__ void operator()(EPI_ACC, const Unit& u, int wr, int wc, int fr, int fq) const {
        const int row0 = u.pm * 256 + wr * 64 + fr, colb = u.pn * 256 + wc * 32 + 8 * fq;
#pragma unroll
        for (int ai = 0; ai < 2; ++ai)
#pragma unroll
            for (int m = 0; m < 4; ++m) { const int row = row0 + ai * 128 + m * 16;
                const bf16* gp = gate + (size_t)row * PGW + goff + colb; float* mp = macc + (size_t)row * DM + colb;
#pragma unroll
                for (int bj = 0; bj < 2; ++bj) { const v4u gw = *(const v4u*)(gp + bj * 128);
                    A4 v0 = acc[ai][bj][m][0], v1 = acc[ai][bj][m][1];
                    v0[0] *= bf_lo(gw.x); v0[1] *= bf_hi(gw.x); v0[2] *= bf_lo(gw.y); v0[3] *= bf_hi(gw.y);
                    v1[0] *= bf_lo(gw.z); v1[1] *= bf_hi(gw.z); v1[2] *= bf_lo(gw.w); v1[3] *= bf_hi(gw.w);
                    if (MODE != 0) { v0 += *(const A4*)(mp + bj * 128); v1 += *(const A4*)(mp + bj * 128 + 4); }
                    if (MODE != 2) { *(A4*)(mp + bj * 128) = v0; *(A4*)(mp + bj * 128 + 4) = v1; }
                    else { v4u w; w.x = cvt_pk_bf16(v0[0], v0[1]); w.y = cvt_pk_bf16(v0[2], v0[3]); w.z = cvt_pk_bf16(v1[0], v1[1]); w.w = cvt_pk_bf16(v1[2], v1[3]);
                        *(v4u*)(mrg + (size_t)row * DM + colb + bj * 128) = w; } } }
    }
};
#undef EPI_ACC
}

#define XB_TMO      128
#define XB_XCNT(j)  (256  + 64 * (j))
#define XB_XSUB(j)  (1280 + 64 * (j))
#define XB_XGEN(j)  (2304 + 64 * (j))
#define XB_TOP      3328
#define XB_TOPGEN   3392
#define XCD_BAR_WORDS 3456
#define XB_SPIN_CAP (1u << 18)

__device__ __forceinline__ unsigned xb_ld(unsigned* p)              { return __hip_atomic_load(p, __ATOMIC_RELAXED, __HIP_MEMORY_SCOPE_AGENT); }
__device__ __forceinline__ unsigned xb_add(unsigned* p, unsigned v) { return __hip_atomic_fetch_add(p, v, __ATOMIC_RELAXED, __HIP_MEMORY_SCOPE_AGENT); }
__device__ __forceinline__ unsigned xb_xcc_id() { return (unsigned)__builtin_amdgcn_s_getreg((3 << 11) | 20) & 0xFu; }
#define XB_SPIN(cond, bar) do { unsigned _sp = 0; while (cond) { __builtin_amdgcn_s_sleep(1); \
    if ((++_sp & 255u) == 0u) { if (xb_ld(&(bar)[XB_TMO])) break; if (_sp > XB_SPIN_CAP) { atomicAdd(&(bar)[XB_TMO], 1u); break; } } } } while (0)

struct XcdBarrier {
    unsigned* bar; unsigned x;
    volatile LAS unsigned* st;
};

__device__ __forceinline__ XcdBarrier xcd_barrier_post(unsigned* bar, volatile LAS unsigned* st) {
    XcdBarrier b; b.bar = bar; b.x = xb_xcc_id(); b.st = st;
    if (threadIdx.x == 0) (void)xb_add(&bar[XB_XCNT(b.x)], 1u);
    return b;
}
__device__ __forceinline__ void xcd_barrier_complete(unsigned* bar, unsigned x, unsigned& nloc, unsigned& nx) {
    const unsigned G = gridDim.x * gridDim.y * gridDim.z;
    unsigned sum, cnt, mine, sp = 0u;
    for (;;) {
        sum = 0u; cnt = 0u; mine = 0u;
#pragma unroll
        for (unsigned j = 0; j < 16; ++j) { const unsigned c = xb_ld(&bar[XB_XCNT(j)]); sum += c; cnt += (c > 0u) ? 1u : 0u; mine = (j == x) ? c : mine; }
        if (sum == G) break;
        __builtin_amdgcn_s_sleep(1);
        if ((++sp & 255u) == 0u) { if (xb_ld(&bar[XB_TMO])) break; if (sp > XB_SPIN_CAP) { atomicAdd(&bar[XB_TMO], 1u); break; } }
    }
    nloc = mine > 0u ? mine : 1u; nx = cnt > 0u ? cnt : 1u;
}

__device__ __forceinline__ void xcd_barrier(const XcdBarrier& b) {
    asm volatile("s_waitcnt vmcnt(0)" ::: "memory");
    __syncthreads();
    if (threadIdx.x == 0) {
        unsigned* bar = b.bar;
        __builtin_amdgcn_s_waitcnt(0);
        unsigned nloc = b.st[0], nx = b.st[1];
        if (nloc == 0u) { xcd_barrier_complete(bar, b.x, nloc, nx); b.st[0] = nloc; b.st[1] = nx; }
        const unsigned old = xb_add(&bar[XB_XSUB(b.x)], 1u);
        const unsigned gen = old / nloc;
        if (old + 1u == (gen + 1u) * nloc) {
            __builtin_amdgcn_fence(__ATOMIC_RELEASE, "agent");
            asm volatile("s_waitcnt vmcnt(0)" ::: "memory");
            const unsigned og = xb_add(&bar[XB_TOP], 1u);
            const unsigned tg = og / nx;
            if (og + 1u == (tg + 1u) * nx) xb_add(&bar[XB_TOPGEN], 1u);
            else XB_SPIN(xb_ld(&bar[XB_TOPGEN]) == tg, bar);
            __builtin_amdgcn_fence(__ATOMIC_ACQUIRE, "agent");
            xb_add(&bar[XB_XGEN(b.x)], 1u);
            asm volatile("s_waitcnt vmcnt(0)" ::: "memory");
        } else {
            XB_SPIN(xb_ld(&bar[XB_XGEN(b.x)]) == gen, bar);
            __builtin_amdgcn_fence(__ATOMIC_ACQUIRE, "agent");
            asm volatile("s_waitcnt vmcnt(0)" ::: "memory");
        }
    }
    __syncthreads();
}

struct Args {
    const float* in[35];
    float* out; unsigned char* ws;
    int ph_lo, ph_hi;
};
enum In { I_XP = 0, I_XS, I_MEM, I_CK, I_CV, I_SRW, I_SSH, I_SCV, I_GF1, I_WF1I, I_WF1O, I_GMIX, I_WIN, I_MU, I_W0, I_WLU, I_A0, I_ALU, I_GLU, I_KK, I_KA, I_RK, I_LNW, I_LNB, I_CW, I_GMEM, I_WMKV,
          I_WBA, I_WBB, I_WBC, I_WOUT, I_GF2, I_WF2I, I_WF2O, I_GFIN };

struct Ctx { LAS unsigned char* lds; int tid, lane, wave, G, vcu, gw, NGW; };

__device__ __forceinline__ float wave_sum(float v) {
#pragma unroll
    for (int o = 1; o < 64; o <<= 1) v += __shfl_xor(v, o);
    return v;
}
__device__ __forceinline__ float oct_sum(float v) { v += __shfl_xor(v, 1); v += __shfl_xor(v, 2); v += __shfl_xor(v, 4); return v; }

__device__ __forceinline__ void cvt_item(const float* W, int N, const float* gk, bf16* WT, int Kd, int k0, int n0, int drow0, LAS float* scr, int lane) {
    f32x4 v[16];
    const int r4 = lane >> 4, c4 = 4 * (lane & 15);
#pragma unroll
    for (int i = 0; i < 16; ++i) v[i] = *(const f32x4*)(W + (size_t)(k0 + 4 * i + r4) * N + n0 + c4);
    if (gk) {
#pragma unroll
        for (int i = 0; i < 16; ++i) { const float s = gk[k0 + 4 * i + r4]; v[i] = v[i] * s; } }
#pragma unroll
    for (int i = 0; i < 16; ++i) { LAS float* p = scr + (4 * i + r4) * 65 + c4; p[0] = v[i].x; p[1] = v[i].y; p[2] = v[i].z; p[3] = v[i].w; }
    LDS_WAIT(); asm volatile("" ::: "memory");
    const int c = lane & 7;
#pragma unroll
    for (int j = 0; j < 8; ++j) { const int n = (lane >> 3) + 8 * j; const LAS float* s = scr + (8 * c) * 65 + n;
        v4u o; o.x = pk2(s[0 * 65], s[1 * 65]); o.y = pk2(s[2 * 65], s[3 * 65]); o.z = pk2(s[4 * 65], s[5 * 65]); o.w = pk2(s[6 * 65], s[7 * 65]);
        *(v4u*)(WT + (size_t)(drow0 + n) * Kd + k0 + 8 * c) = o; }
    LDS_WAIT(); asm volatile("" ::: "memory");
}
template <int MAP> __device__ __forceinline__ void cvt_matrix(const Ctx& C, const float* W, int K, int N, const float* gk, bf16* WT, int& base) {
    const int nblk = N / 64, nitems = (K / 64) * nblk; LAS float* scr = (LAS float*)(C.lds + C.wave * 16640);
    int first = (C.gw - base % C.NGW + C.NGW) % C.NGW;
    for (int it = first; it < nitems; it += C.NGW) {
        const int kb = it / nblk, nb = it % nblk, n0 = 64 * nb; int d;
        if (MAP == 1) { const int j = n0 < DFF ? n0 : n0 - DFF; d = 256 * (j >> 7) + (j & 127) + (n0 < DFF ? 0 : 128); }
        else if (MAP == 2) d = n0 + (n0 >= PA ? 64 : 0);
        else d = n0;
        cvt_item(W, N, gk, WT, K, 64 * kb, n0, d, scr, C.lane);
    }
    base += nitems;
}
__device__ __forceinline__ void row_to_bf16(const float* xrow, bf16* orow, float* rstd_out, int lane) {
    const f32x4* xr = (const f32x4*)xrow + lane; f32x4 v[16]; float s = 0.f;
#pragma unroll
    for (int j = 0; j < 16; ++j) { v[j] = xr[64 * j]; s += (v[j].x * v[j].x + v[j].y * v[j].y) + (v[j].z * v[j].z + v[j].w * v[j].w); }
    s = wave_sum(s);
    v2u* o8 = (v2u*)orow + lane;
#pragma unroll
    for (int j = 0; j < 16; ++j) { v2u w; w.x = pk2(v[j].x, v[j].y); w.y = pk2(v[j].z, v[j].w); o8[64 * j] = w; }
    if (lane == 0) *rstd_out = 1.0f / sqrtf(s * (1.0f / DM) + EPS);
}
__device__ __forceinline__ void p0_prologue(const Ctx& C, const Args& a) {
    unsigned char* ws = a.ws; int base = 0;
    cvt_matrix<1>(C, a.in[I_WF1I], DM, 2 * DFF, a.in[I_GF1], (bf16*)(ws + WS_W1A), base);
    cvt_matrix<0>(C, a.in[I_WF1O], DFF, DM, nullptr, (bf16*)(ws + WS_W1B), base);
    cvt_matrix<2>(C, a.in[I_WIN], DM, PIN, a.in[I_GMIX], (bf16*)(ws + WS_WIN), base);
    cvt_matrix<0>(C, a.in[I_WMKV], DM, 2048, a.in[I_GMEM], (bf16*)(ws + WS_WMEM), base);
    cvt_matrix<0>(C, a.in[I_WBA], 2048, DM, nullptr, (bf16*)(ws + WS_WBRA), base);
    cvt_matrix<0>(C, a.in[I_WBB], 1024, DM, nullptr, (bf16*)(ws + WS_WBRB), base);
    cvt_matrix<0>(C, a.in[I_WBC], 1024, DM, nullptr, (bf16*)(ws + WS_WBRC), base);
    cvt_matrix<0>(C, a.in[I_WOUT], DM, DM, nullptr, (bf16*)(ws + WS_WOUT), base);
    cvt_matrix<1>(C, a.in[I_WF2I], DM, 2 * DFF, a.in[I_GF2], (bf16*)(ws + WS_W2A), base);
    cvt_matrix<0>(C, a.in[I_WF2O], DFF, DM, nullptr, (bf16*)(ws + WS_W2B), base);
    { v4u z = {0u, 0u, 0u, 0u}; v4u* p = (v4u*)((bf16*)(ws + WS_WIN) + (size_t)PA * DM);
      for (int i = C.gw * 64 + C.lane; i < 64 * DM / 8; i += C.NGW * 64) p[i] = z; }
    { bf16* wl = (bf16*)(ws + WS_WLWA); bf16* wg = (bf16*)(ws + WS_WLG); const float* wu = a.in[I_WLU]; const float* au = a.in[I_ALU]; const float* gu = a.in[I_GLU];
      for (int i = C.gw * 64 + C.lane; i < 6144 * 32; i += C.NGW * 64) { const int n = i >> 5, k0 = 8 * (i & 31); float f[8];
#pragma unroll
          for (int e = 0; e < 8; ++e) { const int k = k0 + e; float x = 0.f;
              if (n < 2048) { if (k < 96) x = wu[(size_t)k * 2048 + n]; }
              else if (n < 4096) { if (k >= 128 && k < 224) x = au[(size_t)(k - 128) * 2048 + (n - 2048)]; }
              else x = gu[(size_t)k * 2048 + (n - 4096)];
              f[e] = x; }
          v4u o; o.x = pk2(f[0], f[1]); o.y = pk2(f[2], f[3]); o.z = pk2(f[4], f[5]); o.w = pk2(f[6], f[7]);
          bf16* dst = n < 4096 ? wl + (size_t)n * 256 + k0 : wg + (size_t)(n - 4096) * 256 + k0;
          *(v4u*)dst = o; } }
    for (int m = C.gw; m < MTOK + 1024; m += C.NGW) {
        if (m < MTOK) { const float* xr = m < NTP ? a.in[I_XP] + (size_t)m * DM : a.in[I_XS] + (size_t)(m - NTP) * DM;
            row_to_bf16(xr, (bf16*)(ws + WS_XB) + (size_t)m * DM, (float*)(ws + WS_RSTD0) + m, C.lane); }
        else { const int r = m - MTOK; row_to_bf16(a.in[I_MEM] + (size_t)r * DM, (bf16*)(ws + WS_MEMB) + (size_t)r * DM, (float*)(ws + WS_RSTDM) + r, C.lane); }
    }
}
__device__ __forceinline__ void rstd_phase(const Ctx& C, const float* slots, float* rstd) {
    for (int m = C.gw; m < MTOK; m += C.NGW) { const float s = wave_sum(slots[(size_t)m * 64 + C.lane]); if (C.lane == 0) rstd[m] = 1.0f / sqrtf(s * (1.0f / DM) + EPS); }
}
__device__ __forceinline__ void final_norm(const Ctx& C, const Args& a) {
    const float* slots = (const float*)(a.ws + WS_SLOT); const f32x4* gf = (const f32x4*)a.in[I_GFIN] + C.lane;
    for (int m = C.gw; m < MTOK; m += C.NGW) {
        const float s = wave_sum(slots[(size_t)m * 64 + C.lane]); const float rs = 1.0f / sqrtf(s * (1.0f / DM) + EPS);
        f32x4* xr = (f32x4*)(a.out + O_Y + (size_t)m * DM) + C.lane;
#pragma unroll
        for (int j = 0; j < 16; ++j) { f32x4 v = xr[64 * j]; const f32x4 g = gf[64 * j]; v = v * rs * g; xr[64 * j] = v; }
    }
}

__device__ __forceinline__ const float* prev_row(const Args& a, int m, int& t, bool& last) {
    const float* pa = (const float*)(a.ws + WS_PAF);
    if (m < NTP) { t = m & (SEQ - 1); last = (t == SEQ - 1); return t ? pa + (size_t)(m - 1) * PA_PAD : nullptr; }
    const int r = m - NTP; t = r & (DSEQ - 1); last = (t == DSEQ - 1);
    return t ? pa + (size_t)(m - 1) * PA_PAD : a.in[I_SSH] + (size_t)(r >> 2) * PA;
}
__device__ __forceinline__ void ld8(const float* p, float (&f)[8]) { const f32x4 x = *(const f32x4*)p, y = *(const f32x4*)(p + 4); f[0] = x.x; f[1] = x.y; f[2] = x.z; f[3] = x.w; f[4] = y.x; f[5] = y.y; f[6] = y.z; f[7] = y.w; }
__device__ __forceinline__ void shift8(const float* cur, const float* prev, const float* mu, int col, float (&f)[8]) {
    float c[8], p[8], u[8]; ld8(cur + col, c); ld8(mu + col, u);
    if (prev) ld8(prev + col, p); else {
#pragma unroll
        for (int e = 0; e < 8; ++e) p[e] = 0.f; }
#pragma unroll
    for (int e = 0; e < 8; ++e) f[e] = c[e] + (p[e] - c[e]) * u[e];
}
__device__ __forceinline__ void r1_phase(const Ctx& C, const Args& a) {
    const float* pa = (const float*)(a.ws + WS_PAF); bf16* lin = (bf16*)(a.ws + WS_LIN); const float* mu = a.in[I_MU];
    const int o = 8 * C.lane; int src = -1, mode = 0;
    if (o < 96) { src = 6144 + o; mode = 0; } else if (o < 128) src = -1; else if (o < 224) { src = 6240 + (o - 128); mode = 1; } else if (o < 256) src = -1; else { src = 6336 + (o - 256); mode = 2; }
    for (int m = C.gw; m < MTOK; m += C.NGW) {
        int t; bool last; const float* prev = prev_row(a, m, t, last); const float* cur = pa + (size_t)m * PA_PAD;
        float f[8];
#pragma unroll
        for (int e = 0; e < 8; ++e) f[e] = 0.f;
        if (src >= 0) { shift8(cur, prev, mu, src, f);
#pragma unroll
            for (int e = 0; e < 8; ++e) f[e] = mode == 0 ? tanhf(f[e]) : (mode == 2 ? fast_sigmoid(f[e]) : f[e]); }
        v4u w; w.x = pk2(f[0], f[1]); w.y = pk2(f[2], f[3]); w.z = pk2(f[4], f[5]); w.w = pk2(f[6], f[7]);
        *(v4u*)(lin + (size_t)m * 512 + o) = w;
        if (last) { float* dst = m < NTP ? a.out + O_SHP + (size_t)(m >> 11) * PA : a.out + O_SHS + (size_t)((m - NTP) >> 2) * PA;
            for (int i = C.lane; i < PA; i += 64) dst[i] = cur[i]; }
    }
}
__device__ __forceinline__ void r4_phase(const Ctx& C, const Args& a) {
    const float* pa = (const float*)(a.ws + WS_PAF); const float* mu = a.in[I_MU]; const float* av = (const float*)(a.ws + WS_AVAL);
    float* invn = (float*)(a.ws + WS_INVN); float* rk = (float*)(a.ws + WS_RK);
    for (int m = C.gw; m < MTOK; m += C.NGW) {
        int t; bool last; const float* prev = prev_row(a, m, t, last); const float* cur = pa + (size_t)m * PA_PAD;
#pragma unroll 1
        for (int it = 0; it < 4; ++it) { const int h = 8 * it + (C.lane >> 3), c0 = h * 64 + 8 * (C.lane & 7);
            float r[8], k[8], aa[8], kk[8], ka[8], rr[8];
            shift8(cur, prev, mu, c0, r); shift8(cur, prev, mu, 2048 + c0, k); ld8(av + (size_t)m * 2048 + c0, aa); ld8(a.in[I_KK] + c0, kk); ld8(a.in[I_KA] + c0, ka); ld8(a.in[I_RK] + c0, rr);
            float ss = 0.f, sr = 0.f;
#pragma unroll
            for (int e = 0; e < 8; ++e) { const float x = k[e] * kk[e]; ss += x * x; const float kp = k[e] * (1.0f + (aa[e] - 1.0f) * ka[e]); sr += r[e] * kp * rr[e]; }
            ss = oct_sum(ss); sr = oct_sum(sr);
            if ((C.lane & 7) == 0) { invn[(size_t)m * 32 + h] = 1.0f / fmaxf(sqrtf(ss), 1e-12f); rk[(size_t)m * 32 + h] = sr; } }
    }
}
__device__ __forceinline__ void post_phase(const Ctx& C, const Args& a) {
    const float* pa = (const float*)(a.ws + WS_PAF); const float* mu = a.in[I_MU]; const float* ys = (const float*)(a.ws + WS_YSCAN); const float* rk = (const float*)(a.ws + WS_RK);
    const bf16* gg = (const bf16*)(a.ws + WS_G); bf16* ya = (bf16*)(a.ws + WS_YA);
    for (int m = C.gw; m < MTOK; m += C.NGW) {
        int t; bool last; const float* prev = prev_row(a, m, t, last); const float* cur = pa + (size_t)m * PA_PAD;
#pragma unroll 1
        for (int it = 0; it < 4; ++it) { const int h = 8 * it + (C.lane >> 3), c0 = h * 64 + 8 * (C.lane & 7);
            float y[8], v[8], lw[8], lb[8];
            ld8(ys + (size_t)m * 2048 + c0, y); shift8(cur, prev, mu, 4096 + c0, v); ld8(a.in[I_LNW] + c0, lw); ld8(a.in[I_LNB] + c0, lb);
            const v4u gw = *(const v4u*)(gg + (size_t)m * 2048 + c0); const float g[8] = {bf_lo(gw.x), bf_hi(gw.x), bf_lo(gw.y), bf_hi(gw.y), bf_lo(gw.z), bf_hi(gw.z), bf_lo(gw.w), bf_hi(gw.w)};
            float s = 0.f;
#pragma unroll
            for (int e = 0; e < 8; ++e) s += y[e];
            const float mean = oct_sum(s) * (1.0f / 64.0f); float q = 0.f;
#pragma unroll
            for (int e = 0; e < 8; ++e) { y[e] -= mean; q += y[e] * y[e]; }
            const float rs = 1.0f / sqrtf(oct_sum(q) * (1.0f / 64.0f) + GN_EPS); const float rkv = rk[(size_t)m * 32 + h];
            float o[8];
#pragma unroll
            for (int e = 0; e < 8; ++e) o[e] = (y[e] * rs * lw[e] + lb[e] + rkv * v[e]) * g[e];
            v4u w; w.x = pk2(o[0], o[1]); w.y = pk2(o[2], o[3]); w.z = pk2(o[4], o[5]); w.w = pk2(o[6], o[7]);
            *(v4u*)(ya + (size_t)m * 2048 + c0) = w; }
    }
}
__device__ __forceinline__ void ldu16(const bf16* row, int c0, float (&u)[16]) {
    const v4u g0 = *(const v4u*)(row + 1024 + c0), g1 = *(const v4u*)(row + 1024 + c0 + 8), u0 = *(const v4u*)(row + 2048 + c0), u1 = *(const v4u*)(row + 2048 + c0 + 8);
    const unsigned gw[8] = {g0.x, g0.y, g0.z, g0.w, g1.x, g1.y, g1.z, g1.w}, uw[8] = {u0.x, u0.y, u0.z, u0.w, u1.x, u1.y, u1.z, u1.w};
#pragma unroll
    for (int i = 0; i < 8; ++i) { u[2 * i] = bf_lo(gw[i]) * bf_lo(uw[i]); u[2 * i + 1] = bf_hi(gw[i]) * bf_hi(uw[i]); }
}
__device__ __forceinline__ void ldf16(const float* p, float (&u)[16]) {
#pragma unroll
    for (int i = 0; i < 4; ++i) { const f32x4 x = *(const f32x4*)(p + 4 * i); u[4 * i] = x.x; u[4 * i + 1] = x.y; u[4 * i + 2] = x.z; u[4 * i + 3] = x.w; }
}
__device__ __forceinline__ void conv_phase(const Args& a, int w, int nw, int lane) {
    const bf16* pb = (const bf16*)(a.ws + WS_PB); bf16* yb = (bf16*)(a.ws + WS_YB); const float* cw = a.in[I_CW]; const int c0 = 16 * lane;
    float w0[16], w1[16], w2[16]; ldf16(cw + c0, w0); ldf16(cw + 1024 + c0, w1); ldf16(cw + 2048 + c0, w2);
    for (int m = w; m < MTOK; m += nw) {
        const bool smp = m >= NTP; const int t = smp ? ((m - NTP) & 3) : (m & (SEQ - 1)); const int T = smp ? DSEQ : SEQ;
        const float* buf = smp ? a.in[I_SCV] + (size_t)((m - NTP) >> 2) * 2048 : nullptr;
        const bf16* row = pb + (size_t)m * PBW;
        float u0[16], u1[16], u2[16];
        ldu16(row, c0, u0);
        if (t >= 1) ldu16(row - PBW, c0, u1); else if (smp) ldf16(buf + 1024 + c0, u1); else {
#pragma unroll
            for (int i = 0; i < 16; ++i) u1[i] = 0.f; }
        if (t >= 2) ldu16(row - 2 * PBW, c0, u2); else if (smp) ldf16(buf + (size_t)t * 1024 + c0, u2); else {
#pragma unroll
            for (int i = 0; i < 16; ++i) u2[i] = 0.f; }
        const v4u b0 = *(const v4u*)(row + c0), b1 = *(const v4u*)(row + c0 + 8); const unsigned bw[8] = {b0.x, b0.y, b0.z, b0.w, b1.x, b1.y, b1.z, b1.w};
        unsigned ow[8];
#pragma unroll
        for (int i = 0; i < 8; ++i) { const float z0 = u2[2 * i] * w0[2 * i] + u1[2 * i] * w1[2 * i] + u0[2 * i] * w2[2 * i], z1 = u2[2 * i + 1] * w0[2 * i + 1] + u1[2 * i + 1] * w1[2 * i + 1] + u0[2 * i + 1] * w2[2 * i + 1];
            ow[i] = pk2(bf_lo(bw[i]) * z0, bf_hi(bw[i]) * z1); }
        v4u o0 = {ow[0], ow[1], ow[2], ow[3]}, o1 = {ow[4], ow[5], ow[6], ow[7]};
        *(v4u*)(yb + (size_t)m * 1024 + c0) = o0; *(v4u*)(yb + (size_t)m * 1024 + c0 + 8) = o1;
        if (t >= T - 2) { float* dst = (smp ? a.out + O_CVS + (size_t)((m - NTP) >> 2) * 2048 : a.out + O_CVP + (size_t)(m >> 11) * 2048) + (size_t)(t - (T - 2)) * 1024 + c0;
#pragma unroll
            for (int i = 0; i < 4; ++i) *(f32x4*)(dst + 4 * i) = (f32x4){u0[4 * i], u0[4 * i + 1], u0[4 * i + 2], u0[4 * i + 3]}; }
    }
}

template <int CTRL> __device__ __forceinline__ float dpp_mov(float v) { return __builtin_bit_cast(float, __builtin_amdgcn_update_dpp(0, __builtin_bit_cast(int, v), CTRL, 0xf, 0xf, false)); }
__device__ __forceinline__ float oct_sum_dpp(float v) { v += dpp_mov<0xB1>(v); v += dpp_mov<0x4E>(v); v += dpp_mov<0x141>(v); return v; }
constexpr int TC = 16, STG = 6 * TC * 64;
struct StageRegs { f32x2 cr, ck, cv, pr, pk, pv, la, lw; float inv; };
__device__ __forceinline__ void stage_load(StageRegs& R, const Args& a, const float* shift_prev, int tok0, int tl, int T, int h, int cj) {
    const f32x2 z = {0.f, 0.f};
    if (tl < T) {
        const int tok = tok0 + tl; const float* P = (const float*)(a.ws + WS_PAF) + (size_t)tok * PA_PAD + cj;
        R.cr = *(const f32x2*)P; R.ck = *(const f32x2*)(P + 2048); R.cv = *(const f32x2*)(P + 4096);
        if (tl > 0) { const float* Q = P - PA_PAD; R.pr = *(const f32x2*)Q; R.pk = *(const f32x2*)(Q + 2048); R.pv = *(const f32x2*)(Q + 4096); }
        else if (shift_prev) { const float* Q = shift_prev + cj; R.pr = *(const f32x2*)Q; R.pk = *(const f32x2*)(Q + 2048); R.pv = *(const f32x2*)(Q + 4096); }
        else { R.pr = z; R.pk = z; R.pv = z; }
        R.la = *(const f32x2*)((const float*)(a.ws + WS_AVAL) + (size_t)tok * 2048 + cj); R.lw = *(const f32x2*)((const float*)(a.ws + WS_WDEC) + (size_t)tok * 2048 + cj);
        R.inv = ((const float*)(a.ws + WS_INVN))[(size_t)tok * 32 + h];
    } else { R.cr = z; R.ck = z; R.cv = z; R.pr = z; R.pk = z; R.pv = z; R.la = z; R.lw = z; R.inv = 0.f; }
}
__device__ __forceinline__ void stage_store(const StageRegs& R, LAS float* B, int st, int sj, f32x2 mur, f32x2 muk, f32x2 muv, f32x2 kkp, f32x2 kap) {
    const f32x2 rs = R.cr + (R.pr - R.cr) * mur, ks = R.ck + (R.pk - R.ck) * muk, vs = R.cv + (R.pv - R.cv) * muv;
    const f32x2 kk = ks * kkp * R.inv, kp = ks * (1.0f + (R.la - 1.0f) * kap);
    LAS float* p = B + st * 64 + sj;
    *(LAS f32x2*)(p) = -kk; *(LAS f32x2*)(p + TC * 64) = R.lw; *(LAS f32x2*)(p + 2 * TC * 64) = kk * R.la; *(LAS f32x2*)(p + 3 * TC * 64) = kp; *(LAS f32x2*)(p + 4 * TC * 64) = rs; *(LAS f32x2*)(p + 5 * TC * 64) = vs;
}
__device__ __forceinline__ void scan_unit(const Ctx& C, const Args& a, int tok0, int T, const float* shift_prev, const float* s_in, float* s_out, int h) {
    LAS float* L = (LAS float*)C.lds; LAS float* Y = L + 2 * STG;
    const int st = C.tid >> 5, sj = (C.tid & 31) * 2, cj = h * 64 + sj;
    const float* mu = a.in[I_MU];
    const f32x2 mur = *(const f32x2*)(mu + cj), muk = *(const f32x2*)(mu + 2048 + cj), muv = *(const f32x2*)(mu + 4096 + cj), kkp = *(const f32x2*)(a.in[I_KK] + cj), kap = *(const f32x2*)(a.in[I_KA] + cj);
    const int row = 8 * C.wave + (C.lane >> 3), cp = C.lane & 7;
    float S[8];
    if (s_in) { const f32x4 x = *(const f32x4*)(s_in + row * 64 + 8 * cp), y = *(const f32x4*)(s_in + row * 64 + 8 * cp + 4); S[0] = x.x; S[1] = x.y; S[2] = x.z; S[3] = x.w; S[4] = y.x; S[5] = y.y; S[6] = y.z; S[7] = y.w; }
    else {
#pragma unroll
        for (int e = 0; e < 8; ++e) S[e] = 0.f; }
    const int NC = (T + TC - 1) / TC;
    float* ysc = (float*)(a.ws + WS_YSCAN);
    StageRegs R;
    stage_load(R, a, shift_prev, tok0, st, T, h, cj); stage_store(R, L, st, sj, mur, muk, muv, kkp, kap);
    if (NC > 1) stage_load(R, a, shift_prev, tok0, TC + st, T, h, cj);
    __syncthreads();
#pragma unroll 1
    for (int c = 0; c < NC; ++c) {
        const int cur = c & 1; const LAS float* B = L + cur * STG; LAS float* Yb = Y + cur * TC * 64;
        const int ns = (T - c * TC) < TC ? (T - c * TC) : TC;
#pragma unroll 4
        for (int t = 0; t < ns; ++t) {
            const LAS float* bt = B + t * 64 + 8 * cp;
            const f32x4 a0 = *(const LAS f32x4*)bt, a1 = *(const LAS f32x4*)(bt + 4);
            const f32x4 w0 = *(const LAS f32x4*)(bt + TC * 64), w1 = *(const LAS f32x4*)(bt + TC * 64 + 4);
            const f32x4 b0 = *(const LAS f32x4*)(bt + 2 * TC * 64), b1 = *(const LAS f32x4*)(bt + 2 * TC * 64 + 4);
            const f32x4 k0 = *(const LAS f32x4*)(bt + 3 * TC * 64), k1 = *(const LAS f32x4*)(bt + 3 * TC * 64 + 4);
            const f32x4 r0 = *(const LAS f32x4*)(bt + 4 * TC * 64), r1 = *(const LAS f32x4*)(bt + 4 * TC * 64 + 4);
            const float vv = B[5 * TC * 64 + t * 64 + row];
            const float av[8] = {a0.x, a0.y, a0.z, a0.w, a1.x, a1.y, a1.z, a1.w}, wv[8] = {w0.x, w0.y, w0.z, w0.w, w1.x, w1.y, w1.z, w1.w}, bv[8] = {b0.x, b0.y, b0.z, b0.w, b1.x, b1.y, b1.z, b1.w};
            const float kv[8] = {k0.x, k0.y, k0.z, k0.w, k1.x, k1.y, k1.z, k1.w}, rv[8] = {r0.x, r0.y, r0.z, r0.w, r1.x, r1.y, r1.z, r1.w};
            float sa = 0.f;
#pragma unroll
            for (int e = 0; e < 8; ++e) sa += S[e] * av[e];
            sa = oct_sum_dpp(sa);
            float y = 0.f;
#pragma unroll
            for (int e = 0; e < 8; ++e) { S[e] = S[e] * wv[e] + (sa * bv[e] + vv * kv[e]); y += S[e] * rv[e]; }
            y = oct_sum_dpp(y);
            if (cp == 0) Yb[t * 64 + row] = y;
        }
        if (c + 1 < NC) { stage_store(R, L + (cur ^ 1) * STG, st, sj, mur, muk, muv, kkp, kap); if (c + 2 < NC) stage_load(R, a, shift_prev, tok0, (c + 2) * TC + st, T, h, cj); }
        __syncthreads();
        if (c * TC + st < T) *(f32x2*)(ysc + (size_t)(tok0 + c * TC + st) * 2048 + cj) = *(const LAS f32x2*)(Yb + st * 64 + sj);
    }
    *(f32x4*)(s_out + row * 64 + 8 * cp) = (f32x4){S[0], S[1], S[2], S[3]}; *(f32x4*)(s_out + row * 64 + 8 * cp + 4) = (f32x4){S[4], S[5], S[6], S[7]};
}

__device__ __forceinline__ bf16x8 pack8(const f32x4 x, const f32x4 y) { v4u w; w.x = cvt_pk_bf16(x[0], x[1]); w.y = cvt_pk_bf16(x[2], x[3]); w.z = cvt_pk_bf16(y[0], y[1]); w.w = cvt_pk_bf16(y[2], y[3]); return __builtin_bit_cast(bf16x8, w); }
__device__ __forceinline__ void attn_prompt_unit(const Args& a, int u, int wave, int lane) {
    const int b = u >> 6, h = (u >> 4) & 3, qt = u & 15, fr = lane & 15, g = lane >> 4;
    const bf16* q = (const bf16*)(a.ws + WS_Q); const bf16* kb = (const bf16*)(a.ws + WS_KB); const bf16* vt = (const bf16*)(a.ws + WS_VT); bf16* yc = (bf16*)(a.ws + WS_YC);
    const int tok = b * SEQ + qt * 128 + wave * 16 + fr;
    bf16x8 qf[8];
#pragma unroll
    for (int ks = 0; ks < 8; ++ks) qf[ks] = *(const bf16x8*)(q + (size_t)tok * 1024 + h * 256 + 32 * ks + 8 * g);
    f32x4 st[16];
#pragma unroll
    for (int T = 0; T < 16; ++T) { st[T] = (f32x4){0.f, 0.f, 0.f, 0.f}; const bf16* kr = kb + (size_t)(b * 256 + 16 * T + fr) * 1024 + h * 256 + 8 * g;
#pragma unroll
        for (int ks = 0; ks < 8; ++ks) { const bf16x8 kf = *(const bf16x8*)(kr + 32 * ks); st[T] = __builtin_amdgcn_mfma_f32_16x16x32_bf16(kf, qf[ks], st[T], 0, 0, 0); } }
    float mx = -3.0e38f;
#pragma unroll
    for (int T = 0; T < 16; ++T) mx = fmaxf(fmaxf(fmaxf(st[T][0], st[T][1]), fmaxf(st[T][2], st[T][3])), mx);
    mx = fmaxf(mx, __shfl_xor(mx, 16)); mx = fmaxf(mx, __shfl_xor(mx, 32));
    float sum = 0.f;
#pragma unroll
    for (int T = 0; T < 16; ++T)
#pragma unroll
        for (int r = 0; r < 4; ++r) { const float p = __builtin_amdgcn_exp2f(st[T][r] - mx); st[T][r] = p; sum += p; }
    sum += __shfl_xor(sum, 16); sum += __shfl_xor(sum, 32);
    const float inv = 1.0f / sum;
    bf16x8 pf[8];
#pragma unroll
    for (int ks = 0; ks < 8; ++ks) pf[ks] = pack8(st[2 * ks], st[2 * ks + 1]);
#pragma unroll
    for (int dt = 0; dt < 16; ++dt) { f32x4 o = {0.f, 0.f, 0.f, 0.f}; const bf16* vr = vt + ((size_t)(b * 4 + h) * 256 + 16 * dt + fr) * 256 + 8 * g;
#pragma unroll
        for (int ks = 0; ks < 8; ++ks) { const bf16x8 vf = *(const bf16x8*)(vr + 32 * ks); o = __builtin_amdgcn_mfma_f32_16x16x32_bf16(vf, pf[ks], o, 0, 0, 0); }
        o = o * inv; v2u w; w.x = cvt_pk_bf16(o[0], o[1]); w.y = cvt_pk_bf16(o[2], o[3]);
        *(v2u*)(yc + (size_t)tok * 1024 + h * 256 + 16 * dt + 4 * g) = w; }
}
__device__ __forceinline__ void attn_sample_unit(const Ctx& C, const Args& a, int u) {
    const int db = u >> 2, h = u & 3, lane = C.lane, wave = C.wave, fr = lane & 15, g = lane >> 4;
    LAS float* sc = (LAS float*)C.lds; LAS float* red = sc + 1024; LAS float* sinv = red + 8192;
    const float* ck = a.in[I_CK] + (size_t)db * 256 * 1024 + h * 256; const float* cv = a.in[I_CV] + (size_t)db * 256 * 1024 + h * 256;
    const bf16* q = (const bf16*)(a.ws + WS_Q) + (size_t)(NTP + db * 4) * 1024 + h * 256; bf16* yc = (bf16*)(a.ws + WS_YC) + (size_t)(NTP + db * 4) * 1024 + h * 256;
    bf16x8 qf[8];
#pragma unroll
    for (int ks = 0; ks < 8; ++ks) { const v4u z = {0u, 0u, 0u, 0u}; qf[ks] = __builtin_bit_cast(bf16x8, z); if (fr < 4) qf[ks] = *(const bf16x8*)(q + (size_t)fr * 1024 + 32 * ks + 8 * g); }
#pragma unroll
    for (int T2 = 0; T2 < 2; ++T2) { const int key = 32 * wave + 16 * T2 + fr; f32x4 s = {0.f, 0.f, 0.f, 0.f}; const float* kp = ck + (size_t)key * 1024 + 8 * g;
#pragma unroll
        for (int ks = 0; ks < 8; ++ks) { const f32x4 k0 = *(const f32x4*)(kp + 32 * ks), k1 = *(const f32x4*)(kp + 32 * ks + 4); s = __builtin_amdgcn_mfma_f32_16x16x32_bf16(pack8(k0, k1), qf[ks], s, 0, 0, 0); }
        if (fr < 4) *(LAS f32x4*)(sc + fr * 256 + 32 * wave + 16 * T2 + 4 * g) = s; }
    __syncthreads();
    if (wave < 4) { f32x4 v = *(LAS f32x4*)(sc + wave * 256 + 4 * lane); float mx = fmaxf(fmaxf(v[0], v[1]), fmaxf(v[2], v[3]));
#pragma unroll
        for (int o = 1; o < 64; o <<= 1) mx = fmaxf(mx, __shfl_xor(mx, o));
        float s = 0.f;
#pragma unroll
        for (int e = 0; e < 4; ++e) { v[e] = __builtin_amdgcn_exp2f(v[e] - mx); s += v[e]; }
        s = wave_sum(s); *(LAS f32x4*)(sc + wave * 256 + 4 * lane) = v; if (lane == 0) sinv[wave] = 1.0f / s; }
    __syncthreads();
    f32x4 o[4];
#pragma unroll
    for (int t = 0; t < 4; ++t) o[t] = (f32x4){0.f, 0.f, 0.f, 0.f};
#pragma unroll 2
    for (int kk = 0; kk < 32; kk += 4) { f32x4 p[4];
#pragma unroll
        for (int t = 0; t < 4; ++t) p[t] = *(LAS f32x4*)(sc + t * 256 + 32 * wave + kk);
#pragma unroll
        for (int e = 0; e < 4; ++e) { const f32x4 v = *(const f32x4*)(cv + (size_t)(32 * wave + kk + e) * 1024 + 4 * lane);
#pragma unroll
            for (int t = 0; t < 4; ++t) o[t] += v * p[t][e]; } }
#pragma unroll
    for (int t = 0; t < 4; ++t) *(LAS f32x4*)(red + (wave * 4 + t) * 256 + 4 * lane) = o[t];
    __syncthreads();
    { const int t = C.tid >> 7, d = (C.tid & 127) * 2; f32x2 s = {0.f, 0.f};
#pragma unroll
        for (int w = 0; w < 8; ++w) s += *(LAS f32x2*)(red + (w * 4 + t) * 256 + d);
        s = s * sinv[t]; *(unsigned*)(yc + (size_t)t * 1024 + d) = cvt_pk_bf16(s.x, s.y); }
    __syncthreads();
}

#ifndef MK_ONE_LAUNCH
#define MK_ONE_LAUNCH 1
#endif
constexpr int NPHASE = 16;
constexpr int CW_BAR = 4096;

__global__ void __launch_bounds__(NWAVES * 64, 2) mk_fwd(Args args) {
    extern __shared__ __attribute__((aligned(16))) unsigned char lds_raw[];
    Ctx C; C.lds = (LAS unsigned char*)lds_raw; C.tid = threadIdx.x; C.lane = C.tid & 63; C.wave = __builtin_amdgcn_readfirstlane(C.tid >> 6);
    C.G = gridDim.x; { const int bx = blockIdx.x; C.vcu = (C.G % 8 == 0) ? (bx % 8) * (C.G / 8) + bx / 8 : bx; }
    C.gw = C.vcu * NWAVES + C.wave; C.NGW = C.G * NWAVES;
    const Args& a = args; unsigned char* ws = a.ws;
    volatile LAS unsigned* MISC = (volatile LAS unsigned*)(C.lds + MISC_OFF);
    for (int u = C.tid; u < (LDS_BYTES - LDSCTL_OFF) / 4; u += NWAVES * 64) ((LAS unsigned*)(C.lds + LDSCTL_OFF))[u] = 0u;
    __syncthreads();
#if MK_ONE_LAUNCH
    XcdBarrier bar = xcd_barrier_post((unsigned*)(ws + WS_CTL) + CW_BAR, MISC + 8);
#define GRID_BAR() xcd_barrier(bar)
#else
#define GRID_BAR() do { } while (0)
#endif
    const int lo = a.ph_lo, hi = a.ph_hi;
#ifndef PH_MASK
#define PH_MASK 0xFFFF
#endif
#define IN(k) ((((PH_MASK) >> (k)) & 1) && lo <= (k) && (k) < hi)
#define SEAM(k) do { if (IN(k) && IN((k) + 1)) GRID_BAR(); } while (0)
    LAS unsigned char* ring = C.lds + RING_OFF;
    const int bx = blockIdx.x;

    if (IN(0)) { p0_prologue(C, a); } SEAM(0);

    if (IN(1)) {
        { pg8::Gemm g{(const bf16*)(ws + WS_XB), (const bf16*)(ws + WS_W1A), MTOK, 2 * DFF, DM, DM, DM}; pg8::StaticOrder S; S.init(MTOK, 2 * DFF, C.G, bx);
          epi::SwiGLU E{(bf16*)(ws + WS_ACT), (const float*)(ws + WS_RSTD0)};
          pg8::gemm_phase<epi::SwiGLU, pg8::StaticOrder, PG8_ALIGN, PG8_SP2>(ring, g, S, E); }
        { constexpr int NU1 = (MTOK / 256) * (2 * DFF / 256); const int c0 = (C.G == 256) ? (NU1 % 256) : 0; const int gsub = C.G - c0;
          if (bx >= c0) { pg8::Gemm g{(const bf16*)(ws + WS_MEMB), (const bf16*)(ws + WS_WMEM), 1024, 2048, DM, DM, DM}; pg8::StaticOrder S; S.init(1024, 2048, gsub, bx - c0);
            epi::MemKV E{a.out + O_MK, a.out + O_MV, (bf16*)(ws + WS_KB), (bf16*)(ws + WS_VT), (const float*)(ws + WS_RSTDM)};
            pg8::gemm_phase<epi::MemKV, pg8::StaticOrder, PG8_ALIGN, PG8_SP2>(ring, g, S, E); } }
    } SEAM(1);

    if (IN(2)) {
        pg8::Gemm g{(const bf16*)(ws + WS_ACT), (const bf16*)(ws + WS_W1B), MTOK, DM, DFF, DFF, DFF}; pg8::StaticOrder S; S.init(MTOK, DM, C.G, bx);
        epi::Resid E{a.in[I_XP], a.in[I_XS] - (size_t)NTP * DM, a.out + O_Y, (bf16*)(ws + WS_XB), (float*)(ws + WS_SLOT), 0.5f};
        pg8::gemm_phase<epi::Resid, pg8::StaticOrder, PG8_ALIGN, PG8_SP2>(ring, g, S, E);
    } SEAM(2);

    if (IN(3)) { rstd_phase(C, (const float*)(ws + WS_SLOT), (float*)(ws + WS_RSTD1)); } SEAM(3);

    if (IN(4)) {
        pg8::Gemm g{(const bf16*)(ws + WS_XB), (const bf16*)(ws + WS_WIN), MTOK, NWIN, DM, DM, DM}; pg8::StaticOrder S; S.init(MTOK, NWIN, C.G, bx);
        epi::Win E{(float*)(ws + WS_PAF), (bf16*)(ws + WS_PB), (bf16*)(ws + WS_Q), (bf16*)(ws + WS_GATE), (const float*)(ws + WS_RSTD1)};
        pg8::gemm_phase<epi::Win, pg8::StaticOrder, PG8_ALIGN, PG8_SP2>(ring, g, S, E);
    } SEAM(4);

    if (IN(5)) { r1_phase(C, a); } SEAM(5);

    if (IN(6)) {
        { pg8::Gemm g{(const bf16*)(ws + WS_LIN), (const bf16*)(ws + WS_WLWA), MTOK, 4096, 256, 512, 256}; pg8::StaticOrder S; S.init(MTOK, 4096, C.G, bx);
          epi::LoraWA E{(float*)(ws + WS_WDEC), (float*)(ws + WS_AVAL), a.in[I_W0], a.in[I_A0]};
          pg8::gemm_phase<epi::LoraWA, pg8::StaticOrder, PG8_ALIGN, PG8_SP2>(ring, g, S, E); }
        { pg8::Gemm g{(const bf16*)(ws + WS_LIN) + 256, (const bf16*)(ws + WS_WLG), MTOK, 2048, 256, 512, 256}; pg8::StaticOrder S; S.init(MTOK, 2048, C.G, bx);
          epi::LoraG E{(bf16*)(ws + WS_G)};
          pg8::gemm_phase<epi::LoraG, pg8::StaticOrder, PG8_ALIGN, PG8_SP2>(ring, g, S, E); }
    } SEAM(6);

    if (IN(7)) { r4_phase(C, a); } SEAM(7);

    if (IN(8)) {
        const int nscan = (C.G > 128) ? 128 : C.G / 2, nother = C.G - nscan;
        if (bx < nscan) {
            for (int u = bx; u < 128; u += nscan) { const int b = u >> 5, h = u & 31; scan_unit(C, a, b * SEQ, SEQ, nullptr, nullptr, a.out + O_RWP + (size_t)u * 4096, h); }
        } else {
            const int r = bx - nscan;
            for (int u = r; u < NDB * HA; u += nother) { const int db = u >> 5, h = u & 31;
                scan_unit(C, a, NTP + db * DSEQ, DSEQ, a.in[I_SSH] + (size_t)db * PA, a.in[I_SRW] + (size_t)u * 4096, a.out + O_RWS + (size_t)u * 4096, h); }
            for (int u = r; u < 256; u += nother) attn_prompt_unit(a, u, C.wave, C.lane);
            for (int u = r; u < 512; u += nother) attn_sample_unit(C, a, u);
            conv_phase(a, r * NWAVES + C.wave, nother * NWAVES, C.lane);
        }
    } SEAM(8);

    if (IN(9)) { post_phase(C, a); } SEAM(9);

    if (IN(10)) {
        pg8::StaticOrder S; S.init(MTOK, DM, C.G, bx);
        { pg8::Gemm g{(const bf16*)(ws + WS_YA), (const bf16*)(ws + WS_WBRA), MTOK, DM, 2048, 2048, 2048}; epi::Gate<0> E{(const bf16*)(ws + WS_GATE), 0, (float*)(ws + WS_MACC), (bf16*)(ws + WS_MRG)};
          pg8::gemm_phase<epi::Gate<0>, pg8::StaticOrder, PG8_ALIGN, PG8_SP2>(ring, g, S, E); }
        { pg8::Gemm g{(const bf16*)(ws + WS_YB), (const bf16*)(ws + WS_WBRB), MTOK, DM, 1024, 1024, 1024}; epi::Gate<1> E{(const bf16*)(ws + WS_GATE), DM, (float*)(ws + WS_MACC), (bf16*)(ws + WS_MRG)};
          pg8::gemm_phase<epi::Gate<1>, pg8::StaticOrder, PG8_ALIGN, PG8_SP2>(ring, g, S, E); }
        { pg8::Gemm g{(const bf16*)(ws + WS_YC), (const bf16*)(ws + WS_WBRC), MTOK, DM, 1024, 1024, 1024}; epi::Gate<2> E{(const bf16*)(ws + WS_GATE), 2 * DM, (float*)(ws + WS_MACC), (bf16*)(ws + WS_MRG)};
          pg8::gemm_phase<epi::Gate<2>, pg8::StaticOrder, PG8_ALIGN, PG8_SP2>(ring, g, S, E); }
    } SEAM(10);

    if (IN(11)) {
        pg8::Gemm g{(const bf16*)(ws + WS_MRG), (const bf16*)(ws + WS_WOUT), MTOK, DM, DM, DM, DM}; pg8::StaticOrder S; S.init(MTOK, DM, C.G, bx);
        epi::Resid E{a.out + O_Y, a.out + O_Y, a.out + O_Y, (bf16*)(ws + WS_XB), (float*)(ws + WS_SLOT), 1.0f};
        pg8::gemm_phase<epi::Resid, pg8::StaticOrder, PG8_ALIGN, PG8_SP2>(ring, g, S, E);
    } SEAM(11);

    if (IN(12)) { rstd_phase(C, (const float*)(ws + WS_SLOT), (float*)(ws + WS_RSTD2)); } SEAM(12);

    if (IN(13)) {
        pg8::Gemm g{(const bf16*)(ws + WS_XB), (const bf16*)(ws + WS_W2A), MTOK, 2 * DFF, DM, DM, DM}; pg8::StaticOrder S; S.init(MTOK, 2 * DFF, C.G, bx);
        epi::SwiGLU E{(bf16*)(ws + WS_ACT), (const float*)(ws + WS_RSTD2)};
        pg8::gemm_phase<epi::SwiGLU, pg8::StaticOrder, PG8_ALIGN, PG8_SP2>(ring, g, S, E);
    } SEAM(13);

    if (IN(14)) {
        pg8::Gemm g{(const bf16*)(ws + WS_ACT), (const bf16*)(ws + WS_W2B), MTOK, DM, DFF, DFF, DFF}; pg8::StaticOrder S; S.init(MTOK, DM, C.G, bx);
        epi::Resid E{a.out + O_Y, a.out + O_Y, a.out + O_Y, (bf16*)(ws + WS_XB), (float*)(ws + WS_SLOT), 0.5f};
        pg8::gemm_phase<epi::Resid, pg8::StaticOrder, PG8_ALIGN, PG8_SP2>(ring, g, S, E);
    } SEAM(14);

    if (IN(15)) { final_norm(C, a); }
#undef IN
#undef SEAM
}

extern "C" void kernel_launch(void* const* d_in, const int* in_sizes, int n_in, void* d_out, int out_size, void* d_ws, size_t ws_size, hipStream_t stream) {
    static int grid = 0;
    if (grid == 0) {
        if (n_in != 35 || (size_t)out_size != O_END || ws_size < WS_END) { fprintf(stderr, "kernel_launch: unexpected problem: n_in %d out_size %d ws_size %zu (need %zu)\n", n_in, out_size, ws_size, (size_t)WS_END); grid = -1; return; }
        int dev = 0, cus = 0;
        if (hipGetDevice(&dev) != hipSuccess || hipDeviceGetAttribute(&cus, hipDeviceAttributeMultiprocessorCount, dev) != hipSuccess) { grid = -1; return; }
        if (hipFuncSetAttribute((const void*)mk_fwd, hipFuncAttributeMaxDynamicSharedMemorySize, LDS_BYTES) != hipSuccess) { fprintf(stderr, "kernel_launch: hipFuncSetAttribute failed\n"); grid = -1; return; }
        int per_cu = 0;
        if (hipOccupancyMaxActiveBlocksPerMultiprocessor(&per_cu, (const void*)mk_fwd, NWAVES * 64, LDS_BYTES) != hipSuccess || per_cu < 1) fprintf(stderr, "kernel_launch: occupancy query says %d\n", per_cu);
        (void)hipGetLastError();
        grid = cus;
    }
    if (grid < 0) return;
    (void)hipMemsetAsync((char*)d_ws + WS_CTL, 0, CTL_BYTES, stream);
    Args a{};
    for (int i = 0; i < 35; ++i) a.in[i] = (const float*)d_in[i];
    a.out = (float*)d_out; a.ws = (unsigned char*)d_ws;
#if MK_ONE_LAUNCH
    a.ph_lo = 0; a.ph_hi = NPHASE;
    hipLaunchKernelGGL(mk_fwd, dim3(grid), dim3(NWAVES * 64), LDS_BYTES, stream, a);
#else
#ifndef MK_LAST_PHASE
#define MK_LAST_PHASE (NPHASE - 1)
#endif
    for (int p = 0; p <= MK_LAST_PHASE; ++p) { a.ph_lo = p; a.ph_hi = p + 1; hipLaunchKernelGGL(mk_fwd, dim3(grid), dim3(NWAVES * 64), LDS_BYTES, stream, a); }
#endif
}
```

```cpp
#include <hip/hip_runtime.h>
#include <cstdio>
#include <cstdint>
namespace pg8 {
#define PG8_LAS __attribute__((address_space(3)))
typedef unsigned short bf16_t;
typedef short bf16x8 __attribute__((ext_vector_type(8)));
typedef float f32x4 __attribute__((ext_vector_type(4)));
typedef unsigned u32x4 __attribute__((ext_vector_type(4)));
constexpr int BM = 256, BK = 64, HALF = 128, HTB = HALF * BK * 2  , STAGE_BYTES = 8 * HTB, NXCD = 8, WGM = 8;

__host__ __device__ __forceinline__ int lds_byte(int r, int c) { const int st = (r >> 4) * 2 + (c >> 5), rr = r & 15, cc = c & 31, ob = rr * 64 + cc * 2; return st * 1024 + (ob ^ (((ob >> 9) & 1) << 5)); }
__host__ __device__ __forceinline__ void stage_rc(int b, int& R, int& C) { const int st = b / 1024, sb = b % 1024, swz = sb ^ (((sb >> 9) & 1) << 5); R = (st >> 1) * 16 + swz / 64; C = (st & 1) * 32 + (swz % 64) / 2; }
__host__ __device__ __forceinline__ int perm32(int rho) { const int n = rho >> 4, i = rho & 15; return 8 * (i >> 2) + 4 * n + (i & 3); }

struct Unit { int pm, pn, kt0, nt, kind, slab; };
struct Gemm { const bf16_t* A; const bf16_t* Bt; int M, N, K, lda, ldb; };

struct StaticOrder {
    int nM, nN, nwg, G, c;
    __host__ __device__ void init(int M, int N, int G_, int c_) { nM = M / BM; nN = N / BM; nwg = nM * nN; G = G_; c = c_; }
    __host__ __device__ bool next(int i, Unit& u) const {
        const long L = (long)i * G + c; if (L >= nwg) return false;
        int wgid = (int)L; { const int q = nwg / NXCD, r = nwg % NXCD, xcd = wgid % NXCD, off = wgid / NXCD; wgid = (xcd < r ? xcd * (q + 1) : r * (q + 1) + (xcd - r) * q) + off; }
        const int nig = WGM * nN, gid = wgid / nig, fm = gid * WGM, gsz = (nM - fm) < WGM ? (nM - fm) : WGM;
        u.pm = fm + ((wgid % nig) % gsz); u.pn = (wgid % nig) / gsz; u.kt0 = 0; u.nt = -1; u.kind = 0; u.slab = 0; return true;
    }
    static constexpr bool STREAMK = false;
    __device__ __forceinline__ void a_ready(const Unit&) const {}
    __device__ __forceinline__ void done(const Unit&) const {}
};


struct XcdOrder {
    static constexpr bool STREAMK = false;
    int nN, x, j;
    __host__ __device__ __forceinline__ void init(int N, int c) { nN = N / BM; x = c & 7; j = c >> 3; }
    __host__ __device__ __forceinline__ bool entry(int e, Unit& u) const {
        if (e < 4 * nN) { u.pn = 8 * (e >> 5) + ((e & 31) >> 2); u.pm = x + 8 * (e & 3); }
        else { const int s = x + 8 * (e - 4 * nN); if (s >= 2 * nN) return false; u.pn = s >> 1; u.pm = 32 + (s & 1); }
        u.kt0 = 0; u.nt = -1; u.kind = 0; u.slab = 0; return true;
    }
    __host__ __device__ __forceinline__ bool next(int i, Unit& u) const { return entry(j + 32 * i, u); }
    __device__ __forceinline__ void a_ready(const Unit&) const {}
    __device__ __forceinline__ void done(const Unit&) const {}
};
typedef __attribute__((address_space(1))) unsigned long long gu64_t; typedef __attribute__((address_space(1))) unsigned gu32_t;
struct StreamKOrder {
    static constexpr bool STREAMK = true;
    int nN, NB, s0, s1, rank;
    unsigned long long* slab; unsigned* flag; unsigned* tmo;
    __device__ __forceinline__ void init(int M, int N, int K, int G, int rank_, unsigned long long* slab_, unsigned* flag_, unsigned* tmo_) {
        nN = N / BM; NB = K / 128; const long I = (long)(M / BM) * nN * NB; s0 = (int)(I * rank_ / G); s1 = (int)(I * (rank_ + 1) / G); rank = rank_; slab = slab_; flag = flag_; tmo = tmo_; }
    __device__ __forceinline__ void set(Unit& u, int unit, int kb0, int nkb, int kind, int sl) const { u.pm = unit / nN; u.pn = unit % nN; u.kt0 = 2 * kb0; u.nt = 2 * nkb; u.kind = kind; u.slab = sl; }
    __device__ __forceinline__ bool next(int i, Unit& u) const {
        const int uf = s0 / NB, r0 = s0 % NB, ul = s1 / NB, r1 = s1 % NB; int idx = i;
        if (r0 != 0) { if (idx == 0) { set(u, uf, r0, NB - r0, 1, rank); return true; } idx -= 1; }
        const int f0 = uf + (r0 != 0 ? 1 : 0), nfull = ul - f0;
        if (idx < nfull) { set(u, f0 + idx, 0, NB, 0, 0); return true; }
        idx -= nfull;
        if (r1 != 0 && idx == 0) { set(u, ul, 0, r1, 2, rank + 1); return true; }
        return false;
    }
    __device__ __forceinline__ void a_ready(const Unit&) const {}
    __device__ __forceinline__ void done(const Unit&) const {}
    __device__ __forceinline__ void store_slab(const f32x4 (&acc)[2][2][4][2], const Unit& u, int wid, int lane) const {
        gu64_t* p = (gu64_t*)slab + ((size_t)(u.slab * 8 + wid) * 32 * 64 + lane) * 2;
#pragma unroll
        for (int r4 = 0; r4 < 8; ++r4) {
#pragma unroll
            for (int j = 0; j < 4; ++j) { const int r = 4 * r4 + j; const f32x4 v = acc[r >> 4][(r >> 3) & 1][(r >> 1) & 3][r & 1];
                const float f0 = v[0], f1 = v[1], f2 = v[2], f3 = v[3];
                __hip_atomic_store(p + j * 128, ((unsigned long long)__float_as_uint(f1) << 32) | __float_as_uint(f0), __ATOMIC_RELAXED, __HIP_MEMORY_SCOPE_AGENT);
                __hip_atomic_store(p + j * 128 + 1, ((unsigned long long)__float_as_uint(f3) << 32) | __float_as_uint(f2), __ATOMIC_RELAXED, __HIP_MEMORY_SCOPE_AGENT); }
            p += 512; asm volatile("" : "+v"(p) :: "memory"); }
        asm volatile("s_waitcnt vmcnt(0)" ::: "memory");
        if (lane == 0) __hip_atomic_fetch_add((gu32_t*)flag + 64 * u.slab, 1u, __ATOMIC_RELAXED, __HIP_MEMORY_SCOPE_AGENT);
    }
    __device__ __forceinline__ void add_slab(f32x4 (&acc)[2][2][4][2], const Unit& u, int wid, int lane) const {
        const unsigned long long t0 = __builtin_amdgcn_s_memrealtime();
        while ((unsigned)__builtin_amdgcn_readfirstlane(__hip_atomic_load((gu32_t*)flag + 64 * u.slab, __ATOMIC_RELAXED, __HIP_MEMORY_SCOPE_AGENT)) < 8u) {
            if (__builtin_amdgcn_s_memrealtime() - t0 > 2000000ull) { if (lane == 0) __hip_atomic_store((gu32_t*)tmo, 1u, __ATOMIC_RELAXED, __HIP_MEMORY_SCOPE_AGENT); break; }
            __builtin_amdgcn_s_sleep(2); }
        gu64_t* p = (gu64_t*)slab + ((size_t)(u.slab * 8 + wid) * 32 * 64 + lane) * 2;
#pragma unroll
        for (int r4 = 0; r4 < 8; ++r4) {
#pragma unroll
            for (int j = 0; j < 4; ++j) { const int r = 4 * r4 + j;
                const unsigned long long lo = __hip_atomic_load(p + j * 128, __ATOMIC_RELAXED, __HIP_MEMORY_SCOPE_AGENT), hi = __hip_atomic_load(p + j * 128 + 1, __ATOMIC_RELAXED, __HIP_MEMORY_SCOPE_AGENT);
                f32x4& a = acc[r >> 4][(r >> 3) & 1][(r >> 1) & 3][r & 1];
                a[0] += __uint_as_float((unsigned)lo); a[1] += __uint_as_float((unsigned)(lo >> 32)); a[2] += __uint_as_float((unsigned)hi); a[3] += __uint_as_float((unsigned)(hi >> 32)); }
            p += 512; asm volatile("" : "+v"(p) :: "memory"); }
    }
};

struct TailSplitOrder {
    static constexpr bool STREAMK = true;
    XcdOrder xo; int c, R, rem, split, NB; float* slabf;
    __device__ __forceinline__ void init(int M, int N, int K, int G, int c_, float* slab_) { xo.init(N, c_); c = c_; const int nwg = (M / BM) * (N / BM); R = nwg / G; rem = nwg - R * G; split = rem ? G / rem : 1; NB = K / 128; slabf = slab_; }
    __device__ __forceinline__ static void leftover(int N, int R, int l, Unit& u) { XcdOrder t; t.init(N, l & 7); t.entry(32 * R + (l >> 3), u); }
    __device__ __forceinline__ bool next(int i, Unit& u) const {
        if (i < R) return xo.next(i, u);
        if (i > R || rem == 0) return false;
        const int l = c / split, part = c % split; if (l >= rem) return false;
        leftover(xo.nN * BM, R, l, u);
        const int kb0 = part * NB / split, kb1 = (part + 1) * NB / split; u.kt0 = 2 * kb0; u.nt = 2 * (kb1 - kb0); u.kind = 1; u.slab = c; return true;
    }
    __device__ __forceinline__ void a_ready(const Unit&) const {}
    __device__ __forceinline__ void done(const Unit&) const {}
    __device__ __forceinline__ void store_slab(const f32x4 (&acc)[2][2][4][2], const Unit& u, int wid, int lane) const {
        float* p = slabf + ((size_t)(u.slab * 8 + wid) * 32 * 64 + lane) * 4;
#pragma unroll
        for (int r4 = 0; r4 < 8; ++r4) {
#pragma unroll
            for (int j = 0; j < 4; ++j) { const int r = 4 * r4 + j; *(f32x4*)(p + j * 256) = acc[r >> 4][(r >> 3) & 1][(r >> 1) & 3][r & 1]; }
            p += 1024; asm volatile("" : "+v"(p) :: "memory"); }
    }
    __device__ __forceinline__ void add_slab(f32x4 (&)[2][2][4][2], const Unit&, int, int) const {}
};

template <class Epi, class Sched, bool ALIGN_EPI = false, bool SP2 = false>
__device__ __forceinline__ void gemm_phase(PG8_LAS unsigned char* lds, const Gemm g, const Sched& S, const Epi& E) {
    const int tid = threadIdx.x, wid = __builtin_amdgcn_readfirstlane(tid >> 6), lane = tid & 63, wr = wid >> 2, wc = wid & 3, fr = lane & 15, fq = lane >> 4;
    const int K = g.K, nt = K / BK;
    unsigned voffA[2], voffB[2];
#pragma unroll
    for (int i = 0; i < 2; ++i) { int R, C; stage_rc(tid * 16 + i * 8192, R, C); const int Rb = Epi::PERM ? ((R & ~31) + perm32(R & 31)) : R;
        voffA[i] = (unsigned)(R * g.lda + C) * 2u; voffB[i] = (unsigned)(Rb * g.ldb + C) * 2u; }
    const size_t kstep = (size_t)(BK * 2);
    const size_t hstepA = (size_t)HALF * g.lda * 2, hstepB = (size_t)HALF * g.ldb * 2;
    const size_t tstepA = 2 * hstepA, tstepB = 2 * hstepB;
    const unsigned ldsw = (unsigned)wid * 1024u;
    const int aoff = lds_byte(wr * 64 + fr, fq * 8), boff = lds_byte(wc * 32 + fr, fq * 8);
#define PG8_SA(b, h) (((b) * 2 + (h)) * HTB)
#define PG8_SB(b, h) ((4 + (b) * 2 + (h)) * HTB)
#define PG8_STAGE(bufoff, gbase, voff) do { _Pragma("unroll") for (int _i = 0; _i < 2; ++_i) \
        __builtin_amdgcn_global_load_lds((const unsigned*)((const char*)(gbase) + (voff)[_i]), (PG8_LAS unsigned*)(lds + (bufoff) + ldsw + _i * 8192), 16, 0, 0); } while (0)
#define PG8_LDA(dst, b, h) do { _Pragma("unroll") for (int m = 0; m < 4; ++m) _Pragma("unroll") for (int k = 0; k < 2; ++k) dst[m][k] = *(const PG8_LAS bf16x8*)(lds + PG8_SA(b, h) + aoff + m * 2048 + k * 1024); } while (0)
#define PG8_LDB(dst, b, h) do { _Pragma("unroll") for (int n = 0; n < 2; ++n) _Pragma("unroll") for (int k = 0; k < 2; ++k) dst[n][k] = *(const PG8_LAS bf16x8*)(lds + PG8_SB(b, h) + boff + n * 2048 + k * 1024); } while (0)
#define PG8_MMA(ai, bj, At, Bt) do { __builtin_amdgcn_s_setprio(1); _Pragma("unroll") for (int m = 0; m < 4; ++m) _Pragma("unroll") for (int n = 0; n < 2; ++n) _Pragma("unroll") for (int k = 0; k < 2; ++k) \
        acc[ai][bj][m][n] = __builtin_amdgcn_mfma_f32_16x16x32_bf16(Bt[n][k], At[m][k], acc[ai][bj][m][n], 0, 0, 0); __builtin_amdgcn_s_setprio(0); } while (0)
#define PG8_WAIT_V(n) asm volatile("s_waitcnt vmcnt(" #n ")" ::: "memory")
#define PG8_WAIT_L(n) asm volatile("s_waitcnt lgkmcnt(" #n ")" ::: "memory")
#define PG8_BAR __builtin_amdgcn_s_barrier()
#define PG8_SCHED __builtin_amdgcn_sched_barrier(0)
    Unit cur, nxt; int ui = 0;
    if (!S.next(0, cur)) return;
    int cnt = cur.nt < 0 ? nt : cur.nt;
    f32x4 acc[2][2][4][2];
#pragma unroll
    for (int a = 0; a < 2; ++a)
#pragma unroll
        for (int b = 0; b < 2; ++b)
#pragma unroll
            for (int m = 0; m < 4; ++m)
#pragma unroll
                for (int n = 0; n < 2; ++n) acc[a][b][m][n] = (f32x4){0.f, 0.f, 0.f, 0.f};
    bf16x8 At[4][2], B0[2][2], B1[2][2];
    const char* cA = (const char*)g.A + (size_t)cur.pm * tstepA + (size_t)cur.kt0 * kstep; const char* cB = (const char*)g.Bt + (size_t)cur.pn * tstepB + (size_t)cur.kt0 * kstep;
    S.a_ready(cur);
    if constexpr (SP2) {
        PG8_STAGE(PG8_SB(0, 0), cB, voffB); PG8_STAGE(PG8_SB(0, 1), cB + hstepB, voffB); PG8_STAGE(PG8_SA(0, 0), cA, voffA); PG8_STAGE(PG8_SA(0, 1), cA + hstepA, voffA);
        if (wr == 1) PG8_BAR;
        PG8_WAIT_V(2); PG8_BAR;
        PG8_STAGE(PG8_SB(1, 0), cB + kstep, voffB); PG8_STAGE(PG8_SA(1, 0), cA + kstep, voffA); PG8_STAGE(PG8_SB(1, 1), cB + hstepB + kstep, voffB);
        PG8_WAIT_V(6); PG8_BAR;
    } else {
        PG8_STAGE(PG8_SB(0, 0), cB, voffB); PG8_STAGE(PG8_SA(0, 0), cA, voffA); PG8_STAGE(PG8_SB(0, 1), cB + hstepB, voffB); PG8_STAGE(PG8_SA(0, 1), cA + hstepA, voffA);
        if (wr == 1) PG8_BAR;
        PG8_WAIT_V(4); PG8_BAR;
        PG8_STAGE(PG8_SB(1, 0), cB + kstep, voffB); PG8_STAGE(PG8_SA(1, 0), cA + kstep, voffA); PG8_STAGE(PG8_SB(1, 1), cB + hstepB + kstep, voffB);
        PG8_WAIT_V(6); PG8_BAR;
    }
    for (;;) {
        const bool has_next = S.next(ui + 1, nxt);
        const char* nA = has_next ? (const char*)g.A + (size_t)nxt.pm * tstepA + (size_t)nxt.kt0 * kstep : cA; const char* nB = has_next ? (const char*)g.Bt + (size_t)nxt.pn * tstepB + (size_t)nxt.kt0 * kstep : cB;
#pragma unroll 1
        for (int t = 0; t < cnt; t += 2) {
            const bool last = (t == cnt - 2);
            if constexpr (Epi::KHOOK) { const int kt = cur.kt0 + t; if (t > 0 && (kt == 32 || kt == 48)) E.khook(acc, cur, kt, wr, wc, fr, fq); }
            const char* a1 = cA + (size_t)(t + 1) * kstep;
            const char* a2 = last ? nA : cA + (size_t)(t + 2) * kstep; const char* b2 = last ? nB : cB + (size_t)(t + 2) * kstep;
            const char* a3 = a2 + kstep; const char* b3 = b2 + kstep;
            if (last && has_next) S.a_ready(nxt);
            if constexpr (SP2) {
            PG8_LDB(B0, 0, 0); PG8_LDB(B1, 0, 1); PG8_SCHED; PG8_LDA(At, 0, 0); PG8_STAGE(PG8_SA(1, 1), a1 + hstepA, voffA);
            PG8_WAIT_V(8); PG8_WAIT_L(0); PG8_BAR; PG8_MMA(0, 0, At, B0); PG8_MMA(0, 1, At, B1); PG8_BAR; PG8_SCHED;
            PG8_LDA(At, 0, 1); PG8_STAGE(PG8_SB(0, 0), b2, voffB); PG8_STAGE(PG8_SB(0, 1), b2 + hstepB, voffB); PG8_STAGE(PG8_SA(0, 0), a2, voffA);
            PG8_WAIT_V(8); PG8_WAIT_L(0); PG8_BAR; PG8_MMA(1, 0, At, B0); PG8_MMA(1, 1, At, B1); PG8_BAR; PG8_SCHED;
            PG8_LDB(B0, 1, 0); PG8_LDB(B1, 1, 1); PG8_SCHED; PG8_LDA(At, 1, 0); PG8_STAGE(PG8_SA(0, 1), a2 + hstepA, voffA);
            PG8_WAIT_V(8); PG8_WAIT_L(0); PG8_BAR; PG8_MMA(0, 0, At, B0); PG8_MMA(0, 1, At, B1); PG8_BAR; PG8_SCHED;
            PG8_LDA(At, 1, 1); PG8_STAGE(PG8_SB(1, 0), b3, voffB); PG8_STAGE(PG8_SB(1, 1), b3 + hstepB, voffB); PG8_STAGE(PG8_SA(1, 0), a3, voffA);
            PG8_WAIT_V(8); PG8_WAIT_L(0); PG8_BAR; PG8_MMA(1, 0, At, B0); PG8_MMA(1, 1, At, B1); PG8_BAR; PG8_SCHED;
            } else {
            PG8_LDB(B0, 0, 0); PG8_SCHED; PG8_LDA(At, 0, 0); PG8_STAGE(PG8_SA(1, 1), a1 + hstepA, voffA);
            PG8_WAIT_L(8); PG8_BAR; PG8_WAIT_L(0); PG8_MMA(0, 0, At, B0); PG8_BAR; PG8_SCHED;
            PG8_LDB(B1, 0, 1); PG8_STAGE(PG8_SB(0, 0), b2, voffB);
            PG8_BAR; PG8_WAIT_L(0); PG8_MMA(0, 1, At, B1); PG8_BAR;
            PG8_LDA(At, 0, 1); PG8_STAGE(PG8_SA(0, 0), a2, voffA);
            PG8_BAR; PG8_WAIT_L(0); PG8_MMA(1, 0, At, B0); PG8_BAR; PG8_SCHED;
            PG8_STAGE(PG8_SB(0, 1), b2 + hstepB, voffB);
            PG8_WAIT_V(6); PG8_BAR; PG8_MMA(1, 1, At, B1); PG8_BAR;
            PG8_LDB(B0, 1, 0); PG8_SCHED; PG8_LDA(At, 1, 0); PG8_STAGE(PG8_SA(0, 1), a2 + hstepA, voffA);
            PG8_WAIT_L(8); PG8_BAR; PG8_WAIT_L(0); PG8_MMA(0, 0, At, B0); PG8_BAR; PG8_SCHED;
            PG8_LDB(B1, 1, 1); PG8_STAGE(PG8_SB(1, 0), b3, voffB);
            PG8_BAR; PG8_WAIT_L(0); PG8_MMA(0, 1, At, B1); PG8_BAR;
            PG8_LDA(At, 1, 1); PG8_STAGE(PG8_SA(1, 0), a3, voffA);
            PG8_BAR; PG8_WAIT_L(0); PG8_MMA(1, 0, At, B0); PG8_BAR; PG8_SCHED;
            PG8_STAGE(PG8_SB(1, 1), b3 + hstepB, voffB);
            PG8_WAIT_V(6); PG8_BAR; PG8_MMA(1, 1, At, B1); PG8_BAR;
            }
        }
        if constexpr (ALIGN_EPI) { if (wr == 0) PG8_BAR; }
        if constexpr (Sched::STREAMK) { __builtin_amdgcn_sched_barrier(0); if (cur.kind == 2) S.add_slab(acc, cur, wid, lane); __builtin_amdgcn_sched_barrier(0);
            if (cur.kind == 1) { if constexpr (Epi::KHOOK) E.pre_slab(acc, cur, wr, wc, fr, fq); S.store_slab(acc, cur, wid, lane); } else E(acc, cur, wr, wc, fr, fq); __builtin_amdgcn_sched_barrier(0); }
        else if constexpr (!Epi::AFTER_DRAIN) { E(acc, cur, wr, wc, fr, fq); S.done(cur); }
        if (!has_next) break;
#pragma unroll
        for (int a = 0; a < 2; ++a)
#pragma unroll
            for (int b = 0; b < 2; ++b)
#pragma unroll
                for (int m = 0; m < 4; ++m)
#pragma unroll
                    for (int n = 0; n < 2; ++n) acc[a][b][m][n] = (f32x4){0.f, 0.f, 0.f, 0.f};
        cur = nxt; cA = nA; cB = nB; ++ui; cnt = cur.nt < 0 ? nt : cur.nt;
        if constexpr (ALIGN_EPI) { if (wr == 1) PG8_BAR; }
    }
    PG8_WAIT_V(0);
    if constexpr (!ALIGN_EPI) { if (wr == 0) PG8_BAR; }
    PG8_BAR;
    if constexpr (Epi::AFTER_DRAIN) { E.fused(acc, cur, wr, wc, fr, fq, lds, wid, lane); S.done(cur); }
#undef PG8_SA
#undef PG8_SB
#undef PG8_STAGE
#undef PG8_LDA
#undef PG8_LDB
#undef PG8_MMA
#undef PG8_WAIT_V
#undef PG8_WAIT_L
#undef PG8_BAR
#undef PG8_SCHED
}
}

#ifndef PG8_SP2
#define PG8_SP2 true
#endif
#ifndef PG8_ALIGN
#define PG8_ALIGN true
#endif

constexpr int DM = 4096, NTP = 8192, NTS = 512, MTOK = 8704, DFF = 11008, SEQ = 2048, NB = 4, NDB = 128, DSEQ = 4;
constexpr int PA = 6592, PA_PAD = 6656, PBW = 3072, PCW = 1024, PGW = 12288, NWIN = 23040, PIN = 22976;
constexpr int DA = 2048, HA = 32, NMEM = 256;
constexpr float EPS = 1e-6f, GN_EPS = 64e-5f;
constexpr float QSCALE = 0.0625f * 1.4426950408889634f;

constexpr size_t O_Y = 0, O_MK = 35651584, O_MV = 36700160, O_RWP = 37748736, O_SHP = 38273024, O_CVP = 38299392, O_RWS = 38307584, O_SHS = 55084800, O_CVS = 55928576, O_END = 56190720;

constexpr size_t al256(size_t x) { return (x + 255) & ~(size_t)255; }
constexpr size_t WS_CTL = 0, CTL_BYTES = 1u << 20;
constexpr size_t WS_W1A = WS_CTL + CTL_BYTES;
constexpr size_t WS_W1B = WS_W1A + (size_t)2 * DFF * DM * 2;
constexpr size_t WS_WIN = WS_W1B + (size_t)DM * DFF * 2;
constexpr size_t WS_WMEM = WS_WIN + (size_t)NWIN * DM * 2;
constexpr size_t WS_WBRA = WS_WMEM + (size_t)2048 * DM * 2;
constexpr size_t WS_WBRB = WS_WBRA + (size_t)DM * 2048 * 2;
constexpr size_t WS_WBRC = WS_WBRB + (size_t)DM * 1024 * 2;
constexpr size_t WS_WOUT = WS_WBRC + (size_t)DM * 1024 * 2;
constexpr size_t WS_W2A = WS_WOUT + (size_t)DM * DM * 2;
constexpr size_t WS_W2B = WS_W2A + (size_t)2 * DFF * DM * 2;
constexpr size_t WS_WLWA = WS_W2B + (size_t)DM * DFF * 2;
constexpr size_t WS_WLG = WS_WLWA + (size_t)4096 * 256 * 2;
constexpr size_t WS_XB = WS_WLG + (size_t)2048 * 256 * 2;
constexpr size_t WS_ACT = WS_XB + (size_t)MTOK * DM * 2;
constexpr size_t WS_PAF = WS_ACT + (size_t)MTOK * DFF * 2;
constexpr size_t WS_PB = WS_PAF + (size_t)MTOK * PA_PAD * 4;
constexpr size_t WS_Q = WS_PB + (size_t)MTOK * PBW * 2;
constexpr size_t WS_GATE = WS_Q + (size_t)MTOK * PCW * 2;
constexpr size_t WS_LIN = WS_GATE + (size_t)MTOK * PGW * 2;
constexpr size_t WS_G = WS_LIN + (size_t)MTOK * 512 * 2;
constexpr size_t WS_YA = WS_G + (size_t)MTOK * 2048 * 2;
constexpr size_t WS_YB = WS_YA + (size_t)MTOK * 2048 * 2;
constexpr size_t WS_YC = WS_YB + (size_t)MTOK * 1024 * 2;
constexpr size_t WS_MRG = WS_YC + (size_t)MTOK * 1024 * 2;
constexpr size_t WS_MEMB = WS_MRG + (size_t)MTOK * DM * 2;
constexpr size_t WS_KB = WS_MEMB + (size_t)1024 * DM * 2;
constexpr size_t WS_VT = WS_KB + (size_t)1024 * 1024 * 2;
constexpr size_t WS_SLOT = WS_VT + (size_t)1024 * 1024 * 2;
constexpr size_t WS_RSTD0 = WS_SLOT + (size_t)MTOK * 64 * 4;
constexpr size_t WS_RSTD1 = WS_RSTD0 + 65536;
constexpr size_t WS_RSTD2 = WS_RSTD1 + 65536;
constexpr size_t WS_RSTDM = WS_RSTD2 + 65536;
constexpr size_t WS_INVN = WS_RSTDM + 65536;
constexpr size_t WS_RK = WS_INVN + (size_t)MTOK * 32 * 4;
constexpr size_t WS_SLAB = WS_RK + (size_t)MTOK * 32 * 4;
constexpr size_t WS_END = WS_SLAB + (size_t)256 * 262144;
static_assert(WS_END <= (size_t)2029 * 1024 * 1024, "d_ws map exceeds the guaranteed workspace");
static_assert((size_t)MTOK * 2048 * 4 <= (size_t)MTOK * DM * 2 && (size_t)MTOK * DM * 4 <= (size_t)MTOK * DFF * 2 && (size_t)2 * MTOK * 2048 * 4 <= (size_t)MTOK * DFF * 2, "overlays");
constexpr size_t WS_YSCAN = WS_XB, WS_WDEC = WS_ACT, WS_AVAL = WS_ACT + (size_t)MTOK * 2048 * 4, WS_MACC = WS_ACT;

constexpr int RING_OFF = 0, RING_BYTES = 131072;
constexpr int LDSCTL_OFF = 135168, MISC_OFF = LDSCTL_OFF + 320;
constexpr int LDS_BYTES = 147456;
constexpr int NWAVES = 8;

#define GAS __attribute__((address_space(1)))
#define LAS __attribute__((address_space(3)))
typedef unsigned short bf16;
typedef unsigned v4u __attribute__((ext_vector_type(4)));
typedef unsigned v2u __attribute__((ext_vector_type(2)));
typedef float f32x4 __attribute__((ext_vector_type(4)));
typedef float f32x2 __attribute__((ext_vector_type(2)));
typedef short bf16x8 __attribute__((ext_vector_type(8)));
#define LDS_WAIT() asm volatile("s_waitcnt lgkmcnt(0)" ::: "memory")
#define VM_WAIT() asm volatile("s_waitcnt vmcnt(0)" ::: "memory")
__device__ __forceinline__ unsigned f2bf(float f) { unsigned u = __builtin_bit_cast(unsigned, f); return (u + 0x7fffu + ((u >> 16) & 1u)) >> 16; }
__device__ __forceinline__ unsigned pk2(float lo, float hi) { return f2bf(lo) | (f2bf(hi) << 16); }
__device__ __forceinline__ float bf_lo(unsigned w) { return __builtin_bit_cast(float, w << 16); }
__device__ __forceinline__ float bf_hi(unsigned w) { return __builtin_bit_cast(float, w & 0xffff0000u); }
__device__ __forceinline__ float fast_exp(float x) { return __builtin_amdgcn_exp2f(x * 1.4426950408889634f); }
__device__ __forceinline__ float fast_sigmoid(float x) { return __builtin_amdgcn_rcpf(1.0f + fast_exp(-x)); }
typedef __bf16 bf16x2_t __attribute__((ext_vector_type(2)));
__device__ __forceinline__ unsigned cvt_pk_bf16(float lo, float hi) { f32x2 v = {lo, hi}; bf16x2_t b = __builtin_convertvector(v, bf16x2_t); return __builtin_bit_cast(unsigned, b); }

namespace epi {
using pg8::Unit;
typedef pg8::f32x4 A4;
#define EPI_ACC const A4 (&acc)[2][2][4][2]

struct SwiGLU {
    static constexpr bool PERM = true, AFTER_DRAIN = false, KHOOK = false;
    bf16* O; const float* rstd;
    __device__ __forceinline__ void operator()(EPI_ACC, const Unit& u, int wr, int wc, int fr, int fq) const {
        const int row0 = u.pm * 256 + wr * 64 + fr, col0 = u.pn * 128 + wc * 32 + 8 * fq;
#pragma unroll
        for (int ai = 0; ai < 2; ++ai)
#pragma unroll
            for (int m = 0; m < 4; ++m) {
                const int row = row0 + ai * 128 + m * 16; const float rs = rstd[row];
                float o[8];
#pragma unroll
                for (int n = 0; n < 2; ++n)
#pragma unroll
                    for (int e = 0; e < 4; ++e) { const float g = acc[ai][0][m][n][e] * rs, up = acc[ai][1][m][n][e] * rs; o[n * 4 + e] = g * fast_sigmoid(g) * up; }
                v4u w; w.x = cvt_pk_bf16(o[0], o[1]); w.y = cvt_pk_bf16(o[2], o[3]); w.z = cvt_pk_bf16(o[4], o[5]); w.w = cvt_pk_bf16(o[6], o[7]);
                *(v4u*)(O + (size_t)row * DFF + col0) = w;
            }
    }
};

template <bool BASE_BF16, bool OUT_F32> struct Resid {
    static constexpr bool PERM = true, AFTER_DRAIN = false, KHOOK = false;
    const float* base_p; const float* base_s;
    float* out; bf16* xb; float* slots; float scale;
    __device__ __forceinline__ void row_op(const A4 (&v)[2][2], int row, int pn, int wc, int fq) const {
        const int colb = pn * 256 + wc * 32 + 8 * fq;
        bf16* xp = xb + (size_t)row * DM + colb;
        float ss = 0.f;
#pragma unroll
        for (int bj = 0; bj < 2; ++bj) {
            A4 b0, b1;
            if (BASE_BF16) { const v4u bw = *(const v4u*)(xp + bj * 128); b0 = (A4){bf_lo(bw.x), bf_hi(bw.x), bf_lo(bw.y), bf_hi(bw.y)}; b1 = (A4){bf_lo(bw.z), bf_hi(bw.z), bf_lo(bw.w), bf_hi(bw.w)}; }
            else { const float* bp = (row < NTP ? base_p : base_s) + (size_t)row * DM + colb; b0 = *(const A4*)(bp + bj * 128); b1 = *(const A4*)(bp + bj * 128 + 4); }
            const A4 v0 = b0 + v[bj][0] * scale, v1 = b1 + v[bj][1] * scale;
            if (OUT_F32) { float* op = out + (size_t)row * DM + colb; *(A4*)(op + bj * 128) = v0; *(A4*)(op + bj * 128 + 4) = v1; }
            else { v4u w; w.x = cvt_pk_bf16(v0[0], v0[1]); w.y = cvt_pk_bf16(v0[2], v0[3]); w.z = cvt_pk_bf16(v1[0], v1[1]); w.w = cvt_pk_bf16(v1[2], v1[3]); *(v4u*)(xp + bj * 128) = w; }
            ss += (v0[0] * v0[0] + v0[1] * v0[1]) + (v0[2] * v0[2] + v0[3] * v0[3]) + (v1[0] * v1[0] + v1[1] * v1[1]) + (v1[2] * v1[2] + v1[3] * v1[3]);
        }
        ss += __shfl_xor(ss, 16); ss += __shfl_xor(ss, 32);
        if (fq == 0) slots[(size_t)row * 64 + pn * 4 + wc] = ss;
    }
    __device__ __forceinline__ void operator()(EPI_ACC, const Unit& u, int wr, int wc, int fr, int fq) const {
        const int row0 = u.pm * 256 + wr * 64 + fr;
#pragma unroll
        for (int ai = 0; ai < 2; ++ai)
#pragma unroll
            for (int m = 0; m < 4; ++m) { const A4 v[2][2] = {{acc[ai][0][m][0], acc[ai][0][m][1]}, {acc[ai][1][m][0], acc[ai][1][m][1]}}; row_op(v, row0 + ai * 128 + m * 16, u.pn, wc, fq); }
    }
};

struct Win {
    static constexpr bool PERM = true, AFTER_DRAIN = false, KHOOK = false;
    bf16* pa; bf16* pb; bf16* q; bf16* gate; const float* rstd; float* shp; float* shs;
    template <bool SG> __device__ __forceinline__ void st16(EPI_ACC, bf16* O, int ld, int colb, float sc, int row0) const {
#pragma unroll
        for (int ai = 0; ai < 2; ++ai)
#pragma unroll
            for (int m = 0; m < 4; ++m) { const int row = row0 + ai * 128 + m * 16; const float rs = rstd[row] * sc; bf16* op = O + (size_t)row * ld + colb;
#pragma unroll
                for (int bj = 0; bj < 2; ++bj) { A4 v0 = acc[ai][bj][m][0] * rs, v1 = acc[ai][bj][m][1] * rs;
                    if (SG) {
#pragma unroll
                        for (int e = 0; e < 4; ++e) { v0[e] = fast_sigmoid(v0[e]); v1[e] = fast_sigmoid(v1[e]); } }
                    v4u w; w.x = cvt_pk_bf16(v0[0], v0[1]); w.y = cvt_pk_bf16(v0[2], v0[3]); w.z = cvt_pk_bf16(v1[0], v1[1]); w.w = cvt_pk_bf16(v1[2], v1[3]);
                    *(v4u*)(op + bj * 128) = w; } }
    }
    __device__ __forceinline__ void operator()(EPI_ACC, const Unit& u, int wr, int wc, int fr, int fq) const {
        const int row0 = u.pm * 256 + wr * 64 + fr, cw = wc * 32 + 8 * fq;
        if (u.pn < 26) {
            const int colb = u.pn * 256 + cw;
#pragma unroll
            for (int ai = 0; ai < 2; ++ai)
#pragma unroll
                for (int m = 0; m < 4; ++m) { const int row = row0 + ai * 128 + m * 16; const float rs = rstd[row]; bf16* op = pa + (size_t)row * PA_PAD + colb;
                    const bool last = row < NTP ? ((row & (SEQ - 1)) == SEQ - 1) : (((row - NTP) & (DSEQ - 1)) == DSEQ - 1);
                    float* sh = row < NTP ? shp + (size_t)(row >> 11) * PA : shs + (size_t)((row - NTP) >> 2) * PA;
#pragma unroll
                    for (int bj = 0; bj < 2; ++bj) { const A4 v0 = acc[ai][bj][m][0] * rs, v1 = acc[ai][bj][m][1] * rs;
                        v4u w; w.x = cvt_pk_bf16(v0[0], v0[1]); w.y = cvt_pk_bf16(v0[2], v0[3]); w.z = cvt_pk_bf16(v1[0], v1[1]); w.w = cvt_pk_bf16(v1[2], v1[3]);
                        *(v4u*)(op + bj * 128) = w;
                        if (last && colb + bj * 128 < PA) { *(A4*)(sh + colb + bj * 128) = v0; *(A4*)(sh + colb + bj * 128 + 4) = v1; } } }
        } else if (u.pn < 38) st16<false>(acc, pb, PBW, (u.pn - 26) * 256 + cw, 1.f, row0);
        else if (u.pn < 42) st16<false>(acc, q, PCW, (u.pn - 38) * 256 + cw, QSCALE, row0);
        else st16<true>(acc, gate, PGW, (u.pn - 42) * 256 + cw, 1.f, row0);
    }
};

struct MemKV {
    static constexpr bool PERM = true, AFTER_DRAIN = false, KHOOK = false;
    float* outk; float* outv; bf16* kb; bf16* vt; const float* rstd;
    __device__ __forceinline__ void operator()(EPI_ACC, const Unit& u, int wr, int wc, int fr, int fq) const {
        const int row0 = u.pm * 256 + wr * 64 + fr; const bool isv = u.pn >= 4; const int h = u.pn & 3; const int cw = wc * 32 + 8 * fq;
        float* of = isv ? outv : outk;
#pragma unroll
        for (int ai = 0; ai < 2; ++ai)
#pragma unroll
            for (int m = 0; m < 4; ++m) { const int row = row0 + ai * 128 + m * 16; const float rs = rstd[row];
                const int b = row >> 8, key = row & 255, kk = key & 31; const int pos = (key & ~31) + 8 * ((kk & 15) >> 2) + (kk & 3) + 4 * (kk >> 4);
#pragma unroll
                for (int bj = 0; bj < 2; ++bj) { const A4 v0 = acc[ai][bj][m][0] * rs, v1 = acc[ai][bj][m][1] * rs; const int d0 = bj * 128 + cw;
                    float* op = of + (size_t)row * 1024 + h * 256 + d0; *(A4*)op = v0; *(A4*)(op + 4) = v1;
                    if (!isv) { v4u w; w.x = cvt_pk_bf16(v0[0], v0[1]); w.y = cvt_pk_bf16(v0[2], v0[3]); w.z = cvt_pk_bf16(v1[0], v1[1]); w.w = cvt_pk_bf16(v1[2], v1[3]);
                        *(v4u*)(kb + (size_t)row * 1024 + h * 256 + d0) = w; }
                    else { bf16* vp = vt + ((size_t)(b * 4 + h) * 256 + d0) * 256 + pos;
#pragma unroll
                        for (int e = 0; e < 4; ++e) { vp[(size_t)e * 256] = (bf16)f2bf(v0[e]); vp[(size_t)(4 + e) * 256] = (bf16)f2bf(v1[e]); } }
                } }
    }
};

struct LoraWA {
    static constexpr bool PERM = true, AFTER_DRAIN = false, KHOOK = false;
    float* wdec; float* aval; const float* w0; const float* a0;
    template <bool ISA> __device__ __forceinline__ void run(EPI_ACC, float* O, const float* bias, int colb, int row0) const {
#pragma unroll
        for (int bj = 0; bj < 2; ++bj)
#pragma unroll
            for (int n = 0; n < 2; ++n) { const A4 bv = *(const A4*)(bias + colb + bj * 128 + 4 * n);
#pragma unroll
                for (int ai = 0; ai < 2; ++ai)
#pragma unroll
                    for (int m = 0; m < 4; ++m) { const int row = row0 + ai * 128 + m * 16; A4 v = acc[ai][bj][m][n] + bv;
#pragma unroll
                        for (int e = 0; e < 4; ++e) { const float x = v[e];
                            if (ISA) v[e] = fast_sigmoid(x);
                            else v[e] = fast_exp(-0.6065306597126334f * fast_sigmoid(x)); }
                        *(A4*)(O + (size_t)row * 2048 + colb + bj * 128 + 4 * n) = v; }
                asm volatile("" ::: "memory"); }
    }
    __device__ __forceinline__ void operator()(EPI_ACC, const Unit& u, int wr, int wc, int fr, int fq) const {
        const int row0 = u.pm * 256 + wr * 64 + fr; const int colb = (u.pn & 7) * 256 + wc * 32 + 8 * fq;
        if (u.pn >= 8) run<true>(acc, aval, a0, colb, row0); else run<false>(acc, wdec, w0, colb, row0);
    }
};
struct LoraG {
    static constexpr bool PERM = true, AFTER_DRAIN = false, KHOOK = false;
    bf16* O;
    __device__ __forceinline__ void operator()(EPI_ACC, const Unit& u, int wr, int wc, int fr, int fq) const {
        const int row0 = u.pm * 256 + wr * 64 + fr, colb = u.pn * 256 + wc * 32 + 8 * fq;
#pragma unroll
        for (int ai = 0; ai < 2; ++ai)
#pragma unroll
            for (int m = 0; m < 4; ++m) { const int row = row0 + ai * 128 + m * 16; bf16* op = O + (size_t)row * 2048 + colb;
#pragma unroll
                for (int bj = 0; bj < 2; ++bj) { const A4 v0 = acc[ai][bj][m][0], v1 = acc[ai][bj][m][1];
                    v4u w; w.x = cvt_pk_bf16(v0[0], v0[1]); w.y = cvt_pk_bf16(v0[2], v0[3]); w.z = cvt_pk_bf16(v1[0], v1[1]); w.w = cvt_pk_bf16(v1[2], v1[3]);
                    *(v4u*)(op + bj * 128) = w; } }
    }
};
struct GateCat {
    static constexpr bool PERM = true, AFTER_DRAIN = false, KHOOK = true;
    const bf16* gate; bf16* mrg;
    __device__ __forceinline__ static void unpack8(const v4u w, float (&g)[8]) { g[0] = bf_lo(w.x); g[1] = bf_hi(w.x); g[2] = bf_lo(w.y); g[3] = bf_hi(w.y); g[4] = bf_lo(w.z); g[5] = bf_hi(w.z); g[6] = bf_lo(w.w); g[7] = bf_hi(w.w); }
    template <int MODE> __device__ __forceinline__ void scale(A4 (&acc)[2][2][4][2], const Unit& u, int seg, int wr, int wc, int fr, int fq) const {
        const int row0 = u.pm * 256 + wr * 64 + fr, colb = u.pn * 256 + wc * 32 + 8 * fq;
#pragma unroll
        for (int ai = 0; ai < 2; ++ai)
#pragma unroll
            for (int m = 0; m < 4; ++m) { const bf16* gp = gate + (size_t)(row0 + ai * 128 + m * 16) * PGW + seg * DM + colb;
#pragma unroll
                for (int bj = 0; bj < 2; ++bj) { float g[8]; unpack8(*(const v4u*)(gp + bj * 128), g);
                    if (MODE == 1) { float h[8]; unpack8(*(const v4u*)(gp + DM + bj * 128), h);
#pragma unroll
                        for (int e = 0; e < 8; ++e) g[e] *= __builtin_amdgcn_rcpf(fmaxf(h[e], 1e-30f)); }
#pragma unroll
                    for (int e = 0; e < 4; ++e) { acc[ai][bj][m][0][e] *= g[e]; acc[ai][bj][m][1][e] *= g[4 + e]; } }
                asm volatile("" ::: "memory"); }
    }
    __device__ __forceinline__ void khook(A4 (&acc)[2][2][4][2], const Unit& u, int kt, int wr, int wc, int fr, int fq) const { scale<1>(acc, u, kt == 32 ? 0 : 1, wr, wc, fr, fq); }
    __device__ __forceinline__ void pre_slab(A4 (&acc)[2][2][4][2], const Unit& u, int wr, int wc, int fr, int fq) const { scale<0>(acc, u, u.kt0 < 32 ? 0 : (u.kt0 < 48 ? 1 : 2), wr, wc, fr, fq); }
    __device__ __forceinline__ void row_op(const A4 (&v)[2][2], int row, int pn, int wc, int fq) const {
        bf16* op = mrg + (size_t)row * DM + pn * 256 + wc * 32 + 8 * fq;
#pragma unroll
        for (int bj = 0; bj < 2; ++bj) { v4u w; w.x = cvt_pk_bf16(v[bj][0][0], v[bj][0][1]); w.y = cvt_pk_bf16(v[bj][0][2], v[bj][0][3]); w.z = cvt_pk_bf16(v[bj][1][0], v[bj][1][1]); w.w = cvt_pk_bf16(v[bj][1][2], v[bj][1][3]);
            *(v4u*)(op + bj * 128) = w; }
    }
    __device__ __forceinline__ void operator()(EPI_ACC, const Unit& u, int wr, int wc, int fr, int fq) const {
        const int row0 = u.pm * 256 + wr * 64 + fr, colb = u.pn * 256 + wc * 32 + 8 * fq;
#pragma unroll
        for (int ai = 0; ai < 2; ++ai)
#pragma unroll
            for (int m = 0; m < 4; ++m) { const int row = row0 + ai * 128 + m * 16; const bf16* gp = gate + (size_t)row * PGW + 2 * DM + colb; A4 v[2][2];
#pragma unroll
                for (int bj = 0; bj < 2; ++bj) { float g[8]; unpack8(*(const v4u*)(gp + bj * 128), g);
#pragma unroll
                    for (int e = 0; e < 4; ++e) { v[bj][0][e] = acc[ai][bj][m][0][e] * g[e]; v[bj][1][e] = acc[ai][bj][m][1][e] * g[4 + e]; } }
                row_op(v, row, u.pn, wc, fq); }
    }
};
#undef EPI_ACC
}

#define XB_TMO      128
#define XB_XCNT(j)  (256  + 64 * (j))
#define XB_XSUB(j)  (1280 + 64 * (j))
#define XB_XGEN(j)  (2304 + 64 * (j))
#define XB_TOP      3328
#define XB_TOPGEN   3392
#define XCD_BAR_WORDS 3456
#define XB_SPIN_CAP (1u << 18)

__device__ __forceinline__ unsigned xb_ld(unsigned* p)              { return __hip_atomic_load(p, __ATOMIC_RELAXED, __HIP_MEMORY_SCOPE_AGENT); }
__device__ __forceinline__ unsigned xb_add(unsigned* p, unsigned v) { return __hip_atomic_fetch_add(p, v, __ATOMIC_RELAXED, __HIP_MEMORY_SCOPE_AGENT); }
__device__ __forceinline__ unsigned xb_xcc_id() { return (unsigned)__builtin_amdgcn_s_getreg((3 << 11) | 20) & 0xFu; }
#define XB_SPIN(cond, bar) do { unsigned _sp = 0; while (cond) { __builtin_amdgcn_s_sleep(1); \
    if ((++_sp & 255u) == 0u) { if (xb_ld(&(bar)[XB_TMO])) break; if (_sp > XB_SPIN_CAP) { atomicAdd(&(bar)[XB_TMO], 1u); break; } } } } while (0)

struct XcdBarrier {
    unsigned* bar; unsigned x;
    volatile LAS unsigned* st;
};

__device__ __forceinline__ XcdBarrier xcd_barrier_post(unsigned* bar, volatile LAS unsigned* st) {
    XcdBarrier b; b.bar = bar; b.x = xb_xcc_id(); b.st = st;
    if (threadIdx.x == 0) (void)xb_add(&bar[XB_XCNT(b.x)], 1u);
    return b;
}
__device__ __forceinline__ void xcd_barrier_complete(unsigned* bar, unsigned x, unsigned& nloc, unsigned& nx) {
    const unsigned G = gridDim.x * gridDim.y * gridDim.z;
    unsigned sum, cnt, mine, sp = 0u;
    for (;;) {
        sum = 0u; cnt = 0u; mine = 0u;
#pragma unroll
        for (unsigned j = 0; j < 16; ++j) { const unsigned c = xb_ld(&bar[XB_XCNT(j)]); sum += c; cnt += (c > 0u) ? 1u : 0u; mine = (j == x) ? c : mine; }
        if (sum == G) break;
        __builtin_amdgcn_s_sleep(1);
        if ((++sp & 255u) == 0u) { if (xb_ld(&bar[XB_TMO])) break; if (sp > XB_SPIN_CAP) { atomicAdd(&bar[XB_TMO], 1u); break; } }
    }
    nloc = mine > 0u ? mine : 1u; nx = cnt > 0u ? cnt : 1u;
}

__device__ __forceinline__ void xcd_barrier(const XcdBarrier& b) {
    asm volatile("s_waitcnt vmcnt(0)" ::: "memory");
    __syncthreads();
    if (threadIdx.x == 0) {
        unsigned* bar = b.bar;
        __builtin_amdgcn_s_waitcnt(0);
        unsigned nloc = b.st[0], nx = b.st[1];
        if (nloc == 0u) { xcd_barrier_complete(bar, b.x, nloc, nx); b.st[0] = nloc; b.st[1] = nx; }
        const unsigned old = xb_add(&bar[XB_XSUB(b.x)], 1u);
        const unsigned gen = old / nloc;
        if (old + 1u == (gen + 1u) * nloc) {
            __builtin_amdgcn_fence(__ATOMIC_RELEASE, "agent");
            asm volatile("s_waitcnt vmcnt(0)" ::: "memory");
            const unsigned og = xb_add(&bar[XB_TOP], 1u);
            const unsigned tg = og / nx;
            if (og + 1u == (tg + 1u) * nx) xb_add(&bar[XB_TOPGEN], 1u);
            else XB_SPIN(xb_ld(&bar[XB_TOPGEN]) == tg, bar);
            __builtin_amdgcn_fence(__ATOMIC_ACQUIRE, "agent");
            xb_add(&bar[XB_XGEN(b.x)], 1u);
            asm volatile("s_waitcnt vmcnt(0)" ::: "memory");
        } else {
            XB_SPIN(xb_ld(&bar[XB_XGEN(b.x)]) == gen, bar);
            __builtin_amdgcn_fence(__ATOMIC_ACQUIRE, "agent");
            asm volatile("s_waitcnt vmcnt(0)" ::: "memory");
        }
    }
    __syncthreads();
}

struct Args {
    const float* in[35];
    float* out; unsigned char* ws;
    int ph_lo, ph_hi, li, pad;
};
enum In { I_XP = 0, I_XS, I_MEM, I_CK, I_CV, I_SRW, I_SSH, I_SCV, I_GF1, I_WF1I, I_WF1O, I_GMIX, I_WIN, I_MU, I_W0, I_WLU, I_A0, I_ALU, I_GLU, I_KK, I_KA, I_RK, I_LNW, I_LNB, I_CW, I_GMEM, I_WMKV,
          I_WBA, I_WBB, I_WBC, I_WOUT, I_GF2, I_WF2I, I_WF2O, I_GFIN };

struct Ctx { LAS unsigned char* lds; int tid, lane, wave, G, vcu, gw, NGW; };

__device__ __forceinline__ float wave_sum(float v) {
#pragma unroll
    for (int o = 1; o < 64; o <<= 1) v += __shfl_xor(v, o);
    return v;
}
__device__ __forceinline__ float oct_sum(float v) { v += __shfl_xor(v, 1); v += __shfl_xor(v, 2); v += __shfl_xor(v, 4); return v; }

__device__ __forceinline__ void cvt_item(const float* W, int N, const float* gk, bf16* WT, int Kd, int k0, int n0, int drow0, LAS float* scr, int lane) {
    f32x4 v[16];
    const int r4 = lane >> 4, c4 = 4 * (lane & 15);
#pragma unroll
    for (int i = 0; i < 16; ++i) v[i] = *(const f32x4*)(W + (size_t)(k0 + 4 * i + r4) * N + n0 + c4);
    if (gk) {
#pragma unroll
        for (int i = 0; i < 16; ++i) { const float s = gk[k0 + 4 * i + r4]; v[i] = v[i] * s; } }
#pragma unroll
    for (int i = 0; i < 16; ++i) { LAS float* p = scr + (4 * i + r4) * 65 + c4; p[0] = v[i].x; p[1] = v[i].y; p[2] = v[i].z; p[3] = v[i].w; }
    LDS_WAIT(); asm volatile("" ::: "memory");
    const int c = lane & 7;
#pragma unroll
    for (int j = 0; j < 8; ++j) { const int n = (lane >> 3) + 8 * j; const LAS float* s = scr + (8 * c) * 65 + n;
        v4u o; o.x = cvt_pk_bf16(s[0 * 65], s[1 * 65]); o.y = cvt_pk_bf16(s[2 * 65], s[3 * 65]); o.z = cvt_pk_bf16(s[4 * 65], s[5 * 65]); o.w = cvt_pk_bf16(s[6 * 65], s[7 * 65]);
        *(v4u*)(WT + (size_t)(drow0 + n) * Kd + k0 + 8 * c) = o; }
    LDS_WAIT(); asm volatile("" ::: "memory");
}
constexpr int W1B_EARLY = 4096;
template <int MAP> __device__ __forceinline__ void cvt_matrix(const Ctx& C, const float* W, int K, int N, const float* gk, bf16* WT, int& base, int Kd = 0, int it_lo = 0, int it_hi = -1) {
    if (Kd == 0) Kd = K;
    const int nblk = N / 64, nall = (K / 64) * nblk, nitems = it_hi < 0 ? nall : it_hi; LAS float* scr = (LAS float*)(C.lds + C.wave * 16640);
    int first = it_lo + (C.gw - base % C.NGW + C.NGW) % C.NGW;
    for (int it = first; it < nitems; it += C.NGW) {
        const int kb = it / nblk, nb = it % nblk, n0 = 64 * nb; int d;
        if (MAP == 1) { const int j = n0 < DFF ? n0 : n0 - DFF; d = 256 * (j >> 7) + (j & 127) + (n0 < DFF ? 0 : 128); }
        else if (MAP == 2) d = n0 + (n0 >= PA ? 64 : 0);
        else d = n0;
        cvt_item(W, N, gk, WT, Kd, 64 * kb, n0, d, scr, C.lane);
    }
    base += nitems - it_lo;
}
__device__ __forceinline__ void row_to_bf16(const float* xrow, bf16* orow, float* rstd_out, int lane) {
    const f32x4* xr = (const f32x4*)xrow + lane; f32x4 v[16]; float s = 0.f;
#pragma unroll
    for (int j = 0; j < 16; ++j) { v[j] = xr[64 * j]; s += (v[j].x * v[j].x + v[j].y * v[j].y) + (v[j].z * v[j].z + v[j].w * v[j].w); }
    s = wave_sum(s);
    v2u* o8 = (v2u*)orow + lane;
#pragma unroll
    for (int j = 0; j < 16; ++j) { v2u w; w.x = cvt_pk_bf16(v[j].x, v[j].y); w.y = cvt_pk_bf16(v[j].z, v[j].w); o8[64 * j] = w; }
    if (lane == 0) *rstd_out = 1.0f / sqrtf(s * (1.0f / DM) + EPS);
}
__device__ __forceinline__ void p0_prologue(const Ctx& C, const Args& a) {
    unsigned char* ws = a.ws; int base = 0;
    cvt_matrix<1>(C, a.in[I_WF1I], DM, 2 * DFF, a.in[I_GF1], (bf16*)(ws + WS_W1A), base);
    cvt_matrix<0>(C, a.in[I_WMKV], DM, 2048, a.in[I_GMEM], (bf16*)(ws + WS_WMEM), base);
    cvt_matrix<0>(C, a.in[I_WF1O], DFF, DM, nullptr, (bf16*)(ws + WS_W1B), base, 0, 0, W1B_EARLY);
    { bf16* wl = (bf16*)(ws + WS_WLWA); bf16* wg = (bf16*)(ws + WS_WLG); const float* wu = a.in[I_WLU]; const float* au = a.in[I_ALU]; const float* gu = a.in[I_GLU];
      for (int i = C.gw * 64 + C.lane; i < 6144 * 32; i += C.NGW * 64) { const int n = i % 6144, k0 = 8 * (i / 6144); float f[8];
#pragma unroll
          for (int e = 0; e < 8; ++e) { const int k = k0 + e; float x = 0.f;
              if (n < 2048) { if (k < 96) x = wu[(size_t)k * 2048 + n]; }
              else if (n < 4096) { if (k >= 128 && k < 224) x = au[(size_t)(k - 128) * 2048 + (n - 2048)]; }
              else x = gu[(size_t)k * 2048 + (n - 4096)];
              f[e] = x; }
          v4u o; o.x = pk2(f[0], f[1]); o.y = pk2(f[2], f[3]); o.z = pk2(f[4], f[5]); o.w = pk2(f[6], f[7]);
          bf16* dst = n < 4096 ? wl + (size_t)n * 256 + k0 : wg + (size_t)(n - 4096) * 256 + k0;
          *(v4u*)dst = o; } }
    for (int m = C.gw; m < MTOK + 1024; m += C.NGW) {
        if (m < MTOK) { const float* xr = m < NTP ? a.in[I_XP] + (size_t)m * DM : a.in[I_XS] + (size_t)(m - NTP) * DM;
            row_to_bf16(xr, (bf16*)(ws + WS_XB) + (size_t)m * DM, (float*)(ws + WS_RSTD0) + m, C.lane); }
        else { const int r = m - MTOK; row_to_bf16(a.in[I_MEM] + (size_t)r * DM, (bf16*)(ws + WS_MEMB) + (size_t)r * DM, (float*)(ws + WS_RSTDM) + r, C.lane); }
    }
}
__device__ __forceinline__ void late_weights(const Ctx& C2, const Args& a) {
    unsigned char* ws = a.ws; int base = 0;
    cvt_matrix<0>(C2, a.in[I_WBA], 2048, DM, nullptr, (bf16*)(ws + WS_WBRA), base, DM);
    cvt_matrix<0>(C2, a.in[I_WBB], 1024, DM, nullptr, (bf16*)(ws + WS_WBRA) + 2048, base, DM);
    cvt_matrix<0>(C2, a.in[I_WBC], 1024, DM, nullptr, (bf16*)(ws + WS_WBRA) + 3072, base, DM);
    cvt_matrix<0>(C2, a.in[I_WOUT], DM, DM, nullptr, (bf16*)(ws + WS_WOUT), base);
    cvt_matrix<1>(C2, a.in[I_WF2I], DM, 2 * DFF, a.in[I_GF2], (bf16*)(ws + WS_W2A), base);
}
__device__ __forceinline__ void win_weights(const Ctx& C, const Args& a) {
    unsigned char* ws = a.ws; int base = 0;
    cvt_matrix<2>(C, a.in[I_WIN], DM, PIN, a.in[I_GMIX], (bf16*)(ws + WS_WIN), base);
    { v4u z = {0u, 0u, 0u, 0u}; v4u* p = (v4u*)((bf16*)(ws + WS_WIN) + (size_t)PA * DM);
      for (int i = C.gw * 64 + C.lane; i < 64 * DM / 8; i += C.NGW * 64) p[i] = z; }
}
__device__ __forceinline__ void rstd_phase(const Ctx& C, const float* slots, float* rstd) {
    for (int m = C.gw; m < MTOK; m += C.NGW) { const float s = wave_sum(slots[(size_t)m * 64 + C.lane]); if (C.lane == 0) rstd[m] = 1.0f / sqrtf(s * (1.0f / DM) + EPS); }
}
__device__ __forceinline__ void final_norm(const Ctx& C, const Args& a) {
    const float* slots = (const float*)(a.ws + WS_SLOT); const f32x4* gf = (const f32x4*)a.in[I_GFIN]; const bf16* xb = (const bf16*)(a.ws + WS_XB);
    for (int m = C.gw; m < MTOK; m += C.NGW) {
        const float s = wave_sum(slots[(size_t)m * 64 + C.lane]); const float rs = 1.0f / sqrtf(s * (1.0f / DM) + EPS);
        const v4u* xr = (const v4u*)(xb + (size_t)m * DM) + C.lane; f32x4* yr = (f32x4*)(a.out + O_Y + (size_t)m * DM);
#pragma unroll
        for (int j = 0; j < 8; ++j) { const v4u w = xr[64 * j]; const int c4 = (64 * j + C.lane) * 2;
            const f32x4 g0 = gf[c4], g1 = gf[c4 + 1];
            yr[c4] = (f32x4){bf_lo(w.x), bf_hi(w.x), bf_lo(w.y), bf_hi(w.y)} * rs * g0; yr[c4 + 1] = (f32x4){bf_lo(w.z), bf_hi(w.z), bf_lo(w.w), bf_hi(w.w)} * rs * g1; }
    }
}

__device__ __forceinline__ void ld8(const float* p, float (&f)[8]) { const f32x4 x = *(const f32x4*)p, y = *(const f32x4*)(p + 4); f[0] = x.x; f[1] = x.y; f[2] = x.z; f[3] = x.w; f[4] = y.x; f[5] = y.y; f[6] = y.z; f[7] = y.w; }
__device__ __forceinline__ void ld8b(const bf16* p, float (&f)[8]) { const v4u w = *(const v4u*)p; f[0] = bf_lo(w.x); f[1] = bf_hi(w.x); f[2] = bf_lo(w.y); f[3] = bf_hi(w.y); f[4] = bf_lo(w.z); f[5] = bf_hi(w.z); f[6] = bf_lo(w.w); f[7] = bf_hi(w.w); }
__device__ __forceinline__ void r1_phase(const Ctx& C, const Args& a) {
    const bf16* pa = (const bf16*)(a.ws + WS_PAF); bf16* lin = (bf16*)(a.ws + WS_LIN); const float* mu = a.in[I_MU];
    const int o = 8 * C.lane; int src = -1, mode = 0;
    if (o < 96) { src = 6144 + o; mode = 0; } else if (o < 128) src = -1; else if (o < 224) { src = 6240 + (o - 128); mode = 1; } else if (o < 256) src = -1; else { src = 6336 + (o - 256); mode = 2; }
    for (int m = C.gw; m < MTOK; m += C.NGW) {
        const int t = m < NTP ? (m & (SEQ - 1)) : ((m - NTP) & (DSEQ - 1)); const bf16* cur = pa + (size_t)m * PA_PAD;
        float f[8];
#pragma unroll
        for (int e = 0; e < 8; ++e) f[e] = 0.f;
        if (src >= 0) { float c[8], p[8], u[8]; ld8b(cur + src, c); ld8(mu + src, u);
            if (t) ld8b(cur - PA_PAD + src, p); else if (m >= NTP) ld8(a.in[I_SSH] + (size_t)((m - NTP) >> 2) * PA + src, p); else {
#pragma unroll
                for (int e = 0; e < 8; ++e) p[e] = 0.f; }
#pragma unroll
            for (int e = 0; e < 8; ++e) { const float x = c[e] + (p[e] - c[e]) * u[e]; f[e] = mode == 0 ? (1.0f - 2.0f * __builtin_amdgcn_rcpf(1.0f + fast_exp(2.0f * x))) : (mode == 2 ? fast_sigmoid(x) : x); } }
        v4u w; w.x = pk2(f[0], f[1]); w.y = pk2(f[2], f[3]); w.z = pk2(f[4], f[5]); w.w = pk2(f[6], f[7]);
        *(v4u*)(lin + (size_t)m * 512 + o) = w;
    }
}
__device__ __forceinline__ void ldu16(const bf16* row, int c0, float (&u)[16]) {
    const v4u g0 = *(const v4u*)(row + 1024 + c0), g1 = *(const v4u*)(row + 1024 + c0 + 8), u0 = *(const v4u*)(row + 2048 + c0), u1 = *(const v4u*)(row + 2048 + c0 + 8);
    const unsigned gw[8] = {g0.x, g0.y, g0.z, g0.w, g1.x, g1.y, g1.z, g1.w}, uw[8] = {u0.x, u0.y, u0.z, u0.w, u1.x, u1.y, u1.z, u1.w};
#pragma unroll
    for (int i = 0; i < 8; ++i) { u[2 * i] = bf_lo(gw[i]) * bf_lo(uw[i]); u[2 * i + 1] = bf_hi(gw[i]) * bf_hi(uw[i]); }
}
__device__ __forceinline__ void ldf16(const float* p, float (&u)[16]) {
#pragma unroll
    for (int i = 0; i < 4; ++i) { const f32x4 x = *(const f32x4*)(p + 4 * i); u[4 * i] = x.x; u[4 * i + 1] = x.y; u[4 * i + 2] = x.z; u[4 * i + 3] = x.w; }
}
__device__ __forceinline__ void conv_phase(const Args& a, int w, int nw, int lane) {
    const bf16* pb = (const bf16*)(a.ws + WS_PB); bf16* yb = (bf16*)(a.ws + WS_YA) + 2048; const float* cw = a.in[I_CW]; const int c0 = 16 * lane;
    float w0[16], w1[16], w2[16]; ldf16(cw + c0, w0); ldf16(cw + 1024 + c0, w1); ldf16(cw + 2048 + c0, w2);
    for (int m = w; m < MTOK; m += nw) {
        const bool smp = m >= NTP; const int t = smp ? ((m - NTP) & 3) : (m & (SEQ - 1)); const int T = smp ? DSEQ : SEQ;
        const float* buf = smp ? a.in[I_SCV] + (size_t)((m - NTP) >> 2) * 2048 : nullptr;
        const bf16* row = pb + (size_t)m * PBW;
        float u0[16], u1[16], u2[16];
        ldu16(row, c0, u0);
        if (t >= 1) ldu16(row - PBW, c0, u1); else if (smp) ldf16(buf + 1024 + c0, u1); else {
#pragma unroll
            for (int i = 0; i < 16; ++i) u1[i] = 0.f; }
        if (t >= 2) ldu16(row - 2 * PBW, c0, u2); else if (smp) ldf16(buf + (size_t)t * 1024 + c0, u2); else {
#pragma unroll
            for (int i = 0; i < 16; ++i) u2[i] = 0.f; }
        const v4u b0 = *(const v4u*)(row + c0), b1 = *(const v4u*)(row + c0 + 8); const unsigned bw[8] = {b0.x, b0.y, b0.z, b0.w, b1.x, b1.y, b1.z, b1.w};
        unsigned ow[8];
#pragma unroll
        for (int i = 0; i < 8; ++i) { const float z0 = u2[2 * i] * w0[2 * i] + u1[2 * i] * w1[2 * i] + u0[2 * i] * w2[2 * i], z1 = u2[2 * i + 1] * w0[2 * i + 1] + u1[2 * i + 1] * w1[2 * i + 1] + u0[2 * i + 1] * w2[2 * i + 1];
            ow[i] = pk2(bf_lo(bw[i]) * z0, bf_hi(bw[i]) * z1); }
        v4u o0 = {ow[0], ow[1], ow[2], ow[3]}, o1 = {ow[4], ow[5], ow[6], ow[7]};
        *(v4u*)(yb + (size_t)m * DM + c0) = o0; *(v4u*)(yb + (size_t)m * DM + c0 + 8) = o1;
        if (t >= T - 2) { float* dst = (smp ? a.out + O_CVS + (size_t)((m - NTP) >> 2) * 2048 : a.out + O_CVP + (size_t)(m >> 11) * 2048) + (size_t)(t - (T - 2)) * 1024 + c0;
#pragma unroll
            for (int i = 0; i < 4; ++i) *(f32x4*)(dst + 4 * i) = (f32x4){u0[4 * i], u0[4 * i + 1], u0[4 * i + 2], u0[4 * i + 3]}; }
    }
}

template <int CTRL> __device__ __forceinline__ float dpp_mov(float v) { return __builtin_bit_cast(float, __builtin_amdgcn_update_dpp(0, __builtin_bit_cast(int, v), CTRL, 0xf, 0xf, false)); }
__device__ __forceinline__ float oct_sum_dpp(float v) { v += dpp_mov<0xB1>(v); v += dpp_mov<0x4E>(v); v += dpp_mov<0x141>(v); return v; }
constexpr int TC = 16, STG = 6 * TC * 64;
template <int CTRL> __device__ __forceinline__ float dpp_add(float v) { return v + dpp_mov<CTRL>(v); }
__device__ __forceinline__ float row16_sum(float v) { v = dpp_add<0xB1>(v); v = dpp_add<0x4E>(v); v = dpp_add<0x141>(v); v = dpp_add<0x140>(v); return v; }
struct StageRegs { f32x4 cr, ck, cv, pr, pk, pv, la, lw; v2u g; };
struct StagePar { f32x4 mur, muk, muv, kkp, kap, rkp; };
__device__ __forceinline__ f32x4 ld4b(const bf16* p) { const v2u w = *(const v2u*)p; return (f32x4){bf_lo(w.x), bf_hi(w.x), bf_lo(w.y), bf_hi(w.y)}; }
__device__ __forceinline__ void stage_load(StageRegs& R, const Args& a, const float* shift_prev, int tok0, int tl, int T, int cj) {
    const f32x4 z = {0.f, 0.f, 0.f, 0.f};
    if (tl < T) {
        const int tok = tok0 + tl; const bf16* P = (const bf16*)(a.ws + WS_PAF) + (size_t)tok * PA_PAD + cj;
        R.cr = ld4b(P); R.ck = ld4b(P + 2048); R.cv = ld4b(P + 4096);
        if (tl > 0) { const bf16* Q = P - PA_PAD; R.pr = ld4b(Q); R.pk = ld4b(Q + 2048); R.pv = ld4b(Q + 4096); }
        else if (shift_prev) { const float* Q = shift_prev + cj; R.pr = *(const f32x4*)Q; R.pk = *(const f32x4*)(Q + 2048); R.pv = *(const f32x4*)(Q + 4096); }
        else { R.pr = z; R.pk = z; R.pv = z; }
        R.la = *(const f32x4*)((const float*)(a.ws + WS_AVAL) + (size_t)tok * 2048 + cj); R.lw = *(const f32x4*)((const float*)(a.ws + WS_WDEC) + (size_t)tok * 2048 + cj);
        R.g = *(const v2u*)((const bf16*)(a.ws + WS_G) + (size_t)tok * 2048 + cj);
    } else { R.cr = z; R.ck = z; R.cv = z; R.pr = z; R.pk = z; R.pv = z; R.la = z; R.lw = z; R.g = (v2u){0u, 0u}; }
}
__device__ __forceinline__ float sum4(const f32x4 v) { return (v.x + v.y) + (v.z + v.w); }
__device__ __forceinline__ float stage_store(const StageRegs& R, LAS float* B, LAS float* BRK, int st, int cq, const StagePar& P) {
    const f32x4 rs = R.cr + (R.pr - R.cr) * P.mur, ks = R.ck + (R.pk - R.ck) * P.muk, vs = R.cv + (R.pv - R.cv) * P.muv;
    const f32x4 kr_ = ks * P.kkp, kp = ks * (1.0f + (R.la - 1.0f) * P.kap);
    const float ss = row16_sum(sum4(kr_ * kr_));
    const float inv = 1.0f / fmaxf(sqrtf(ss), 1e-12f);
    const f32x4 kk = kr_ * inv, bv = kk * R.la;
    const float br = row16_sum(sum4(bv * rs)), kr = row16_sum(sum4(kp * rs)), rk = row16_sum(sum4(rs * kp * P.rkp));
    LAS float* p = B + st * 64 + 4 * cq;
    *(LAS f32x4*)(p) = -kk; *(LAS f32x4*)(p + TC * 64) = R.lw; *(LAS f32x4*)(p + 2 * TC * 64) = bv; *(LAS f32x4*)(p + 3 * TC * 64) = kp; *(LAS f32x4*)(p + 4 * TC * 64) = R.lw * rs; *(LAS f32x4*)(p + 5 * TC * 64) = vs;
    if (cq == 0) *(LAS f32x2*)(BRK + st * 2) = (f32x2){br, kr};
    return rk;
}
struct Carry { float rk; v2u g; };
__device__ __forceinline__ void post_store(const LAS float* yv, const LAS float* vv, const Carry& cy, const f32x4 lnw, const f32x4 lnb, bf16* dst) {
    f32x4 y = *(const LAS f32x4*)yv; const f32x4 v = *(const LAS f32x4*)vv;
    const float mean = row16_sum(sum4(y)) * (1.0f / 64.0f); y = y - mean;
    const float rs = 1.0f / sqrtf(row16_sum(sum4(y * y)) * (1.0f / 64.0f) + GN_EPS);
    const f32x4 g = {bf_lo(cy.g.x), bf_hi(cy.g.x), bf_lo(cy.g.y), bf_hi(cy.g.y)};
    const f32x4 o = (y * rs * lnw + lnb + v * cy.rk) * g;
    v2u w; w.x = cvt_pk_bf16(o.x, o.y); w.y = cvt_pk_bf16(o.z, o.w);
    *(v2u*)dst = w;
}
__device__ __forceinline__ void row8_sum4(float& a0, float& a1, float& a2, float& a3) {
#define R8_OP(n, ctl) "v_add_f32_dpp %" #n ", %" #n ", %" #n " " ctl " row_mask:0xf bank_mask:0xf bound_ctrl:1\n\t"
#define R8_STAGE(ctl) R8_OP(0, ctl) R8_OP(1, ctl) R8_OP(2, ctl) R8_OP(3, ctl)
    asm volatile("s_nop 1\n\t" R8_STAGE("quad_perm:[1,0,3,2]") R8_STAGE("quad_perm:[2,3,0,1]") R8_STAGE("row_half_mirror") "s_nop 1"
        : "+v"(a0), "+v"(a1), "+v"(a2), "+v"(a3));
#undef R8_STAGE
#undef R8_OP
}
struct StepOps { f32x4 a[2], w[2], b[2], k[2], r[2]; f32x2 v, brk; };
__device__ __forceinline__ void step_load(StepOps& o, const LAS float* bt, const LAS float* vt, const LAS float* brk) {
#pragma unroll
    for (int j = 0; j < 2; ++j) { o.a[j] = *(const LAS f32x4*)(bt + 4 * j); o.w[j] = *(const LAS f32x4*)(bt + TC * 64 + 4 * j); o.b[j] = *(const LAS f32x4*)(bt + 2 * TC * 64 + 4 * j); o.k[j] = *(const LAS f32x4*)(bt + 3 * TC * 64 + 4 * j); o.r[j] = *(const LAS f32x4*)(bt + 4 * TC * 64 + 4 * j); }
    o.v = *(const LAS f32x2*)vt; o.brk = *(const LAS f32x2*)brk;
}
__device__ __forceinline__ f32x2 lo2(const f32x4 v) { return (f32x2){v.x, v.y}; }
__device__ __forceinline__ f32x2 hi2(const f32x4 v) { return (f32x2){v.z, v.w}; }
#define PKB0 "op_sel:[0,0,0] op_sel_hi:[1,0,1]"
#define PKB1 "op_sel:[0,1,0] op_sel_hi:[1,1,1]"
__device__ __forceinline__ void blk_partials(const f32x2 (&S)[8], const f32x2 (&a2)[4], const f32x2 (&r2)[4], f32x2& s, f32x2& y) {
    f32x2 s1, y1;
    asm("v_pk_mul_f32 %0, %4, %12 op_sel:[0,0] op_sel_hi:[1,0]\n\tv_pk_mul_f32 %1, %8, %14 op_sel:[0,0] op_sel_hi:[1,0]\n\t"
        "v_pk_mul_f32 %2, %4, %16 op_sel:[0,0] op_sel_hi:[1,0]\n\tv_pk_mul_f32 %3, %8, %18 op_sel:[0,0] op_sel_hi:[1,0]\n\t"
        "v_pk_fma_f32 %0, %5, %12, %0 " PKB1 "\n\tv_pk_fma_f32 %1, %9, %14, %1 " PKB1 "\n\tv_pk_fma_f32 %2, %5, %16, %2 " PKB1 "\n\tv_pk_fma_f32 %3, %9, %18, %3 " PKB1 "\n\t"
        "v_pk_fma_f32 %0, %6, %13, %0 " PKB0 "\n\tv_pk_fma_f32 %1, %10, %15, %1 " PKB0 "\n\tv_pk_fma_f32 %2, %6, %17, %2 " PKB0 "\n\tv_pk_fma_f32 %3, %10, %19, %3 " PKB0 "\n\t"
        "v_pk_fma_f32 %0, %7, %13, %0 " PKB1 "\n\tv_pk_fma_f32 %1, %11, %15, %1 " PKB1 "\n\tv_pk_fma_f32 %2, %7, %17, %2 " PKB1 "\n\tv_pk_fma_f32 %3, %11, %19, %3 " PKB1 "\n\t"
        "v_pk_add_f32 %0, %0, %1\n\tv_pk_add_f32 %2, %2, %3"
        : "=&v"(s), "=&v"(s1), "=&v"(y), "=&v"(y1)
        : "v"(S[0]), "v"(S[1]), "v"(S[2]), "v"(S[3]), "v"(S[4]), "v"(S[5]), "v"(S[6]), "v"(S[7]), "v"(a2[0]), "v"(a2[1]), "v"(a2[2]), "v"(a2[3]), "v"(r2[0]), "v"(r2[1]), "v"(r2[2]), "v"(r2[3]));
}
__device__ __forceinline__ void blk_update(f32x2& Se, f32x2& So, const f32x2 sa, const f32x2 v, const f32x2 w2, const f32x2 b2, const f32x2 k2) {
    f32x2 t0, t1;
    asm("v_pk_mul_f32 %2, %5, %8 op_sel:[0,0] op_sel_hi:[1,0]\n\tv_pk_mul_f32 %3, %5, %8 op_sel:[0,1] op_sel_hi:[1,1]\n\t"
        "v_pk_fma_f32 %2, %4, %7, %2 " PKB0 "\n\tv_pk_fma_f32 %3, %4, %7, %3 " PKB1 "\n\t"
        "v_pk_fma_f32 %0, %0, %6, %2 " PKB0 "\n\tv_pk_fma_f32 %1, %1, %6, %3 " PKB1
        : "+v"(Se), "+v"(So), "=&v"(t0), "=&v"(t1) : "v"(sa), "v"(v), "v"(w2), "v"(b2), "v"(k2));
}
__device__ __forceinline__ void blk_yfin(f32x2& y, const f32x2 sa, const f32x2 v, const f32x2 brk) {
    asm("v_pk_fma_f32 %0, %1, %3, %0 " PKB0 "\n\tv_pk_fma_f32 %0, %2, %3, %0 " PKB1 : "+v"(y) : "v"(sa), "v"(v), "v"(brk));
}
#undef PKB0
#undef PKB1
__device__ __forceinline__ void step_math(const StepOps& o, f32x2 (&S)[8], LAS float* yp, bool wr) {
    const f32x2 a2[4] = {lo2(o.a[0]), hi2(o.a[0]), lo2(o.a[1]), hi2(o.a[1])}, r2[4] = {lo2(o.r[0]), hi2(o.r[0]), lo2(o.r[1]), hi2(o.r[1])};
    const f32x2 w2[4] = {lo2(o.w[0]), hi2(o.w[0]), lo2(o.w[1]), hi2(o.w[1])}, b2[4] = {lo2(o.b[0]), hi2(o.b[0]), lo2(o.b[1]), hi2(o.b[1])}, k2[4] = {lo2(o.k[0]), hi2(o.k[0]), lo2(o.k[1]), hi2(o.k[1])};
    f32x2 s, y; blk_partials(S, a2, r2, s, y);
    float r0 = s.x, r1 = s.y, r2v = y.x, r3 = y.y;
    row8_sum4(r0, r1, r2v, r3);
    const f32x2 sa = {r0, r1}; f32x2 yo = {r2v, r3};
#pragma unroll
    for (int p = 0; p < 4; ++p) blk_update(S[2 * p], S[2 * p + 1], sa, o.v, w2[p], b2[p], k2[p]);
    blk_yfin(yo, sa, o.v, o.brk);
    if (wr) *(LAS f32x2*)yp = yo;
}
__device__ __forceinline__ void scan_unit(const Ctx& C, const Args& a, int tok0, int T, const float* shift_prev, const float* s_in, float* s_out, int h) {
    LAS float* L = (LAS float*)C.lds; LAS float* Y = L + 2 * STG; LAS float* BRK = Y + 2 * TC * 64;
    const int NC = (T + TC - 1) / TC; const bool comp = C.wave < 4;
    const int t2 = C.tid - 256, st = t2 >> 4, cq = t2 & 15, cj = h * 64 + 4 * cq;
    bf16* yout = (bf16*)(a.ws + WS_YA) + (size_t)tok0 * DM + cj;
    StagePar P; StageRegs R; Carry cA, cB; f32x4 lnw, lnb; cA.rk = 0.f; cA.g = (v2u){0u, 0u}; cB = cA;
    const int row = 16 * C.wave + 2 * (C.lane >> 3), cg = C.lane & 7; const bool wr = (cg == 0);
    f32x2 S[8];
    if (comp) {
        if (s_in) {
#pragma unroll
            for (int j = 0; j < 2; ++j) { const f32x4 x0 = *(const f32x4*)(s_in + row * 64 + 8 * cg + 4 * j), x1 = *(const f32x4*)(s_in + (row + 1) * 64 + 8 * cg + 4 * j);
#pragma unroll
                for (int e = 0; e < 4; ++e) S[4 * j + e] = (f32x2){x0[e], x1[e]}; } }
        else {
#pragma unroll
            for (int e = 0; e < 8; ++e) S[e] = (f32x2){0.f, 0.f}; }
    } else {
        const float* mu = a.in[I_MU];
        P.mur = *(const f32x4*)(mu + cj); P.muk = *(const f32x4*)(mu + 2048 + cj); P.muv = *(const f32x4*)(mu + 4096 + cj); P.kkp = *(const f32x4*)(a.in[I_KK] + cj); P.kap = *(const f32x4*)(a.in[I_KA] + cj); P.rkp = *(const f32x4*)(a.in[I_RK] + cj);
        lnw = *(const f32x4*)(a.in[I_LNW] + cj); lnb = *(const f32x4*)(a.in[I_LNB] + cj);
        stage_load(R, a, shift_prev, tok0, st, T, cj); cB.g = R.g; cB.rk = stage_store(R, L, BRK, st, cq, P);
        if (NC > 1) stage_load(R, a, shift_prev, tok0, TC + st, T, cj);
    }
    __syncthreads();
#pragma unroll 1
    for (int c = 0; c < NC; ++c) {
        const int cur = c & 1;
        if (comp) {
            const LAS float* B = L + cur * STG + 8 * cg; const LAS float* V = L + cur * STG + 5 * TC * 64 + row; const LAS float* K2 = BRK + cur * TC * 2; LAS float* Yb = Y + cur * TC * 64 + row;
            const int ns = (T - c * TC) < TC ? (T - c * TC) : TC;
            if (ns == TC) {
                StepOps o0, o1; step_load(o0, B, V, K2);
#pragma unroll
                for (int t = 0; t < TC; t += 2) {
                    step_load(o1, B + (t + 1) * 64, V + (t + 1) * 64, K2 + (t + 1) * 2);
                    step_math(o0, S, Yb + t * 64, wr);
                    if (t + 2 < TC) step_load(o0, B + (t + 2) * 64, V + (t + 2) * 64, K2 + (t + 2) * 2);
                    step_math(o1, S, Yb + (t + 1) * 64, wr);
                }
            } else {
#pragma unroll 1
                for (int t = 0; t < ns; ++t) { StepOps o; step_load(o, B + t * 64, V + t * 64, K2 + t * 2); step_math(o, S, Yb + t * 64, wr); }
            }
        } else {
            if (c > 0 && (c - 1) * TC + st < T) post_store(Y + (cur ^ 1) * TC * 64 + st * 64 + 4 * cq, L + (cur ^ 1) * STG + 5 * TC * 64 + st * 64 + 4 * cq, cA, lnw, lnb, yout + (size_t)((c - 1) * TC + st) * DM);
            Carry cN = cB;
            if (c + 1 < NC) { cN.g = R.g; cN.rk = stage_store(R, L + (cur ^ 1) * STG, BRK + (cur ^ 1) * TC * 2, st, cq, P); if (c + 2 < NC) stage_load(R, a, shift_prev, tok0, (c + 2) * TC + st, T, cj); }
            cA = cB; cB = cN;
        }
        __syncthreads();
    }
    if (comp) {
#pragma unroll
        for (int j = 0; j < 2; ++j) { *(f32x4*)(s_out + row * 64 + 8 * cg + 4 * j) = (f32x4){S[4 * j].x, S[4 * j + 1].x, S[4 * j + 2].x, S[4 * j + 3].x};
            *(f32x4*)(s_out + (row + 1) * 64 + 8 * cg + 4 * j) = (f32x4){S[4 * j].y, S[4 * j + 1].y, S[4 * j + 2].y, S[4 * j + 3].y}; }
    } else {
        const int cl = NC - 1; if (cl * TC + st < T) post_store(Y + (cl & 1) * TC * 64 + st * 64 + 4 * cq, L + (cl & 1) * STG + 5 * TC * 64 + st * 64 + 4 * cq, cA, lnw, lnb, yout + (size_t)(cl * TC + st) * DM);
    }
}

__device__ __forceinline__ bf16x8 pack8(const f32x4 x, const f32x4 y) { v4u w; w.x = cvt_pk_bf16(x[0], x[1]); w.y = cvt_pk_bf16(x[2], x[3]); w.z = cvt_pk_bf16(y[0], y[1]); w.w = cvt_pk_bf16(y[2], y[3]); return __builtin_bit_cast(bf16x8, w); }
__device__ __forceinline__ void attn_prompt_unit(const Args& a, int u, int wave, int lane) {
    const int b = u >> 6, h = (u >> 4) & 3, qt = u & 15, fr = lane & 15, g = lane >> 4;
    const bf16* q = (const bf16*)(a.ws + WS_Q); const bf16* kb = (const bf16*)(a.ws + WS_KB); const bf16* vt = (const bf16*)(a.ws + WS_VT); bf16* yc = (bf16*)(a.ws + WS_YA) + 3072;
    const int tok = b * SEQ + qt * 128 + wave * 16 + fr;
    bf16x8 qf[8];
#pragma unroll
    for (int ks = 0; ks < 8; ++ks) qf[ks] = *(const bf16x8*)(q + (size_t)tok * 1024 + h * 256 + 32 * ks + 8 * g);
    f32x4 st[16];
#pragma unroll
    for (int T = 0; T < 16; ++T) { st[T] = (f32x4){0.f, 0.f, 0.f, 0.f}; const bf16* kr = kb + (size_t)(b * 256 + 16 * T + fr) * 1024 + h * 256 + 8 * g;
#pragma unroll
        for (int ks = 0; ks < 8; ++ks) { const bf16x8 kf = *(const bf16x8*)(kr + 32 * ks); st[T] = __builtin_amdgcn_mfma_f32_16x16x32_bf16(kf, qf[ks], st[T], 0, 0, 0); } }
    float mx = -3.0e38f;
#pragma unroll
    for (int T = 0; T < 16; ++T) mx = fmaxf(fmaxf(fmaxf(st[T][0], st[T][1]), fmaxf(st[T][2], st[T][3])), mx);
    mx = fmaxf(mx, __shfl_xor(mx, 16)); mx = fmaxf(mx, __shfl_xor(mx, 32));
    float sum = 0.f;
#pragma unroll
    for (int T = 0; T < 16; ++T)
#pragma unroll
        for (int r = 0; r < 4; ++r) { const float p = __builtin_amdgcn_exp2f(st[T][r] - mx); st[T][r] = p; sum += p; }
    sum += __shfl_xor(sum, 16); sum += __shfl_xor(sum, 32);
    const float inv = 1.0f / sum;
    bf16x8 pf[8];
#pragma unroll
    for (int ks = 0; ks < 8; ++ks) pf[ks] = pack8(st[2 * ks], st[2 * ks + 1]);
#pragma unroll
    for (int dt = 0; dt < 16; ++dt) { f32x4 o = {0.f, 0.f, 0.f, 0.f}; const bf16* vr = vt + ((size_t)(b * 4 + h) * 256 + 16 * dt + fr) * 256 + 8 * g;
#pragma unroll
        for (int ks = 0; ks < 8; ++ks) { const bf16x8 vf = *(const bf16x8*)(vr + 32 * ks); o = __builtin_amdgcn_mfma_f32_16x16x32_bf16(vf, pf[ks], o, 0, 0, 0); }
        o = o * inv; v2u w; w.x = cvt_pk_bf16(o[0], o[1]); w.y = cvt_pk_bf16(o[2], o[3]);
        *(v2u*)(yc + (size_t)tok * DM + h * 256 + 16 * dt + 4 * g) = w; }
}
__device__ __forceinline__ void attn_sample_unit(const Ctx& C, const Args& a, int u) {
    const int db = u >> 2, h = u & 3, lane = C.lane, wave = C.wave, fr = lane & 15, g = lane >> 4;
    LAS float* sc = (LAS float*)C.lds; LAS float* red = sc + 1024; LAS float* sinv = red + 8192;
    const float* ck = a.in[I_CK] + (size_t)db * 256 * 1024 + h * 256; const float* cv = a.in[I_CV] + (size_t)db * 256 * 1024 + h * 256;
    const bf16* q = (const bf16*)(a.ws + WS_Q) + (size_t)(NTP + db * 4) * 1024 + h * 256; bf16* yc = (bf16*)(a.ws + WS_YA) + 3072 + (size_t)(NTP + db * 4) * DM + h * 256;
    bf16x8 qf[8];
#pragma unroll
    for (int ks = 0; ks < 8; ++ks) { const v4u z = {0u, 0u, 0u, 0u}; qf[ks] = __builtin_bit_cast(bf16x8, z); if (fr < 4) qf[ks] = *(const bf16x8*)(q + (size_t)fr * 1024 + 32 * ks + 8 * g); }
#pragma unroll
    for (int T2 = 0; T2 < 2; ++T2) { const int key = 32 * wave + 16 * T2 + fr; f32x4 s = {0.f, 0.f, 0.f, 0.f}; const float* kp = ck + (size_t)key * 1024 + 8 * g;
#pragma unroll
        for (int ks = 0; ks < 8; ++ks) { const f32x4 k0 = *(const f32x4*)(kp + 32 * ks), k1 = *(const f32x4*)(kp + 32 * ks + 4); s = __builtin_amdgcn_mfma_f32_16x16x32_bf16(pack8(k0, k1), qf[ks], s, 0, 0, 0); }
        if (fr < 4) *(LAS f32x4*)(sc + fr * 256 + 32 * wave + 16 * T2 + 4 * g) = s; }
    __syncthreads();
    if (wave < 4) { f32x4 v = *(LAS f32x4*)(sc + wave * 256 + 4 * lane); float mx = fmaxf(fmaxf(v[0], v[1]), fmaxf(v[2], v[3]));
#pragma unroll
        for (int o = 1; o < 64; o <<= 1) mx = fmaxf(mx, __shfl_xor(mx, o));
        float s = 0.f;
#pragma unroll
        for (int e = 0; e < 4; ++e) { v[e] = __builtin_amdgcn_exp2f(v[e] - mx); s += v[e]; }
        s = wave_sum(s); *(LAS f32x4*)(sc + wave * 256 + 4 * lane) = v; if (lane == 0) sinv[wave] = 1.0f / s; }
    __syncthreads();
    f32x4 o[4];
#pragma unroll
    for (int t = 0; t < 4; ++t) o[t] = (f32x4){0.f, 0.f, 0.f, 0.f};
#pragma unroll 2
    for (int kk = 0; kk < 32; kk += 4) { f32x4 p[4];
#pragma unroll
        for (int t = 0; t < 4; ++t) p[t] = *(LAS f32x4*)(sc + t * 256 + 32 * wave + kk);
#pragma unroll
        for (int e = 0; e < 4; ++e) { const f32x4 v = *(const f32x4*)(cv + (size_t)(32 * wave + kk + e) * 1024 + 4 * lane);
#pragma unroll
            for (int t = 0; t < 4; ++t) o[t] += v * p[t][e]; } }
#pragma unroll
    for (int t = 0; t < 4; ++t) *(LAS f32x4*)(red + (wave * 4 + t) * 256 + 4 * lane) = o[t];
    __syncthreads();
    { const int t = C.tid >> 7, d = (C.tid & 127) * 2; f32x2 s = {0.f, 0.f};
#pragma unroll
        for (int w = 0; w < 8; ++w) s += *(LAS f32x2*)(red + (w * 4 + t) * 256 + d);
        s = s * sinv[t]; *(unsigned*)(yc + (size_t)t * DM + d) = cvt_pk_bf16(s.x, s.y); }
    __syncthreads();
}

template <class E> __device__ __forceinline__ void tail_combine(const Ctx& C, const E& e, const float* slab, int M, int N, int bx) {
    pg8::StaticOrder so; so.init(M, N, C.G, 0); const int R = so.nwg / C.G, rem = so.nwg - R * C.G; if (rem == 0) return; const int split = C.G / rem;
    const int l = bx / split, q = bx % split; if (l >= rem || q >= 8) return;
    pg8::Unit u; pg8::TailSplitOrder::leftover(N, R, l, u);
    const int ai = q >> 2, m = q & 3, w = C.wave, wr = w >> 2, wc = w & 3, fr = C.lane & 15, fq = C.lane >> 4;
    epi::A4 v[2][2];
#pragma unroll
    for (int bj = 0; bj < 2; ++bj)
#pragma unroll
        for (int n = 0; n < 2; ++n) v[bj][n] = (epi::A4){0.f, 0.f, 0.f, 0.f};
#pragma unroll
    for (int part = 0; part < 8; ++part) { if (part >= split) break; const float* p = slab + ((size_t)((l * split + part) * 8 + w) * 32 * 64 + C.lane) * 4;
#pragma unroll
        for (int bj = 0; bj < 2; ++bj)
#pragma unroll
            for (int n = 0; n < 2; ++n) v[bj][n] += *(const epi::A4*)(p + (size_t)(ai * 16 + bj * 8 + m * 2 + n) * 256); }
    e.row_op(v, u.pm * 256 + ai * 128 + wr * 64 + m * 16 + fr, u.pn, wc, fq);
}

#ifndef MK_ONE_LAUNCH
#define MK_ONE_LAUNCH 1
#endif
constexpr int NPHASE = 16;
constexpr int CW_SKF = 32768;
constexpr int CW_BAR = 4096;

__global__ void __launch_bounds__(NWAVES * 64, 2) mk_fwd(Args args) {
    extern __shared__ __attribute__((aligned(16))) unsigned char lds_raw[];
    Ctx C; C.lds = (LAS unsigned char*)lds_raw; C.tid = threadIdx.x; C.lane = C.tid & 63; C.wave = __builtin_amdgcn_readfirstlane(C.tid >> 6);
    C.G = gridDim.x; { const int bx = blockIdx.x; C.vcu = (C.G % 8 == 0) ? (bx % 8) * (C.G / 8) + bx / 8 : bx; }
    C.gw = C.vcu * NWAVES + C.wave; C.NGW = C.G * NWAVES;
    const Args& a = args; unsigned char* ws = a.ws;
    volatile LAS unsigned* MISC = (volatile LAS unsigned*)(C.lds + MISC_OFF);
    for (int u = C.tid; u < (LDS_BYTES - LDSCTL_OFF) / 4; u += NWAVES * 64) ((LAS unsigned*)(C.lds + LDSCTL_OFF))[u] = 0u;
    __syncthreads();
#if MK_ONE_LAUNCH
    XcdBarrier bar = xcd_barrier_post((unsigned*)(ws + WS_CTL) + CW_BAR + a.li * XCD_BAR_WORDS, MISC + 8);
#define GRID_BAR() xcd_barrier(bar)
#else
#define GRID_BAR() do { } while (0)
#endif
    const int lo = a.ph_lo, hi = a.ph_hi;
#ifndef PH_MASK
#define PH_MASK 0xFFFF
#endif
#define IN(k) ((((PH_MASK) >> (k)) & 1) && lo <= (k) && (k) < hi)
#define SEAM(k) do { if (IN(k) && IN((k) + 1)) GRID_BAR(); } while (0)
    LAS unsigned char* ring = C.lds + RING_OFF;
    const int bx = blockIdx.x;

    if (IN(0)) { p0_prologue(C, a); } SEAM(0);

    if (IN(1)) {
        { pg8::Gemm g{(const bf16*)(ws + WS_XB), (const bf16*)(ws + WS_W1A), MTOK, 2 * DFF, DM, DM, DM}; pg8::XcdOrder S; S.init(2 * DFF, bx);
          epi::SwiGLU E{(bf16*)(ws + WS_ACT), (const float*)(ws + WS_RSTD0)};
          pg8::gemm_phase<epi::SwiGLU, pg8::XcdOrder, PG8_ALIGN, PG8_SP2>(ring, g, S, E); }
        { const int c0 = 112; const int gsub = C.G - c0;
          if (bx >= c0) { pg8::Gemm g{(const bf16*)(ws + WS_MEMB), (const bf16*)(ws + WS_WMEM), 1024, 2048, DM, DM, DM}; pg8::StaticOrder S; S.init(1024, 2048, gsub, bx - c0);
            epi::MemKV E{a.out + O_MK, a.out + O_MV, (bf16*)(ws + WS_KB), (bf16*)(ws + WS_VT), (const float*)(ws + WS_RSTDM)};
            pg8::gemm_phase<epi::MemKV, pg8::StaticOrder, PG8_ALIGN, PG8_SP2>(ring, g, S, E); }
          { const int c1 = c0 + 32; if (bx >= c1) { __syncthreads(); Ctx C2 = C; C2.gw = (bx - c1) * NWAVES + C.wave; C2.NGW = (C.G - c1) * NWAVES; int base = 0;
              cvt_matrix<0>(C2, a.in[I_WF1O], DFF, DM, nullptr, (bf16*)(ws + WS_W1B), base, 0, W1B_EARLY, -1); } } }
    } SEAM(1);

    if (IN(2)) {
        pg8::Gemm g{(const bf16*)(ws + WS_ACT), (const bf16*)(ws + WS_W1B), MTOK, DM, DFF, DFF, DFF}; pg8::TailSplitOrder S; S.init(MTOK, DM, g.K, C.G, bx, (float*)(ws + WS_SLAB));
        epi::Resid<true, false> E{a.out + O_Y, a.out + O_Y, a.out + O_Y, (bf16*)(ws + WS_XB), (float*)(ws + WS_SLOT), 0.5f};
        pg8::gemm_phase<epi::Resid<true, false>, pg8::TailSplitOrder, PG8_ALIGN, PG8_SP2>(ring, g, S, E);
        GRID_BAR(); tail_combine(C, E, (const float*)(ws + WS_SLAB), MTOK, DM, bx);
    } SEAM(2);

    if (IN(3)) { rstd_phase(C, (const float*)(ws + WS_SLOT), (float*)(ws + WS_RSTD1)); win_weights(C, a); } SEAM(3);

    if (IN(4)) {
        pg8::Gemm g{(const bf16*)(ws + WS_XB), (const bf16*)(ws + WS_WIN), MTOK, NWIN, DM, DM, DM}; pg8::XcdOrder S; S.init(NWIN, bx);
        epi::Win E{(bf16*)(ws + WS_PAF), (bf16*)(ws + WS_PB), (bf16*)(ws + WS_Q), (bf16*)(ws + WS_GATE), (const float*)(ws + WS_RSTD1), a.out + O_SHP, a.out + O_SHS};
        pg8::gemm_phase<epi::Win, pg8::XcdOrder, PG8_ALIGN, PG8_SP2>(ring, g, S, E);
    } SEAM(4);

    if (IN(5)) { r1_phase(C, a); } SEAM(5);

    if (IN(6)) {
        { pg8::Gemm g{(const bf16*)(ws + WS_LIN), (const bf16*)(ws + WS_WLWA), MTOK, 4096, 256, 512, 256}; pg8::XcdOrder S; S.init(4096, bx);
          epi::LoraWA E{(float*)(ws + WS_WDEC), (float*)(ws + WS_AVAL), a.in[I_W0], a.in[I_A0]};
          pg8::gemm_phase<epi::LoraWA, pg8::XcdOrder, PG8_ALIGN, PG8_SP2>(ring, g, S, E); }
        { pg8::Gemm g{(const bf16*)(ws + WS_LIN) + 256, (const bf16*)(ws + WS_WLG), MTOK, 2048, 256, 512, 256}; pg8::XcdOrder S; S.init(2048, bx);
          epi::LoraG E{(bf16*)(ws + WS_G)};
          pg8::gemm_phase<epi::LoraG, pg8::XcdOrder, PG8_ALIGN, PG8_SP2>(ring, g, S, E); }
    } SEAM(6);


    if (IN(8)) {
        const int nscan = (C.G > 128) ? 128 : C.G / 2, nother = C.G - nscan;
#ifdef MK_P8_PROBE
        const int p8m = (a.li == 1) ? MK_P8_PROBE : 0;
#else
        const int p8m = 0;
#endif
        if (bx < nscan) {
            if (p8m != 2) for (int u = bx; u < 128; u += nscan) { const int b = u >> 5, h = u & 31; scan_unit(C, a, b * SEQ, SEQ, nullptr, nullptr, a.out + O_RWP + (size_t)u * 4096, h); }
        } else {
            const int r = bx - nscan;
            if (p8m != 1) {
            for (int u = r; u < NDB * HA; u += nother) { const int db = u >> 5, h = u & 31;
                scan_unit(C, a, NTP + db * DSEQ, DSEQ, a.in[I_SSH] + (size_t)db * PA, a.in[I_SRW] + (size_t)u * 4096, a.out + O_RWS + (size_t)u * 4096, h); }
            for (int u = r; u < 256; u += nother) attn_prompt_unit(a, u, C.wave, C.lane);
            for (int u = r; u < 512; u += nother) attn_sample_unit(C, a, u);
            conv_phase(a, r * NWAVES + C.wave, nother * NWAVES, C.lane);
            { __syncthreads(); Ctx C2 = C; C2.gw = r * NWAVES + C.wave; C2.NGW = nother * NWAVES; late_weights(C2, a); }
            }
        }
    } SEAM(8);


    if (IN(10)) {
        pg8::Gemm g{(const bf16*)(ws + WS_YA), (const bf16*)(ws + WS_WBRA), MTOK, DM, DM, DM, DM}; pg8::TailSplitOrder S; S.init(MTOK, DM, g.K, C.G, bx, (float*)(ws + WS_SLAB));
        epi::GateCat E{(const bf16*)(ws + WS_GATE), (bf16*)(ws + WS_MRG)};
        pg8::gemm_phase<epi::GateCat, pg8::TailSplitOrder, PG8_ALIGN, PG8_SP2>(ring, g, S, E);
        GRID_BAR(); tail_combine(C, E, (const float*)(ws + WS_SLAB), MTOK, DM, bx);
    } SEAM(10);

    if (IN(11)) {
        pg8::Gemm g{(const bf16*)(ws + WS_MRG), (const bf16*)(ws + WS_WOUT), MTOK, DM, DM, DM, DM}; pg8::TailSplitOrder S; S.init(MTOK, DM, g.K, C.G, bx, (float*)(ws + WS_SLAB));
        epi::Resid<true, false> E{a.out + O_Y, a.out + O_Y, a.out + O_Y, (bf16*)(ws + WS_XB), (float*)(ws + WS_SLOT), 1.0f};
        pg8::gemm_phase<epi::Resid<true, false>, pg8::TailSplitOrder, PG8_ALIGN, PG8_SP2>(ring, g, S, E);
        GRID_BAR(); tail_combine(C, E, (const float*)(ws + WS_SLAB), MTOK, DM, bx);
    } SEAM(11);

    if (IN(12)) { rstd_phase(C, (const float*)(ws + WS_SLOT), (float*)(ws + WS_RSTD2)); } SEAM(12);

    if (IN(13)) {
        pg8::Gemm g{(const bf16*)(ws + WS_XB), (const bf16*)(ws + WS_W2A), MTOK, 2 * DFF, DM, DM, DM}; pg8::XcdOrder S; S.init(2 * DFF, bx);
        epi::SwiGLU E{(bf16*)(ws + WS_ACT), (const float*)(ws + WS_RSTD2)};
        pg8::gemm_phase<epi::SwiGLU, pg8::XcdOrder, PG8_ALIGN, PG8_SP2>(ring, g, S, E);
        { const int c1 = 112;
          if (bx >= c1) { __syncthreads(); Ctx C2 = C; C2.gw = (bx - c1) * NWAVES + C.wave; C2.NGW = (C.G - c1) * NWAVES; int base = 0; cvt_matrix<0>(C2, a.in[I_WF2O], DFF, DM, nullptr, (bf16*)(ws + WS_W2B), base); } }
    } SEAM(13);

    if (IN(14)) {
        pg8::Gemm g{(const bf16*)(ws + WS_ACT), (const bf16*)(ws + WS_W2B), MTOK, DM, DFF, DFF, DFF}; pg8::TailSplitOrder S; S.init(MTOK, DM, g.K, C.G, bx, (float*)(ws + WS_SLAB));
        epi::Resid<true, false> E{a.out + O_Y, a.out + O_Y, a.out + O_Y, (bf16*)(ws + WS_XB), (float*)(ws + WS_SLOT), 0.5f};
        pg8::gemm_phase<epi::Resid<true, false>, pg8::TailSplitOrder, PG8_ALIGN, PG8_SP2>(ring, g, S, E);
        GRID_BAR(); tail_combine(C, E, (const float*)(ws + WS_SLAB), MTOK, DM, bx);
    } SEAM(14);

    if (IN(15)) { final_norm(C, a); }
#undef IN
#undef SEAM
}

extern "C" void kernel_launch(void* const* d_in, const int* in_sizes, int n_in, void* d_out, int out_size, void* d_ws, size_t ws_size, hipStream_t stream) {
    static int grid = 0;
    if (grid == 0) {
        if (n_in != 35 || (size_t)out_size != O_END || ws_size < WS_END) { fprintf(stderr, "kernel_launch: unexpected problem: n_in %d out_size %d ws_size %zu (need %zu)\n", n_in, out_size, ws_size, (size_t)WS_END); grid = -1; return; }
        int dev = 0, cus = 0;
        if (hipGetDevice(&dev) != hipSuccess || hipDeviceGetAttribute(&cus, hipDeviceAttributeMultiprocessorCount, dev) != hipSuccess) { grid = -1; return; }
        if (hipFuncSetAttribute((const void*)mk_fwd, hipFuncAttributeMaxDynamicSharedMemorySize, LDS_BYTES) != hipSuccess) { fprintf(stderr, "kernel_launch: hipFuncSetAttribute failed\n"); grid = -1; return; }
        int per_cu = 0;
        if (hipOccupancyMaxActiveBlocksPerMultiprocessor(&per_cu, (const void*)mk_fwd, NWAVES * 64, LDS_BYTES) != hipSuccess || per_cu < 1) fprintf(stderr, "kernel_launch: occupancy query says %d\n", per_cu);
        (void)hipGetLastError();
        if (cus != 256) { fprintf(stderr, "kernel_launch: built for a 256-CU device (unit orders and tail splits), found %d CUs\n", cus); grid = -1; return; }
        grid = cus;
    }
    if (grid < 0) return;
    (void)hipMemsetAsync((char*)d_ws + WS_CTL, 0, CTL_BYTES, stream);
    Args a{};
    for (int i = 0; i < 35; ++i) a.in[i] = (const float*)d_in[i];
    a.out = (float*)d_out; a.ws = (unsigned char*)d_ws;
#if MK_ONE_LAUNCH
#ifdef MK_DUP_PHASE
    a.ph_lo = 0; a.ph_hi = MK_DUP_PHASE + 1; a.li = 0; hipLaunchKernelGGL(mk_fwd, dim3(grid), dim3(NWAVES * 64), LDS_BYTES, stream, a);
    a.ph_lo = MK_DUP_PHASE; a.ph_hi = MK_DUP_PHASE + 1; a.li = 1; hipLaunchKernelGGL(mk_fwd, dim3(grid), dim3(NWAVES * 64), LDS_BYTES, stream, a);
    if (MK_DUP_PHASE + 1 < NPHASE) { a.ph_lo = MK_DUP_PHASE + 1; a.ph_hi = NPHASE; a.li = 2; hipLaunchKernelGGL(mk_fwd, dim3(grid), dim3(NWAVES * 64), LDS_BYTES, stream, a); }
#else
    a.ph_lo = 0; a.ph_hi = NPHASE; a.li = 0;
    hipLaunchKernelGGL(mk_fwd, dim3(grid), dim3(NWAVES * 64), LDS_BYTES, stream, a);
#endif
#else
#ifndef MK_LAST_PHASE
#define MK_LAST_PHASE (NPHASE - 1)
#endif
    for (int p = 0; p <= MK_LAST_PHASE; ++p) { a.ph_lo = p; a.ph_hi = p + 1; hipLaunchKernelGGL(mk_fwd, dim3(grid), dim3(NWAVES * 64), LDS_BYTES, stream, a); }
#endif
}
```

```cpp
#include <hip/hip_runtime.h>
#include <cstdio>
#include <cstdint>
namespace pg8 {
#define PG8_LAS __attribute__((address_space(3)))
typedef unsigned short bf16_t;
typedef short bf16x8 __attribute__((ext_vector_type(8)));
typedef float f32x4 __attribute__((ext_vector_type(4)));
typedef unsigned u32x4 __attribute__((ext_vector_type(4)));
constexpr int BM = 256, BK = 64, HALF = 128, HTB = HALF * BK * 2  , STAGE_BYTES = 8 * HTB, NXCD = 8, WGM = 8;

__host__ __device__ __forceinline__ int lds_byte(int r, int c) { const int st = (r >> 4) * 2 + (c >> 5), rr = r & 15, cc = c & 31, ob = rr * 64 + cc * 2; return st * 1024 + (ob ^ (((ob >> 9) & 1) << 5)); }
__host__ __device__ __forceinline__ void stage_rc(int b, int& R, int& C) { const int st = b / 1024, sb = b % 1024, swz = sb ^ (((sb >> 9) & 1) << 5); R = (st >> 1) * 16 + swz / 64; C = (st & 1) * 32 + (swz % 64) / 2; }
__host__ __device__ __forceinline__ int perm32(int rho) { const int n = rho >> 4, i = rho & 15; return 8 * (i >> 2) + 4 * n + (i & 3); }

struct Unit { int pm, pn, kt0, nt, kind, slab; };
struct Gemm { const bf16_t* A; const bf16_t* Bt; int M, N, K, lda, ldb; };

struct StaticOrder {
    int nM, nN, nwg, G, c;
    __host__ __device__ void init(int M, int N, int G_, int c_) { nM = M / BM; nN = N / BM; nwg = nM * nN; G = G_; c = c_; }
    __host__ __device__ bool next(int i, Unit& u) const {
        const long L = (long)i * G + c; if (L >= nwg) return false;
        int wgid = (int)L; { const int q = nwg / NXCD, r = nwg % NXCD, xcd = wgid % NXCD, off = wgid / NXCD; wgid = (xcd < r ? xcd * (q + 1) : r * (q + 1) + (xcd - r) * q) + off; }
        const int nig = WGM * nN, gid = wgid / nig, fm = gid * WGM, gsz = (nM - fm) < WGM ? (nM - fm) : WGM;
        u.pm = fm + ((wgid % nig) % gsz); u.pn = (wgid % nig) / gsz; u.kt0 = 0; u.nt = -1; u.kind = 0; u.slab = 0; return true;
    }
    static constexpr bool STREAMK = false;
    __device__ __forceinline__ void a_ready(const Unit&) const {}
    __device__ __forceinline__ void done(const Unit&) const {}
};


struct XcdOrder {
    static constexpr bool STREAMK = false;
    int nN, x, j;
    __host__ __device__ __forceinline__ void init(int N, int c) { nN = N / BM; x = c & 7; j = c >> 3; }
    __host__ __device__ __forceinline__ bool entry(int e, Unit& u) const {
        if (e < 4 * nN) { u.pn = 8 * (e >> 5) + ((e & 31) >> 2); u.pm = x + 8 * (e & 3); }
        else { const int s = x + 8 * (e - 4 * nN); if (s >= 2 * nN) return false; u.pn = s >> 1; u.pm = 32 + (s & 1); }
        u.kt0 = 0; u.nt = -1; u.kind = 0; u.slab = 0; return true;
    }
    __host__ __device__ __forceinline__ bool next(int i, Unit& u) const { return entry(j + 32 * i, u); }
    __device__ __forceinline__ void a_ready(const Unit&) const {}
    __device__ __forceinline__ void done(const Unit&) const {}
};
typedef __attribute__((address_space(1))) unsigned long long gu64_t; typedef __attribute__((address_space(1))) unsigned gu32_t;
struct StreamKOrder {
    static constexpr bool STREAMK = true;
    int nN, NB, s0, s1, rank;
    unsigned long long* slab; unsigned* flag; unsigned* tmo;
    __device__ __forceinline__ void init(int M, int N, int K, int G, int rank_, unsigned long long* slab_, unsigned* flag_, unsigned* tmo_) {
        nN = N / BM; NB = K / 128; const long I = (long)(M / BM) * nN * NB; s0 = (int)(I * rank_ / G); s1 = (int)(I * (rank_ + 1) / G); rank = rank_; slab = slab_; flag = flag_; tmo = tmo_; }
    __device__ __forceinline__ void set(Unit& u, int unit, int kb0, int nkb, int kind, int sl) const { u.pm = unit / nN; u.pn = unit % nN; u.kt0 = 2 * kb0; u.nt = 2 * nkb; u.kind = kind; u.slab = sl; }
    __device__ __forceinline__ bool next(int i, Unit& u) const {
        const int uf = s0 / NB, r0 = s0 % NB, ul = s1 / NB, r1 = s1 % NB; int idx = i;
        if (r0 != 0) { if (idx == 0) { set(u, uf, r0, NB - r0, 1, rank); return true; } idx -= 1; }
        const int f0 = uf + (r0 != 0 ? 1 : 0), nfull = ul - f0;
        if (idx < nfull) { set(u, f0 + idx, 0, NB, 0, 0); return true; }
        idx -= nfull;
        if (r1 != 0 && idx == 0) { set(u, ul, 0, r1, 2, rank + 1); return true; }
        return false;
    }
    __device__ __forceinline__ void a_ready(const Unit&) const {}
    __device__ __forceinline__ void done(const Unit&) const {}
    __device__ __forceinline__ void store_slab(const f32x4 (&acc)[2][2][4][2], const Unit& u, int wid, int lane) const {
        gu64_t* p = (gu64_t*)slab + ((size_t)(u.slab * 8 + wid) * 32 * 64 + lane) * 2;
#pragma unroll
        for (int r4 = 0; r4 < 8; ++r4) {
#pragma unroll
            for (int j = 0; j < 4; ++j) { const int r = 4 * r4 + j; const f32x4 v = acc[r >> 4][(r >> 3) & 1][(r >> 1) & 3][r & 1];
                const float f0 = v[0], f1 = v[1], f2 = v[2], f3 = v[3];
                __hip_atomic_store(p + j * 128, ((unsigned long long)__float_as_uint(f1) << 32) | __float_as_uint(f0), __ATOMIC_RELAXED, __HIP_MEMORY_SCOPE_AGENT);
                __hip_atomic_store(p + j * 128 + 1, ((unsigned long long)__float_as_uint(f3) << 32) | __float_as_uint(f2), __ATOMIC_RELAXED, __HIP_MEMORY_SCOPE_AGENT); }
            p += 512; asm volatile("" : "+v"(p) :: "memory"); }
        asm volatile("s_waitcnt vmcnt(0)" ::: "memory");
        if (lane == 0) __hip_atomic_fetch_add((gu32_t*)flag + 64 * u.slab, 1u, __ATOMIC_RELAXED, __HIP_MEMORY_SCOPE_AGENT);
    }
    __device__ __forceinline__ void add_slab(f32x4 (&acc)[2][2][4][2], const Unit& u, int wid, int lane) const {
        const unsigned long long t0 = __builtin_amdgcn_s_memrealtime();
        while ((unsigned)__builtin_amdgcn_readfirstlane(__hip_atomic_load((gu32_t*)flag + 64 * u.slab, __ATOMIC_RELAXED, __HIP_MEMORY_SCOPE_AGENT)) < 8u) {
            if (__builtin_amdgcn_s_memrealtime() - t0 > 2000000ull) { if (lane == 0) __hip_atomic_store((gu32_t*)tmo, 1u, __ATOMIC_RELAXED, __HIP_MEMORY_SCOPE_AGENT); break; }
            __builtin_amdgcn_s_sleep(2); }
        gu64_t* p = (gu64_t*)slab + ((size_t)(u.slab * 8 + wid) * 32 * 64 + lane) * 2;
#pragma unroll
        for (int r4 = 0; r4 < 8; ++r4) {
#pragma unroll
            for (int j = 0; j < 4; ++j) { const int r = 4 * r4 + j;
                const unsigned long long lo = __hip_atomic_load(p + j * 128, __ATOMIC_RELAXED, __HIP_MEMORY_SCOPE_AGENT), hi = __hip_atomic_load(p + j * 128 + 1, __ATOMIC_RELAXED, __HIP_MEMORY_SCOPE_AGENT);
                f32x4& a = acc[r >> 4][(r >> 3) & 1][(r >> 1) & 3][r & 1];
                a[0] += __uint_as_float((unsigned)lo); a[1] += __uint_as_float((unsigned)(lo >> 32)); a[2] += __uint_as_float((unsigned)hi); a[3] += __uint_as_float((unsigned)(hi >> 32)); }
            p += 512; asm volatile("" : "+v"(p) :: "memory"); }
    }
};

struct TailSplitOrder {
    static constexpr bool STREAMK = true;
    XcdOrder xo; int c, R, rem, split, NB; float* slabf;
    __device__ __forceinline__ void init(int M, int N, int K, int G, int c_, float* slab_) { xo.init(N, c_); c = c_; const int nwg = (M / BM) * (N / BM); R = nwg / G; rem = nwg - R * G; split = rem ? G / rem : 1; NB = K / 128; slabf = slab_; }
    __device__ __forceinline__ static void leftover(int N, int R, int l, Unit& u) { XcdOrder t; t.init(N, l & 7); t.entry(32 * R + (l >> 3), u); }
    __device__ __forceinline__ bool next(int i, Unit& u) const {
        if (i < R) return xo.next(i, u);
        if (i > R || rem == 0) return false;
        const int l = c / split, part = c % split; if (l >= rem) return false;
        leftover(xo.nN * BM, R, l, u);
        const int kb0 = part * NB / split, kb1 = (part + 1) * NB / split; u.kt0 = 2 * kb0; u.nt = 2 * (kb1 - kb0); u.kind = 1; u.slab = c; return true;
    }
    __device__ __forceinline__ void a_ready(const Unit&) const {}
    __device__ __forceinline__ void done(const Unit&) const {}
    __device__ __forceinline__ void store_slab(const f32x4 (&acc)[2][2][4][2], const Unit& u, int wid, int lane) const {
        float* p = slabf + ((size_t)(u.slab * 8 + wid) * 32 * 64 + lane) * 4;
#pragma unroll
        for (int r4 = 0; r4 < 8; ++r4) {
#pragma unroll
            for (int j = 0; j < 4; ++j) { const int r = 4 * r4 + j; *(f32x4*)(p + j * 256) = acc[r >> 4][(r >> 3) & 1][(r >> 1) & 3][r & 1]; }
            p += 1024; asm volatile("" : "+v"(p) :: "memory"); }
    }
    __device__ __forceinline__ void add_slab(f32x4 (&)[2][2][4][2], const Unit&, int, int) const {}
};

template <class Epi, class Sched, bool ALIGN_EPI = false, bool SP2 = false>
__device__ __forceinline__ void gemm_phase(PG8_LAS unsigned char* lds, const Gemm g, const Sched& S, const Epi& E) {
    const int tid = threadIdx.x, wid = __builtin_amdgcn_readfirstlane(tid >> 6), lane = tid & 63, wr = wid >> 2, wc = wid & 3, fr = lane & 15, fq = lane >> 4;
    const int K = g.K, nt = K / BK;
    unsigned voffA[2], voffB[2];
#pragma unroll
    for (int i = 0; i < 2; ++i) { int R, C; stage_rc(tid * 16 + i * 8192, R, C); const int Rb = Epi::PERM ? ((R & ~31) + perm32(R & 31)) : R;
        voffA[i] = (unsigned)(R * g.lda + C) * 2u; voffB[i] = (unsigned)(Rb * g.ldb + C) * 2u; }
    const size_t kstep = (size_t)(BK * 2);
    const size_t hstepA = (size_t)HALF * g.lda * 2, hstepB = (size_t)HALF * g.ldb * 2;
    const size_t tstepA = 2 * hstepA, tstepB = 2 * hstepB;
    const unsigned ldsw = (unsigned)wid * 1024u;
    const int aoff = lds_byte(wr * 64 + fr, fq * 8), boff = lds_byte(wc * 32 + fr, fq * 8);
#define PG8_SA(b, h) (((b) * 2 + (h)) * HTB)
#define PG8_SB(b, h) ((4 + (b) * 2 + (h)) * HTB)
#define PG8_STAGE(bufoff, gbase, voff) do { _Pragma("unroll") for (int _i = 0; _i < 2; ++_i) \
        __builtin_amdgcn_global_load_lds((const unsigned*)((const char*)(gbase) + (voff)[_i]), (PG8_LAS unsigned*)(lds + (bufoff) + ldsw + _i * 8192), 16, 0, 0); } while (0)
#define PG8_LDA(dst, b, h) do { _Pragma("unroll") for (int m = 0; m < 4; ++m) _Pragma("unroll") for (int k = 0; k < 2; ++k) dst[m][k] = *(const PG8_LAS bf16x8*)(lds + PG8_SA(b, h) + aoff + m * 2048 + k * 1024); } while (0)
#define PG8_LDB(dst, b, h) do { _Pragma("unroll") for (int n = 0; n < 2; ++n) _Pragma("unroll") for (int k = 0; k < 2; ++k) dst[n][k] = *(const PG8_LAS bf16x8*)(lds + PG8_SB(b, h) + boff + n * 2048 + k * 1024); } while (0)
#define PG8_MMA(ai, bj, At, Bt) do { __builtin_amdgcn_s_setprio(1); _Pragma("unroll") for (int m = 0; m < 4; ++m) _Pragma("unroll") for (int n = 0; n < 2; ++n) _Pragma("unroll") for (int k = 0; k < 2; ++k) \
        acc[ai][bj][m][n] = __builtin_amdgcn_mfma_f32_16x16x32_bf16(Bt[n][k], At[m][k], acc[ai][bj][m][n], 0, 0, 0); __builtin_amdgcn_s_setprio(0); } while (0)
#define PG8_WAIT_V(n) asm volatile("s_waitcnt vmcnt(" #n ")" ::: "memory")
#define PG8_WAIT_L(n) asm volatile("s_waitcnt lgkmcnt(" #n ")" ::: "memory")
#define PG8_BAR __builtin_amdgcn_s_barrier()
#define PG8_SCHED __builtin_amdgcn_sched_barrier(0)
    Unit cur, nxt; int ui = 0;
    if (!S.next(0, cur)) return;
    int cnt = cur.nt < 0 ? nt : cur.nt;
    f32x4 acc[2][2][4][2];
#pragma unroll
    for (int a = 0; a < 2; ++a)
#pragma unroll
        for (int b = 0; b < 2; ++b)
#pragma unroll
            for (int m = 0; m < 4; ++m)
#pragma unroll
                for (int n = 0; n < 2; ++n) acc[a][b][m][n] = (f32x4){0.f, 0.f, 0.f, 0.f};
    bf16x8 At[4][2], B0[2][2], B1[2][2];
    const char* cA = (const char*)g.A + (size_t)cur.pm * tstepA + (size_t)cur.kt0 * kstep; const char* cB = (const char*)g.Bt + (size_t)cur.pn * tstepB + (size_t)cur.kt0 * kstep;
    S.a_ready(cur);
    if constexpr (SP2) {
        PG8_STAGE(PG8_SB(0, 0), cB, voffB); PG8_STAGE(PG8_SB(0, 1), cB + hstepB, voffB); PG8_STAGE(PG8_SA(0, 0), cA, voffA); PG8_STAGE(PG8_SA(0, 1), cA + hstepA, voffA);
        if (wr == 1) PG8_BAR;
        PG8_WAIT_V(2); PG8_BAR;
        PG8_STAGE(PG8_SB(1, 0), cB + kstep, voffB); PG8_STAGE(PG8_SA(1, 0), cA + kstep, voffA); PG8_STAGE(PG8_SB(1, 1), cB + hstepB + kstep, voffB);
        PG8_WAIT_V(6); PG8_BAR;
    } else {
        PG8_STAGE(PG8_SB(0, 0), cB, voffB); PG8_STAGE(PG8_SA(0, 0), cA, voffA); PG8_STAGE(PG8_SB(0, 1), cB + hstepB, voffB); PG8_STAGE(PG8_SA(0, 1), cA + hstepA, voffA);
        if (wr == 1) PG8_BAR;
        PG8_WAIT_V(4); PG8_BAR;
        PG8_STAGE(PG8_SB(1, 0), cB + kstep, voffB); PG8_STAGE(PG8_SA(1, 0), cA + kstep, voffA); PG8_STAGE(PG8_SB(1, 1), cB + hstepB + kstep, voffB);
        PG8_WAIT_V(6); PG8_BAR;
    }
    for (;;) {
        const bool has_next = S.next(ui + 1, nxt);
        const char* nA = has_next ? (const char*)g.A + (size_t)nxt.pm * tstepA + (size_t)nxt.kt0 * kstep : cA; const char* nB = has_next ? (const char*)g.Bt + (size_t)nxt.pn * tstepB + (size_t)nxt.kt0 * kstep : cB;
#pragma unroll 1
        for (int t = 0; t < cnt; t += 2) {
            const bool last = (t == cnt - 2);
            if constexpr (Epi::KHOOK) { const int kt = cur.kt0 + t; if (t > 0 && (kt == 32 || kt == 48)) E.khook(acc, cur, kt, wr, wc, fr, fq); }
            const char* a1 = cA + (size_t)(t + 1) * kstep;
            const char* a2 = last ? nA : cA + (size_t)(t + 2) * kstep; const char* b2 = last ? nB : cB + (size_t)(t + 2) * kstep;
            const char* a3 = a2 + kstep; const char* b3 = b2 + kstep;
            if (last && has_next) S.a_ready(nxt);
            if constexpr (SP2) {
            PG8_LDB(B0, 0, 0); PG8_LDB(B1, 0, 1); PG8_SCHED; PG8_LDA(At, 0, 0); PG8_STAGE(PG8_SA(1, 1), a1 + hstepA, voffA);
            PG8_WAIT_V(8); PG8_WAIT_L(0); PG8_BAR; PG8_MMA(0, 0, At, B0); PG8_MMA(0, 1, At, B1); PG8_BAR; PG8_SCHED;
            PG8_LDA(At, 0, 1); PG8_STAGE(PG8_SB(0, 0), b2, voffB); PG8_STAGE(PG8_SB(0, 1), b2 + hstepB, voffB); PG8_STAGE(PG8_SA(0, 0), a2, voffA);
            PG8_WAIT_V(8); PG8_WAIT_L(0); PG8_BAR; PG8_MMA(1, 0, At, B0); PG8_MMA(1, 1, At, B1); PG8_BAR; PG8_SCHED;
            PG8_LDB(B0, 1, 0); PG8_LDB(B1, 1, 1); PG8_SCHED; PG8_LDA(At, 1, 0); PG8_STAGE(PG8_SA(0, 1), a2 + hstepA, voffA);
            PG8_WAIT_V(8); PG8_WAIT_L(0); PG8_BAR; PG8_MMA(0, 0, At, B0); PG8_MMA(0, 1, At, B1); PG8_BAR; PG8_SCHED;
            PG8_LDA(At, 1, 1); PG8_STAGE(PG8_SB(1, 0), b3, voffB); PG8_STAGE(PG8_SB(1, 1), b3 + hstepB, voffB); PG8_STAGE(PG8_SA(1, 0), a3, voffA);
            PG8_WAIT_V(8); PG8_WAIT_L(0); PG8_BAR; PG8_MMA(1, 0, At, B0); PG8_MMA(1, 1, At, B1); PG8_BAR; PG8_SCHED;
            } else {
            PG8_LDB(B0, 0, 0); PG8_SCHED; PG8_LDA(At, 0, 0); PG8_STAGE(PG8_SA(1, 1), a1 + hstepA, voffA);
            PG8_WAIT_L(8); PG8_BAR; PG8_WAIT_L(0); PG8_MMA(0, 0, At, B0); PG8_BAR; PG8_SCHED;
            PG8_LDB(B1, 0, 1); PG8_STAGE(PG8_SB(0, 0), b2, voffB);
            PG8_BAR; PG8_WAIT_L(0); PG8_MMA(0, 1, At, B1); PG8_BAR;
            PG8_LDA(At, 0, 1); PG8_STAGE(PG8_SA(0, 0), a2, voffA);
            PG8_BAR; PG8_WAIT_L(0); PG8_MMA(1, 0, At, B0); PG8_BAR; PG8_SCHED;
            PG8_STAGE(PG8_SB(0, 1), b2 + hstepB, voffB);
            PG8_WAIT_V(6); PG8_BAR; PG8_MMA(1, 1, At, B1); PG8_BAR;
            PG8_LDB(B0, 1, 0); PG8_SCHED; PG8_LDA(At, 1, 0); PG8_STAGE(PG8_SA(0, 1), a2 + hstepA, voffA);
            PG8_WAIT_L(8); PG8_BAR; PG8_WAIT_L(0); PG8_MMA(0, 0, At, B0); PG8_BAR; PG8_SCHED;
            PG8_LDB(B1, 1, 1); PG8_STAGE(PG8_SB(1, 0), b3, voffB);
            PG8_BAR; PG8_WAIT_L(0); PG8_MMA(0, 1, At, B1); PG8_BAR;
            PG8_LDA(At, 1, 1); PG8_STAGE(PG8_SA(1, 0), a3, voffA);
            PG8_BAR; PG8_WAIT_L(0); PG8_MMA(1, 0, At, B0); PG8_BAR; PG8_SCHED;
            PG8_STAGE(PG8_SB(1, 1), b3 + hstepB, voffB);
            PG8_WAIT_V(6); PG8_BAR; PG8_MMA(1, 1, At, B1); PG8_BAR;
            }
        }
        if constexpr (ALIGN_EPI) { if (wr == 0) PG8_BAR; }
        if constexpr (Sched::STREAMK) { __builtin_amdgcn_sched_barrier(0); if (cur.kind == 2) S.add_slab(acc, cur, wid, lane); __builtin_amdgcn_sched_barrier(0);
            if (cur.kind == 1) { if constexpr (Epi::KHOOK) E.pre_slab(acc, cur, wr, wc, fr, fq); S.store_slab(acc, cur, wid, lane); } else E(acc, cur, wr, wc, fr, fq); __builtin_amdgcn_sched_barrier(0); }
        else if constexpr (!Epi::AFTER_DRAIN) { E(acc, cur, wr, wc, fr, fq); S.done(cur); }
        if (!has_next) break;
#pragma unroll
        for (int a = 0; a < 2; ++a)
#pragma unroll
            for (int b = 0; b < 2; ++b)
#pragma unroll
                for (int m = 0; m < 4; ++m)
#pragma unroll
                    for (int n = 0; n < 2; ++n) acc[a][b][m][n] = (f32x4){0.f, 0.f, 0.f, 0.f};
        cur = nxt; cA = nA; cB = nB; ++ui; cnt = cur.nt < 0 ? nt : cur.nt;
        if constexpr (ALIGN_EPI) { if (wr == 1) PG8_BAR; }
    }
    PG8_WAIT_V(0);
    if constexpr (!ALIGN_EPI) { if (wr == 0) PG8_BAR; }
    PG8_BAR;
    if constexpr (Epi::AFTER_DRAIN) { E.fused(acc, cur, wr, wc, fr, fq, lds, wid, lane); S.done(cur); }
#undef PG8_SA
#undef PG8_SB
#undef PG8_STAGE
#undef PG8_LDA
#undef PG8_LDB
#undef PG8_MMA
#undef PG8_WAIT_V
#undef PG8_WAIT_L
#undef PG8_BAR
#undef PG8_SCHED
}
}

#ifndef PG8_SP2
#define PG8_SP2 true
#endif
#ifndef PG8_ALIGN
#define PG8_ALIGN true
#endif

constexpr int DM = 4096, NTP = 8192, NTS = 512, MTOK = 8704, DFF = 11008, SEQ = 2048, NB = 4, NDB = 128, DSEQ = 4;
constexpr int PA = 6592, PA_PAD = 6656, PBW = 3072, PCW = 1024, PGW = 12288, NWIN = 23040, PIN = 22976;
constexpr int DA = 2048, HA = 32, NMEM = 256;
constexpr float EPS = 1e-6f, GN_EPS = 64e-5f;
constexpr float QSCALE = 0.0625f * 1.4426950408889634f;

constexpr size_t O_Y = 0, O_MK = 35651584, O_MV = 36700160, O_RWP = 37748736, O_SHP = 38273024, O_CVP = 38299392, O_RWS = 38307584, O_SHS = 55084800, O_CVS = 55928576, O_END = 56190720;

constexpr size_t al256(size_t x) { return (x + 255) & ~(size_t)255; }
constexpr size_t WS_CTL = 0, CTL_BYTES = 1u << 20;
constexpr size_t WS_W1A = WS_CTL + CTL_BYTES;
constexpr size_t WS_W1B = WS_W1A + (size_t)2 * DFF * DM * 2;
constexpr size_t WS_WIN = WS_W1B + (size_t)DM * DFF * 2;
constexpr size_t WS_WMEM = WS_WIN + (size_t)NWIN * DM * 2;
constexpr size_t WS_WBRA = WS_WMEM + (size_t)2048 * DM * 2;
constexpr size_t WS_WBRB = WS_WBRA + (size_t)DM * 2048 * 2;
constexpr size_t WS_WBRC = WS_WBRB + (size_t)DM * 1024 * 2;
constexpr size_t WS_WOUT = WS_WBRC + (size_t)DM * 1024 * 2;
constexpr size_t WS_W2A = WS_WOUT + (size_t)DM * DM * 2;
constexpr size_t WS_W2B = WS_W2A + (size_t)2 * DFF * DM * 2;
constexpr size_t WS_WLWA = WS_W2B + (size_t)DM * DFF * 2;
constexpr size_t WS_WLG = WS_WLWA + (size_t)4096 * 256 * 2;
constexpr size_t WS_XB = WS_WLG + (size_t)2048 * 256 * 2;
constexpr size_t WS_ACT = WS_XB + (size_t)MTOK * DM * 2;
constexpr size_t WS_PAF = WS_ACT + (size_t)MTOK * DFF * 2;
constexpr size_t WS_PB = WS_PAF + (size_t)MTOK * PA_PAD * 4;
constexpr size_t WS_Q = WS_PB + (size_t)MTOK * PBW * 2;
constexpr size_t WS_GATE = WS_Q + (size_t)MTOK * PCW * 2;
constexpr size_t WS_LIN = WS_GATE + (size_t)MTOK * PGW * 2;
constexpr size_t WS_G = WS_LIN + (size_t)MTOK * 512 * 2;
constexpr size_t WS_YA = WS_G + (size_t)MTOK * 2048 * 2;
constexpr size_t WS_YB = WS_YA + (size_t)MTOK * 2048 * 2;
constexpr size_t WS_YC = WS_YB + (size_t)MTOK * 1024 * 2;
constexpr size_t WS_MRG = WS_YC + (size_t)MTOK * 1024 * 2;
constexpr size_t WS_MEMB = WS_MRG + (size_t)MTOK * DM * 2;
constexpr size_t WS_KB = WS_MEMB + (size_t)1024 * DM * 2;
constexpr size_t WS_VT = WS_KB + (size_t)1024 * 1024 * 2;
constexpr size_t WS_SLOT = WS_VT + (size_t)1024 * 1024 * 2;
constexpr size_t WS_RSTD0 = WS_SLOT + (size_t)MTOK * 64 * 4;
constexpr size_t WS_RSTD1 = WS_RSTD0 + 65536;
constexpr size_t WS_RSTD2 = WS_RSTD1 + 65536;
constexpr size_t WS_RSTDM = WS_RSTD2 + 65536;
constexpr size_t WS_INVN = WS_RSTDM + 65536;
constexpr size_t WS_RK = WS_INVN + (size_t)MTOK * 32 * 4;
constexpr size_t WS_SLAB = WS_RK + (size_t)MTOK * 32 * 4;
constexpr size_t WS_END = WS_SLAB + (size_t)256 * 262144;
static_assert(WS_END <= (size_t)2029 * 1024 * 1024, "d_ws map exceeds the guaranteed workspace");
static_assert((size_t)MTOK * 2048 * 4 <= (size_t)MTOK * DM * 2 && (size_t)MTOK * DM * 4 <= (size_t)MTOK * DFF * 2 && (size_t)2 * MTOK * 2048 * 4 <= (size_t)MTOK * DFF * 2, "overlays");
constexpr size_t WS_YSCAN = WS_XB, WS_WDEC = WS_ACT, WS_AVAL = WS_ACT + (size_t)MTOK * 2048 * 4, WS_MACC = WS_ACT;

constexpr int RING_OFF = 0, RING_BYTES = 131072;
constexpr int LDSCTL_OFF = 135168, MISC_OFF = LDSCTL_OFF + 320;
constexpr int LDS_BYTES = 147456;
constexpr int NWAVES = 8;

#define GAS __attribute__((address_space(1)))
#define LAS __attribute__((address_space(3)))
typedef unsigned short bf16;
typedef unsigned v4u __attribute__((ext_vector_type(4)));
typedef unsigned v2u __attribute__((ext_vector_type(2)));
typedef float f32x4 __attribute__((ext_vector_type(4)));
typedef float f32x2 __attribute__((ext_vector_type(2)));
typedef short bf16x8 __attribute__((ext_vector_type(8)));
#define LDS_WAIT() asm volatile("s_waitcnt lgkmcnt(0)" ::: "memory")
#define VM_WAIT() asm volatile("s_waitcnt vmcnt(0)" ::: "memory")
__device__ __forceinline__ unsigned f2bf(float f) { unsigned u = __builtin_bit_cast(unsigned, f); return (u + 0x7fffu + ((u >> 16) & 1u)) >> 16; }
__device__ __forceinline__ unsigned pk2(float lo, float hi) { return f2bf(lo) | (f2bf(hi) << 16); }
__device__ __forceinline__ float bf_lo(unsigned w) { return __builtin_bit_cast(float, w << 16); }
__device__ __forceinline__ float bf_hi(unsigned w) { return __builtin_bit_cast(float, w & 0xffff0000u); }
__device__ __forceinline__ float fast_exp(float x) { return __builtin_amdgcn_exp2f(x * 1.4426950408889634f); }
__device__ __forceinline__ float fast_sigmoid(float x) { return __builtin_amdgcn_rcpf(1.0f + fast_exp(-x)); }
typedef __bf16 bf16x2_t __attribute__((ext_vector_type(2)));
__device__ __forceinline__ unsigned cvt_pk_bf16(float lo, float hi) { f32x2 v = {lo, hi}; bf16x2_t b = __builtin_convertvector(v, bf16x2_t); return __builtin_bit_cast(unsigned, b); }

namespace epi {
using pg8::Unit;
typedef pg8::f32x4 A4;
#define EPI_ACC const A4 (&acc)[2][2][4][2]

struct SwiGLU {
    static constexpr bool PERM = true, AFTER_DRAIN = false, KHOOK = false;
    bf16* O; const float* rstd;
    __device__ __forceinline__ void operator()(EPI_ACC, const Unit& u, int wr, int wc, int fr, int fq) const {
        const int row0 = u.pm * 256 + wr * 64 + fr, col0 = u.pn * 128 + wc * 32 + 8 * fq;
#pragma unroll
        for (int ai = 0; ai < 2; ++ai)
#pragma unroll
            for (int m = 0; m < 4; ++m) {
                const int row = row0 + ai * 128 + m * 16; const float rs = rstd[row];
                float o[8];
#pragma unroll
                for (int n = 0; n < 2; ++n)
#pragma unroll
                    for (int e = 0; e < 4; ++e) { const float g = acc[ai][0][m][n][e] * rs, up = acc[ai][1][m][n][e] * rs; o[n * 4 + e] = g * fast_sigmoid(g) * up; }
                v4u w; w.x = cvt_pk_bf16(o[0], o[1]); w.y = cvt_pk_bf16(o[2], o[3]); w.z = cvt_pk_bf16(o[4], o[5]); w.w = cvt_pk_bf16(o[6], o[7]);
                *(v4u*)(O + (size_t)row * DFF + col0) = w;
            }
    }
};

template <bool BASE_BF16, bool OUT_F32> struct Resid {
    static constexpr bool PERM = true, AFTER_DRAIN = false, KHOOK = false;
    const float* base_p; const float* base_s;
    float* out; bf16* xb; float* slots; float scale;
    __device__ __forceinline__ void row_op(const A4 (&v)[2][2], int row, int pn, int wc, int fq) const {
        const int colb = pn * 256 + wc * 32 + 8 * fq;
        bf16* xp = xb + (size_t)row * DM + colb;
        float ss = 0.f;
#pragma unroll
        for (int bj = 0; bj < 2; ++bj) {
            A4 b0, b1;
            if (BASE_BF16) { const v4u bw = *(const v4u*)(xp + bj * 128); b0 = (A4){bf_lo(bw.x), bf_hi(bw.x), bf_lo(bw.y), bf_hi(bw.y)}; b1 = (A4){bf_lo(bw.z), bf_hi(bw.z), bf_lo(bw.w), bf_hi(bw.w)}; }
            else { const float* bp = (row < NTP ? base_p : base_s) + (size_t)row * DM + colb; b0 = *(const A4*)(bp + bj * 128); b1 = *(const A4*)(bp + bj * 128 + 4); }
            const A4 v0 = b0 + v[bj][0] * scale, v1 = b1 + v[bj][1] * scale;
            if (OUT_F32) { float* op = out + (size_t)row * DM + colb; *(A4*)(op + bj * 128) = v0; *(A4*)(op + bj * 128 + 4) = v1; }
            else { v4u w; w.x = cvt_pk_bf16(v0[0], v0[1]); w.y = cvt_pk_bf16(v0[2], v0[3]); w.z = cvt_pk_bf16(v1[0], v1[1]); w.w = cvt_pk_bf16(v1[2], v1[3]); *(v4u*)(xp + bj * 128) = w; }
            ss += (v0[0] * v0[0] + v0[1] * v0[1]) + (v0[2] * v0[2] + v0[3] * v0[3]) + (v1[0] * v1[0] + v1[1] * v1[1]) + (v1[2] * v1[2] + v1[3] * v1[3]);
        }
        ss += __shfl_xor(ss, 16); ss += __shfl_xor(ss, 32);
        if (fq == 0) slots[(size_t)row * 64 + pn * 4 + wc] = ss;
    }
    __device__ __forceinline__ void operator()(EPI_ACC, const Unit& u, int wr, int wc, int fr, int fq) const {
        const int row0 = u.pm * 256 + wr * 64 + fr;
#pragma unroll
        for (int ai = 0; ai < 2; ++ai)
#pragma unroll
            for (int m = 0; m < 4; ++m) { const A4 v[2][2] = {{acc[ai][0][m][0], acc[ai][0][m][1]}, {acc[ai][1][m][0], acc[ai][1][m][1]}}; row_op(v, row0 + ai * 128 + m * 16, u.pn, wc, fq); }
    }
};

struct Win {
    static constexpr bool PERM = true, AFTER_DRAIN = false, KHOOK = false;
    bf16* pa; bf16* pb; bf16* q; unsigned char* gate; const float* rstd; float* shp; float* shs;
    __device__ __forceinline__ void st8(EPI_ACC, int colb, int row0) const {
#pragma unroll
        for (int ai = 0; ai < 2; ++ai)
#pragma unroll
            for (int m = 0; m < 4; ++m) { const int row = row0 + ai * 128 + m * 16; const float rs = rstd[row]; unsigned char* op = gate + (size_t)row * PGW + colb;
#pragma unroll
                for (int bj = 0; bj < 2; ++bj) { unsigned w[2];
#pragma unroll
                    for (int n = 0; n < 2; ++n) { float g[4];
#pragma unroll
                        for (int e = 0; e < 4; ++e) g[e] = fmaxf(fast_sigmoid(acc[ai][bj][m][n][e] * rs) * 255.0f, 1.0f);
                        unsigned x = __builtin_amdgcn_cvt_pk_u8_f32(g[0], 0, 0u); x = __builtin_amdgcn_cvt_pk_u8_f32(g[1], 1, x); x = __builtin_amdgcn_cvt_pk_u8_f32(g[2], 2, x); x = __builtin_amdgcn_cvt_pk_u8_f32(g[3], 3, x);
                        w[n] = x; }
                    *(v2u*)(op + bj * 128) = (v2u){w[0], w[1]}; } }
    }
    template <bool SG> __device__ __forceinline__ void st16(EPI_ACC, bf16* O, int ld, int colb, float sc, int row0) const {
#pragma unroll
        for (int ai = 0; ai < 2; ++ai)
#pragma unroll
            for (int m = 0; m < 4; ++m) { const int row = row0 + ai * 128 + m * 16; const float rs = rstd[row] * sc; bf16* op = O + (size_t)row * ld + colb;
#pragma unroll
                for (int bj = 0; bj < 2; ++bj) { A4 v0 = acc[ai][bj][m][0] * rs, v1 = acc[ai][bj][m][1] * rs;
                    if (SG) {
#pragma unroll
                        for (int e = 0; e < 4; ++e) { v0[e] = fast_sigmoid(v0[e]); v1[e] = fast_sigmoid(v1[e]); } }
                    v4u w; w.x = cvt_pk_bf16(v0[0], v0[1]); w.y = cvt_pk_bf16(v0[2], v0[3]); w.z = cvt_pk_bf16(v1[0], v1[1]); w.w = cvt_pk_bf16(v1[2], v1[3]);
                    *(v4u*)(op + bj * 128) = w; } }
    }
    __device__ __forceinline__ void operator()(EPI_ACC, const Unit& u, int wr, int wc, int fr, int fq) const {
        const int row0 = u.pm * 256 + wr * 64 + fr, cw = wc * 32 + 8 * fq;
        if (u.pn < 26) {
            const int colb = u.pn * 256 + cw;
#pragma unroll
            for (int ai = 0; ai < 2; ++ai)
#pragma unroll
                for (int m = 0; m < 4; ++m) { const int row = row0 + ai * 128 + m * 16; const float rs = rstd[row]; bf16* op = pa + (size_t)row * PA_PAD + colb;
                    const bool last = row < NTP ? ((row & (SEQ - 1)) == SEQ - 1) : (((row - NTP) & (DSEQ - 1)) == DSEQ - 1);
                    float* sh = row < NTP ? shp + (size_t)(row >> 11) * PA : shs + (size_t)((row - NTP) >> 2) * PA;
#pragma unroll
                    for (int bj = 0; bj < 2; ++bj) { const A4 v0 = acc[ai][bj][m][0] * rs, v1 = acc[ai][bj][m][1] * rs;
                        v4u w; w.x = cvt_pk_bf16(v0[0], v0[1]); w.y = cvt_pk_bf16(v0[2], v0[3]); w.z = cvt_pk_bf16(v1[0], v1[1]); w.w = cvt_pk_bf16(v1[2], v1[3]);
                        *(v4u*)(op + bj * 128) = w;
                        if (last && colb + bj * 128 < PA) { *(A4*)(sh + colb + bj * 128) = v0; *(A4*)(sh + colb + bj * 128 + 4) = v1; } } }
        } else if (u.pn < 38) st16<false>(acc, pb, PBW, (u.pn - 26) * 256 + cw, 1.f, row0);
        else if (u.pn < 42) st16<false>(acc, q, PCW, (u.pn - 38) * 256 + cw, QSCALE, row0);
        else st8(acc, (u.pn - 42) * 256 + cw, row0);
    }
};

struct MemKV {
    static constexpr bool PERM = true, AFTER_DRAIN = false, KHOOK = false;
    float* outk; float* outv; bf16* kb; bf16* vt; const float* rstd;
    __device__ __forceinline__ void operator()(EPI_ACC, const Unit& u, int wr, int wc, int fr, int fq) const {
        const int row0 = u.pm * 256 + wr * 64 + fr; const bool isv = u.pn >= 4; const int h = u.pn & 3; const int cw = wc * 32 + 8 * fq;
        float* of = isv ? outv : outk;
#pragma unroll
        for (int ai = 0; ai < 2; ++ai)
#pragma unroll
            for (int m = 0; m < 4; ++m) { const int row = row0 + ai * 128 + m * 16; const float rs = rstd[row];
                const int b = row >> 8, key = row & 255, kk = key & 31; const int pos = (key & ~31) + 8 * ((kk & 15) >> 2) + (kk & 3) + 4 * (kk >> 4);
#pragma unroll
                for (int bj = 0; bj < 2; ++bj) { const A4 v0 = acc[ai][bj][m][0] * rs, v1 = acc[ai][bj][m][1] * rs; const int d0 = bj * 128 + cw;
                    float* op = of + (size_t)row * 1024 + h * 256 + d0; *(A4*)op = v0; *(A4*)(op + 4) = v1;
                    if (!isv) { v4u w; w.x = cvt_pk_bf16(v0[0], v0[1]); w.y = cvt_pk_bf16(v0[2], v0[3]); w.z = cvt_pk_bf16(v1[0], v1[1]); w.w = cvt_pk_bf16(v1[2], v1[3]);
                        *(v4u*)(kb + (size_t)row * 1024 + h * 256 + d0) = w; }
                    else { bf16* vp = vt + ((size_t)(b * 4 + h) * 256 + d0) * 256 + pos;
#pragma unroll
                        for (int e = 0; e < 4; ++e) { vp[(size_t)e * 256] = (bf16)f2bf(v0[e]); vp[(size_t)(4 + e) * 256] = (bf16)f2bf(v1[e]); } }
                } }
    }
};

struct LoraWA {
    static constexpr bool PERM = true, AFTER_DRAIN = false, KHOOK = false;
    float* wdec; float* aval; const float* w0; const float* a0;
    template <bool ISA> __device__ __forceinline__ void run(EPI_ACC, float* O, const float* bias, int colb, int row0) const {
#pragma unroll
        for (int bj = 0; bj < 2; ++bj)
#pragma unroll
            for (int n = 0; n < 2; ++n) { const A4 bv = *(const A4*)(bias + colb + bj * 128 + 4 * n);
#pragma unroll
                for (int ai = 0; ai < 2; ++ai)
#pragma unroll
                    for (int m = 0; m < 4; ++m) { const int row = row0 + ai * 128 + m * 16; A4 v = acc[ai][bj][m][n] + bv;
#pragma unroll
                        for (int e = 0; e < 4; ++e) { const float x = v[e];
                            if (ISA) v[e] = fast_sigmoid(x);
                            else v[e] = fast_exp(-0.6065306597126334f * fast_sigmoid(x)); }
                        *(A4*)(O + (size_t)row * 2048 + colb + bj * 128 + 4 * n) = v; }
                asm volatile("" ::: "memory"); }
    }
    __device__ __forceinline__ void operator()(EPI_ACC, const Unit& u, int wr, int wc, int fr, int fq) const {
        const int row0 = u.pm * 256 + wr * 64 + fr; const int colb = (u.pn & 7) * 256 + wc * 32 + 8 * fq;
        if (u.pn >= 8) run<true>(acc, aval, a0, colb, row0); else run<false>(acc, wdec, w0, colb, row0);
    }
};
struct LoraG {
    static constexpr bool PERM = true, AFTER_DRAIN = false, KHOOK = false;
    bf16* O;
    __device__ __forceinline__ void operator()(EPI_ACC, const Unit& u, int wr, int wc, int fr, int fq) const {
        const int row0 = u.pm * 256 + wr * 64 + fr, colb = u.pn * 256 + wc * 32 + 8 * fq;
#pragma unroll
        for (int ai = 0; ai < 2; ++ai)
#pragma unroll
            for (int m = 0; m < 4; ++m) { const int row = row0 + ai * 128 + m * 16; bf16* op = O + (size_t)row * 2048 + colb;
#pragma unroll
                for (int bj = 0; bj < 2; ++bj) { const A4 v0 = acc[ai][bj][m][0], v1 = acc[ai][bj][m][1];
                    v4u w; w.x = cvt_pk_bf16(v0[0], v0[1]); w.y = cvt_pk_bf16(v0[2], v0[3]); w.z = cvt_pk_bf16(v1[0], v1[1]); w.w = cvt_pk_bf16(v1[2], v1[3]);
                    *(v4u*)(op + bj * 128) = w; } }
    }
};
struct GateCat {
    static constexpr bool PERM = true, AFTER_DRAIN = false, KHOOK = true;
    const unsigned char* gate; bf16* mrg;
    __device__ __forceinline__ static void unpack8(const v2u w, float (&g)[8]) { g[0] = (float)(w.x & 0xffu); g[1] = (float)((w.x >> 8) & 0xffu); g[2] = (float)((w.x >> 16) & 0xffu); g[3] = (float)(w.x >> 24); g[4] = (float)(w.y & 0xffu); g[5] = (float)((w.y >> 8) & 0xffu); g[6] = (float)((w.y >> 16) & 0xffu); g[7] = (float)(w.y >> 24); }
    template <int MODE> __device__ __forceinline__ void scale(A4 (&acc)[2][2][4][2], const Unit& u, int seg, int wr, int wc, int fr, int fq) const {
        const int row0 = u.pm * 256 + wr * 64 + fr, colb = u.pn * 256 + wc * 32 + 8 * fq;
#pragma unroll
        for (int ai = 0; ai < 2; ++ai)
#pragma unroll
            for (int m = 0; m < 4; ++m) { const unsigned char* gp = gate + (size_t)(row0 + ai * 128 + m * 16) * PGW + seg * DM + colb;
#pragma unroll
                for (int bj = 0; bj < 2; ++bj) { float g[8]; unpack8(*(const v2u*)(gp + bj * 128), g);
                    if (MODE == 1) { float h[8]; unpack8(*(const v2u*)(gp + DM + bj * 128), h);
#pragma unroll
                        for (int e = 0; e < 8; ++e) g[e] *= __builtin_amdgcn_rcpf(h[e]); }
                    else {
#pragma unroll
                        for (int e = 0; e < 8; ++e) g[e] *= (1.0f / 255.0f); }
#pragma unroll
                    for (int e = 0; e < 4; ++e) { acc[ai][bj][m][0][e] *= g[e]; acc[ai][bj][m][1][e] *= g[4 + e]; } }
                asm volatile("" ::: "memory"); }
    }
    __device__ __forceinline__ void khook(A4 (&acc)[2][2][4][2], const Unit& u, int kt, int wr, int wc, int fr, int fq) const { scale<1>(acc, u, kt == 32 ? 0 : 1, wr, wc, fr, fq); }
    __device__ __forceinline__ void pre_slab(A4 (&acc)[2][2][4][2], const Unit& u, int wr, int wc, int fr, int fq) const { scale<0>(acc, u, u.kt0 < 32 ? 0 : (u.kt0 < 48 ? 1 : 2), wr, wc, fr, fq); }
    __device__ __forceinline__ void row_op(const A4 (&v)[2][2], int row, int pn, int wc, int fq) const {
        bf16* op = mrg + (size_t)row * DM + pn * 256 + wc * 32 + 8 * fq;
#pragma unroll
        for (int bj = 0; bj < 2; ++bj) { v4u w; w.x = cvt_pk_bf16(v[bj][0][0], v[bj][0][1]); w.y = cvt_pk_bf16(v[bj][0][2], v[bj][0][3]); w.z = cvt_pk_bf16(v[bj][1][0], v[bj][1][1]); w.w = cvt_pk_bf16(v[bj][1][2], v[bj][1][3]);
            *(v4u*)(op + bj * 128) = w; }
    }
    __device__ __forceinline__ void operator()(EPI_ACC, const Unit& u, int wr, int wc, int fr, int fq) const {
        const int row0 = u.pm * 256 + wr * 64 + fr, colb = u.pn * 256 + wc * 32 + 8 * fq;
#pragma unroll
        for (int ai = 0; ai < 2; ++ai)
#pragma unroll
            for (int m = 0; m < 4; ++m) { const int row = row0 + ai * 128 + m * 16; const unsigned char* gp = gate + (size_t)row * PGW + 2 * DM + colb; A4 v[2][2];
#pragma unroll
                for (int bj = 0; bj < 2; ++bj) { float g[8]; unpack8(*(const v2u*)(gp + bj * 128), g);
#pragma unroll
                    for (int e = 0; e < 4; ++e) { v[bj][0][e] = acc[ai][bj][m][0][e] * (g[e] * (1.0f / 255.0f)); v[bj][1][e] = acc[ai][bj][m][1][e] * (g[4 + e] * (1.0f / 255.0f)); } }
                row_op(v, row, u.pn, wc, fq); }
    }
};
#undef EPI_ACC
}

#define XB_TMO      128
#define XB_XCNT(j)  (256  + 64 * (j))
#define XB_XSUB(j)  (1280 + 64 * (j))
#define XB_XGEN(j)  (2304 + 64 * (j))
#define XB_TOP      3328
#define XB_TOPGEN   3392
#define XCD_BAR_WORDS 3456
#define XB_SPIN_CAP (1u << 18)

__device__ __forceinline__ unsigned xb_ld(unsigned* p)              { return __hip_atomic_load(p, __ATOMIC_RELAXED, __HIP_MEMORY_SCOPE_AGENT); }
__device__ __forceinline__ unsigned xb_add(unsigned* p, unsigned v) { return __hip_atomic_fetch_add(p, v, __ATOMIC_RELAXED, __HIP_MEMORY_SCOPE_AGENT); }
__device__ __forceinline__ unsigned xb_xcc_id() { return (unsigned)__builtin_amdgcn_s_getreg((3 << 11) | 20) & 0xFu; }
#define XB_SPIN(cond, bar) do { unsigned _sp = 0; while (cond) { __builtin_amdgcn_s_sleep(1); \
    if ((++_sp & 255u) == 0u) { if (xb_ld(&(bar)[XB_TMO])) break; if (_sp > XB_SPIN_CAP) { atomicAdd(&(bar)[XB_TMO], 1u); break; } } } } while (0)

struct XcdBarrier {
    unsigned* bar; unsigned x;
    volatile LAS unsigned* st;
};

__device__ __forceinline__ XcdBarrier xcd_barrier_post(unsigned* bar, volatile LAS unsigned* st) {
    XcdBarrier b; b.bar = bar; b.x = xb_xcc_id(); b.st = st;
    if (threadIdx.x == 0) (void)xb_add(&bar[XB_XCNT(b.x)], 1u);
    return b;
}
__device__ __forceinline__ void xcd_barrier_complete(unsigned* bar, unsigned x, unsigned& nloc, unsigned& nx) {
    const unsigned G = gridDim.x * gridDim.y * gridDim.z;
    unsigned sum, cnt, mine, sp = 0u;
    for (;;) {
        sum = 0u; cnt = 0u; mine = 0u;
#pragma unroll
        for (unsigned j = 0; j < 16; ++j) { const unsigned c = xb_ld(&bar[XB_XCNT(j)]); sum += c; cnt += (c > 0u) ? 1u : 0u; mine = (j == x) ? c : mine; }
        if (sum == G) break;
        __builtin_amdgcn_s_sleep(1);
        if ((++sp & 255u) == 0u) { if (xb_ld(&bar[XB_TMO])) break; if (sp > XB_SPIN_CAP) { atomicAdd(&bar[XB_TMO], 1u); break; } }
    }
    nloc = mine > 0u ? mine : 1u; nx = cnt > 0u ? cnt : 1u;
}

__device__ __forceinline__ void xcd_barrier(const XcdBarrier& b) {
    asm volatile("s_waitcnt vmcnt(0)" ::: "memory");
    __syncthreads();
    if (threadIdx.x == 0) {
        unsigned* bar = b.bar;
        __builtin_amdgcn_s_waitcnt(0);
        unsigned nloc = b.st[0], nx = b.st[1];
        if (nloc == 0u) { xcd_barrier_complete(bar, b.x, nloc, nx); b.st[0] = nloc; b.st[1] = nx; }
        const unsigned old = xb_add(&bar[XB_XSUB(b.x)], 1u);
        const unsigned gen = old / nloc;
        if (old + 1u == (gen + 1u) * nloc) {
            __builtin_amdgcn_fence(__ATOMIC_RELEASE, "agent");
            asm volatile("s_waitcnt vmcnt(0)" ::: "memory");
            const unsigned og = xb_add(&bar[XB_TOP], 1u);
            const unsigned tg = og / nx;
            if (og + 1u == (tg + 1u) * nx) xb_add(&bar[XB_TOPGEN], 1u);
            else XB_SPIN(xb_ld(&bar[XB_TOPGEN]) == tg, bar);
            __builtin_amdgcn_fence(__ATOMIC_ACQUIRE, "agent");
            xb_add(&bar[XB_XGEN(b.x)], 1u);
            asm volatile("s_waitcnt vmcnt(0)" ::: "memory");
        } else {
            XB_SPIN(xb_ld(&bar[XB_XGEN(b.x)]) == gen, bar);
            __builtin_amdgcn_fence(__ATOMIC_ACQUIRE, "agent");
            asm volatile("s_waitcnt vmcnt(0)" ::: "memory");
        }
    }
    __syncthreads();
}

struct Args {
    const float* in[35];
    float* out; unsigned char* ws;
    int ph_lo, ph_hi, li, pad;
};
enum In { I_XP = 0, I_XS, I_MEM, I_CK, I_CV, I_SRW, I_SSH, I_SCV, I_GF1, I_WF1I, I_WF1O, I_GMIX, I_WIN, I_MU, I_W0, I_WLU, I_A0, I_ALU, I_GLU, I_KK, I_KA, I_RK, I_LNW, I_LNB, I_CW, I_GMEM, I_WMKV,
          I_WBA, I_WBB, I_WBC, I_WOUT, I_GF2, I_WF2I, I_WF2O, I_GFIN };

struct Ctx { LAS unsigned char* lds; int tid, lane, wave, G, vcu, gw, NGW; };

__device__ __forceinline__ float wave_sum(float v) {
#pragma unroll
    for (int o = 1; o < 64; o <<= 1) v += __shfl_xor(v, o);
    return v;
}
__device__ __forceinline__ float oct_sum(float v) { v += __shfl_xor(v, 1); v += __shfl_xor(v, 2); v += __shfl_xor(v, 4); return v; }

__device__ __forceinline__ void cvt_item(const float* W, int N, const float* gk, bf16* WT, int Kd, int k0, int n0, int drow0, LAS float* scr, int lane) {
    f32x4 v[16];
    const int r4 = lane >> 4, c4 = 4 * (lane & 15);
#pragma unroll
    for (int i = 0; i < 16; ++i) v[i] = *(const f32x4*)(W + (size_t)(k0 + 4 * i + r4) * N + n0 + c4);
    if (gk) {
#pragma unroll
        for (int i = 0; i < 16; ++i) { const float s = gk[k0 + 4 * i + r4]; v[i] = v[i] * s; } }
#pragma unroll
    for (int i = 0; i < 16; ++i) { LAS float* p = scr + (4 * i + r4) * 65 + c4; p[0] = v[i].x; p[1] = v[i].y; p[2] = v[i].z; p[3] = v[i].w; }
    LDS_WAIT(); asm volatile("" ::: "memory");
    const int c = lane & 7;
#pragma unroll
    for (int j = 0; j < 8; ++j) { const int n = (lane >> 3) + 8 * j; const LAS float* s = scr + (8 * c) * 65 + n;
        v4u o; o.x = cvt_pk_bf16(s[0 * 65], s[1 * 65]); o.y = cvt_pk_bf16(s[2 * 65], s[3 * 65]); o.z = cvt_pk_bf16(s[4 * 65], s[5 * 65]); o.w = cvt_pk_bf16(s[6 * 65], s[7 * 65]);
        *(v4u*)(WT + (size_t)(drow0 + n) * Kd + k0 + 8 * c) = o; }
    LDS_WAIT(); asm volatile("" ::: "memory");
}
template <int MAP> __device__ __forceinline__ void cvt_matrix(const Ctx& C, const float* W, int K, int N, const float* gk, bf16* WT, int& base, int Kd = 0) {
    if (Kd == 0) Kd = K;
    const int nblk = N / 64, nitems = (K / 64) * nblk; LAS float* scr = (LAS float*)(C.lds + C.wave * 16640);
    int first = (C.gw - base % C.NGW + C.NGW) % C.NGW;
    for (int it = first; it < nitems; it += C.NGW) {
        const int kb = it / nblk, nb = it % nblk, n0 = 64 * nb; int d;
        if (MAP == 1) { const int j = n0 < DFF ? n0 : n0 - DFF; d = 256 * (j >> 7) + (j & 127) + (n0 < DFF ? 0 : 128); }
        else if (MAP == 2) d = n0 + (n0 >= PA ? 64 : 0);
        else d = n0;
        cvt_item(W, N, gk, WT, Kd, 64 * kb, n0, d, scr, C.lane);
    }
    base += nitems;
}
__device__ __forceinline__ void row_to_bf16(const float* xrow, bf16* orow, float* rstd_out, int lane) {
    const f32x4* xr = (const f32x4*)xrow + lane; f32x4 v[16]; float s = 0.f;
#pragma unroll
    for (int j = 0; j < 16; ++j) { v[j] = xr[64 * j]; s += (v[j].x * v[j].x + v[j].y * v[j].y) + (v[j].z * v[j].z + v[j].w * v[j].w); }
    s = wave_sum(s);
    v2u* o8 = (v2u*)orow + lane;
#pragma unroll
    for (int j = 0; j < 16; ++j) { v2u w; w.x = cvt_pk_bf16(v[j].x, v[j].y); w.y = cvt_pk_bf16(v[j].z, v[j].w); o8[64 * j] = w; }
    if (lane == 0) *rstd_out = 1.0f / sqrtf(s * (1.0f / DM) + EPS);
}
__device__ __forceinline__ void p0_prologue(const Ctx& C, const Args& a) {
    unsigned char* ws = a.ws; int base = 0;
    cvt_matrix<1>(C, a.in[I_WF1I], DM, 2 * DFF, a.in[I_GF1], (bf16*)(ws + WS_W1A), base);
    cvt_matrix<0>(C, a.in[I_WMKV], DM, 2048, a.in[I_GMEM], (bf16*)(ws + WS_WMEM), base);
    { bf16* wl = (bf16*)(ws + WS_WLWA); bf16* wg = (bf16*)(ws + WS_WLG); const float* wu = a.in[I_WLU]; const float* au = a.in[I_ALU]; const float* gu = a.in[I_GLU];
      for (int i = C.gw * 64 + C.lane; i < 6144 * 32; i += C.NGW * 64) { const int n = i % 6144, k0 = 8 * (i / 6144); float f[8];
#pragma unroll
          for (int e = 0; e < 8; ++e) { const int k = k0 + e; float x = 0.f;
              if (n < 2048) { if (k < 96) x = wu[(size_t)k * 2048 + n]; }
              else if (n < 4096) { if (k >= 128 && k < 224) x = au[(size_t)(k - 128) * 2048 + (n - 2048)]; }
              else x = gu[(size_t)k * 2048 + (n - 4096)];
              f[e] = x; }
          v4u o; o.x = pk2(f[0], f[1]); o.y = pk2(f[2], f[3]); o.z = pk2(f[4], f[5]); o.w = pk2(f[6], f[7]);
          bf16* dst = n < 4096 ? wl + (size_t)n * 256 + k0 : wg + (size_t)(n - 4096) * 256 + k0;
          *(v4u*)dst = o; } }
    for (int m = C.gw; m < MTOK + 1024; m += C.NGW) {
        if (m < MTOK) { const float* xr = m < NTP ? a.in[I_XP] + (size_t)m * DM : a.in[I_XS] + (size_t)(m - NTP) * DM;
            row_to_bf16(xr, (bf16*)(ws + WS_XB) + (size_t)m * DM, (float*)(ws + WS_RSTD0) + m, C.lane); }
        else { const int r = m - MTOK; row_to_bf16(a.in[I_MEM] + (size_t)r * DM, (bf16*)(ws + WS_MEMB) + (size_t)r * DM, (float*)(ws + WS_RSTDM) + r, C.lane); }
    }
}
__device__ __forceinline__ void late_weights(const Ctx& C2, const Args& a) {
    unsigned char* ws = a.ws; int base = 0;
    cvt_matrix<0>(C2, a.in[I_WBA], 2048, DM, nullptr, (bf16*)(ws + WS_WBRA), base, DM);
    cvt_matrix<0>(C2, a.in[I_WBB], 1024, DM, nullptr, (bf16*)(ws + WS_WBRA) + 2048, base, DM);
    cvt_matrix<0>(C2, a.in[I_WBC], 1024, DM, nullptr, (bf16*)(ws + WS_WBRA) + 3072, base, DM);
    cvt_matrix<0>(C2, a.in[I_WOUT], DM, DM, nullptr, (bf16*)(ws + WS_WOUT), base);
    cvt_matrix<1>(C2, a.in[I_WF2I], DM, 2 * DFF, a.in[I_GF2], (bf16*)(ws + WS_W2A), base);
}
__device__ __forceinline__ void win_weights(const Ctx& C, const Args& a) {
    unsigned char* ws = a.ws; int base = 0;
    cvt_matrix<2>(C, a.in[I_WIN], DM, PIN, a.in[I_GMIX], (bf16*)(ws + WS_WIN), base);
    { v4u z = {0u, 0u, 0u, 0u}; v4u* p = (v4u*)((bf16*)(ws + WS_WIN) + (size_t)PA * DM);
      for (int i = C.gw * 64 + C.lane; i < 64 * DM / 8; i += C.NGW * 64) p[i] = z; }
}
__device__ __forceinline__ void rstd_phase(const Ctx& C, const float* slots, float* rstd) {
    for (int m = C.gw; m < MTOK; m += C.NGW) { const float s = wave_sum(slots[(size_t)m * 64 + C.lane]); if (C.lane == 0) rstd[m] = 1.0f / sqrtf(s * (1.0f / DM) + EPS); }
}
__device__ __forceinline__ void final_norm(const Ctx& C, const Args& a) {
    const float* slots = (const float*)(a.ws + WS_SLOT); const f32x4* gf = (const f32x4*)a.in[I_GFIN]; const bf16* xb = (const bf16*)(a.ws + WS_XB);
    for (int m = C.gw; m < MTOK; m += C.NGW) {
        const float s = wave_sum(slots[(size_t)m * 64 + C.lane]); const float rs = 1.0f / sqrtf(s * (1.0f / DM) + EPS);
        const v4u* xr = (const v4u*)(xb + (size_t)m * DM) + C.lane; f32x4* yr = (f32x4*)(a.out + O_Y + (size_t)m * DM);
#pragma unroll
        for (int j = 0; j < 8; ++j) { const v4u w = xr[64 * j]; const int c4 = (64 * j + C.lane) * 2;
            const f32x4 g0 = gf[c4], g1 = gf[c4 + 1];
            yr[c4] = (f32x4){bf_lo(w.x), bf_hi(w.x), bf_lo(w.y), bf_hi(w.y)} * rs * g0; yr[c4 + 1] = (f32x4){bf_lo(w.z), bf_hi(w.z), bf_lo(w.w), bf_hi(w.w)} * rs * g1; }
    }
}

__device__ __forceinline__ void ld8(const float* p, float (&f)[8]) { const f32x4 x = *(const f32x4*)p, y = *(const f32x4*)(p + 4); f[0] = x.x; f[1] = x.y; f[2] = x.z; f[3] = x.w; f[4] = y.x; f[5] = y.y; f[6] = y.z; f[7] = y.w; }
__device__ __forceinline__ void ld8b(const bf16* p, float (&f)[8]) { const v4u w = *(const v4u*)p; f[0] = bf_lo(w.x); f[1] = bf_hi(w.x); f[2] = bf_lo(w.y); f[3] = bf_hi(w.y); f[4] = bf_lo(w.z); f[5] = bf_hi(w.z); f[6] = bf_lo(w.w); f[7] = bf_hi(w.w); }
__device__ __forceinline__ void r1_phase(const Ctx& C, const Args& a) {
    const bf16* pa = (const bf16*)(a.ws + WS_PAF); bf16* lin = (bf16*)(a.ws + WS_LIN); const float* mu = a.in[I_MU];
    const int o = 8 * C.lane; int src = -1, mode = 0;
    if (o < 96) { src = 6144 + o; mode = 0; } else if (o < 128) src = -1; else if (o < 224) { src = 6240 + (o - 128); mode = 1; } else if (o < 256) src = -1; else { src = 6336 + (o - 256); mode = 2; }
    for (int m = C.gw; m < MTOK; m += C.NGW) {
        const int t = m < NTP ? (m & (SEQ - 1)) : ((m - NTP) & (DSEQ - 1)); const bf16* cur = pa + (size_t)m * PA_PAD;
        float f[8];
#pragma unroll
        for (int e = 0; e < 8; ++e) f[e] = 0.f;
        if (src >= 0) { float c[8], p[8], u[8]; ld8b(cur + src, c); ld8(mu + src, u);
            if (t) ld8b(cur - PA_PAD + src, p); else if (m >= NTP) ld8(a.in[I_SSH] + (size_t)((m - NTP) >> 2) * PA + src, p); else {
#pragma unroll
                for (int e = 0; e < 8; ++e) p[e] = 0.f; }
#pragma unroll
            for (int e = 0; e < 8; ++e) { const float x = c[e] + (p[e] - c[e]) * u[e]; f[e] = mode == 0 ? (1.0f - 2.0f * __builtin_amdgcn_rcpf(1.0f + fast_exp(2.0f * x))) : (mode == 2 ? fast_sigmoid(x) : x); } }
        v4u w; w.x = pk2(f[0], f[1]); w.y = pk2(f[2], f[3]); w.z = pk2(f[4], f[5]); w.w = pk2(f[6], f[7]);
        *(v4u*)(lin + (size_t)m * 512 + o) = w;
    }
}
__device__ __forceinline__ void ldu16(const bf16* row, int c0, float (&u)[16]) {
    const v4u g0 = *(const v4u*)(row + 1024 + c0), g1 = *(const v4u*)(row + 1024 + c0 + 8), u0 = *(const v4u*)(row + 2048 + c0), u1 = *(const v4u*)(row + 2048 + c0 + 8);
    const unsigned gw[8] = {g0.x, g0.y, g0.z, g0.w, g1.x, g1.y, g1.z, g1.w}, uw[8] = {u0.x, u0.y, u0.z, u0.w, u1.x, u1.y, u1.z, u1.w};
#pragma unroll
    for (int i = 0; i < 8; ++i) { u[2 * i] = bf_lo(gw[i]) * bf_lo(uw[i]); u[2 * i + 1] = bf_hi(gw[i]) * bf_hi(uw[i]); }
}
__device__ __forceinline__ void ldf16(const float* p, float (&u)[16]) {
#pragma unroll
    for (int i = 0; i < 4; ++i) { const f32x4 x = *(const f32x4*)(p + 4 * i); u[4 * i] = x.x; u[4 * i + 1] = x.y; u[4 * i + 2] = x.z; u[4 * i + 3] = x.w; }
}
__device__ __forceinline__ void conv_phase(const Args& a, int w, int nw, int lane) {
    const bf16* pb = (const bf16*)(a.ws + WS_PB); bf16* yb = (bf16*)(a.ws + WS_YA) + 2048; const float* cw = a.in[I_CW]; const int c0 = 16 * lane;
    float w0[16], w1[16], w2[16]; ldf16(cw + c0, w0); ldf16(cw + 1024 + c0, w1); ldf16(cw + 2048 + c0, w2);
    for (int m = w; m < MTOK; m += nw) {
        const bool smp = m >= NTP; const int t = smp ? ((m - NTP) & 3) : (m & (SEQ - 1)); const int T = smp ? DSEQ : SEQ;
        const float* buf = smp ? a.in[I_SCV] + (size_t)((m - NTP) >> 2) * 2048 : nullptr;
        const bf16* row = pb + (size_t)m * PBW;
        float u0[16], u1[16], u2[16];
        ldu16(row, c0, u0);
        if (t >= 1) ldu16(row - PBW, c0, u1); else if (smp) ldf16(buf + 1024 + c0, u1); else {
#pragma unroll
            for (int i = 0; i < 16; ++i) u1[i] = 0.f; }
        if (t >= 2) ldu16(row - 2 * PBW, c0, u2); else if (smp) ldf16(buf + (size_t)t * 1024 + c0, u2); else {
#pragma unroll
            for (int i = 0; i < 16; ++i) u2[i] = 0.f; }
        const v4u b0 = *(const v4u*)(row + c0), b1 = *(const v4u*)(row + c0 + 8); const unsigned bw[8] = {b0.x, b0.y, b0.z, b0.w, b1.x, b1.y, b1.z, b1.w};
        unsigned ow[8];
#pragma unroll
        for (int i = 0; i < 8; ++i) { const float z0 = u2[2 * i] * w0[2 * i] + u1[2 * i] * w1[2 * i] + u0[2 * i] * w2[2 * i], z1 = u2[2 * i + 1] * w0[2 * i + 1] + u1[2 * i + 1] * w1[2 * i + 1] + u0[2 * i + 1] * w2[2 * i + 1];
            ow[i] = pk2(bf_lo(bw[i]) * z0, bf_hi(bw[i]) * z1); }
        v4u o0 = {ow[0], ow[1], ow[2], ow[3]}, o1 = {ow[4], ow[5], ow[6], ow[7]};
        *(v4u*)(yb + (size_t)m * DM + c0) = o0; *(v4u*)(yb + (size_t)m * DM + c0 + 8) = o1;
        if (t >= T - 2) { float* dst = (smp ? a.out + O_CVS + (size_t)((m - NTP) >> 2) * 2048 : a.out + O_CVP + (size_t)(m >> 11) * 2048) + (size_t)(t - (T - 2)) * 1024 + c0;
#pragma unroll
            for (int i = 0; i < 4; ++i) *(f32x4*)(dst + 4 * i) = (f32x4){u0[4 * i], u0[4 * i + 1], u0[4 * i + 2], u0[4 * i + 3]}; }
    }
}

template <int CTRL> __device__ __forceinline__ float dpp_mov(float v) { return __builtin_bit_cast(float, __builtin_amdgcn_update_dpp(0, __builtin_bit_cast(int, v), CTRL, 0xf, 0xf, false)); }
__device__ __forceinline__ float oct_sum_dpp(float v) { v += dpp_mov<0xB1>(v); v += dpp_mov<0x4E>(v); v += dpp_mov<0x141>(v); return v; }
constexpr int TC = 16, STG = 6 * TC * 64;
template <int CTRL> __device__ __forceinline__ float dpp_add(float v) { return v + dpp_mov<CTRL>(v); }
__device__ __forceinline__ float row16_sum(float v) { v = dpp_add<0xB1>(v); v = dpp_add<0x4E>(v); v = dpp_add<0x141>(v); v = dpp_add<0x140>(v); return v; }
struct StageRegs { f32x4 cr, ck, cv, pr, pk, pv, la, lw; v2u g; };
struct StagePar { f32x4 mur, muk, muv, kkp, kap, rkp; };
__device__ __forceinline__ f32x4 ld4b(const bf16* p) { const v2u w = *(const v2u*)p; return (f32x4){bf_lo(w.x), bf_hi(w.x), bf_lo(w.y), bf_hi(w.y)}; }
__device__ __forceinline__ void stage_load(StageRegs& R, const Args& a, const float* shift_prev, int tok0, int tl, int T, int cj) {
    const f32x4 z = {0.f, 0.f, 0.f, 0.f};
    if (tl < T) {
        const int tok = tok0 + tl; const bf16* P = (const bf16*)(a.ws + WS_PAF) + (size_t)tok * PA_PAD + cj;
        R.cr = ld4b(P); R.ck = ld4b(P + 2048); R.cv = ld4b(P + 4096);
        if (tl > 0) { const bf16* Q = P - PA_PAD; R.pr = ld4b(Q); R.pk = ld4b(Q + 2048); R.pv = ld4b(Q + 4096); }
        else if (shift_prev) { const float* Q = shift_prev + cj; R.pr = *(const f32x4*)Q; R.pk = *(const f32x4*)(Q + 2048); R.pv = *(const f32x4*)(Q + 4096); }
        else { R.pr = z; R.pk = z; R.pv = z; }
        R.la = *(const f32x4*)((const float*)(a.ws + WS_AVAL) + (size_t)tok * 2048 + cj); R.lw = *(const f32x4*)((const float*)(a.ws + WS_WDEC) + (size_t)tok * 2048 + cj);
        R.g = *(const v2u*)((const bf16*)(a.ws + WS_G) + (size_t)tok * 2048 + cj);
    } else { R.cr = z; R.ck = z; R.cv = z; R.pr = z; R.pk = z; R.pv = z; R.la = z; R.lw = z; R.g = (v2u){0u, 0u}; }
}
__device__ __forceinline__ float sum4(const f32x4 v) { return (v.x + v.y) + (v.z + v.w); }
__device__ __forceinline__ float stage_store(const StageRegs& R, LAS float* B, LAS float* BRK, int st, int cq, const StagePar& P) {
    const f32x4 rs = R.cr + (R.pr - R.cr) * P.mur, ks = R.ck + (R.pk - R.ck) * P.muk, vs = R.cv + (R.pv - R.cv) * P.muv;
    const f32x4 kr_ = ks * P.kkp, kp = ks * (1.0f + (R.la - 1.0f) * P.kap);
    const float ss = row16_sum(sum4(kr_ * kr_));
    const float inv = 1.0f / fmaxf(sqrtf(ss), 1e-12f);
    const f32x4 kk = kr_ * inv, bv = kk * R.la;
    const float br = row16_sum(sum4(bv * rs)), kr = row16_sum(sum4(kp * rs)), rk = row16_sum(sum4(rs * kp * P.rkp));
    LAS float* p = B + st * 64 + 4 * cq;
    *(LAS f32x4*)(p) = -kk; *(LAS f32x4*)(p + TC * 64) = R.lw; *(LAS f32x4*)(p + 2 * TC * 64) = bv; *(LAS f32x4*)(p + 3 * TC * 64) = kp; *(LAS f32x4*)(p + 4 * TC * 64) = R.lw * rs; *(LAS f32x4*)(p + 5 * TC * 64) = vs;
    if (cq == 0) *(LAS f32x2*)(BRK + st * 2) = (f32x2){br, kr};
    return rk;
}
struct Carry { float rk; v2u g; };
__device__ __forceinline__ void post_store(const LAS float* yv, const LAS float* vv, const Carry& cy, const f32x4 lnw, const f32x4 lnb, bf16* dst) {
    f32x4 y = *(const LAS f32x4*)yv; const f32x4 v = *(const LAS f32x4*)vv;
    const float mean = row16_sum(sum4(y)) * (1.0f / 64.0f); y = y - mean;
    const float rs = 1.0f / sqrtf(row16_sum(sum4(y * y)) * (1.0f / 64.0f) + GN_EPS);
    const f32x4 g = {bf_lo(cy.g.x), bf_hi(cy.g.x), bf_lo(cy.g.y), bf_hi(cy.g.y)};
    const f32x4 o = (y * rs * lnw + lnb + v * cy.rk) * g;
    v2u w; w.x = cvt_pk_bf16(o.x, o.y); w.y = cvt_pk_bf16(o.z, o.w);
    *(v2u*)dst = w;
}
__device__ __forceinline__ void row8_sum4(float& a0, float& a1, float& a2, float& a3) {
#define R8_OP(n, ctl) "v_add_f32_dpp %" #n ", %" #n ", %" #n " " ctl " row_mask:0xf bank_mask:0xf bound_ctrl:1\n\t"
#define R8_STAGE(ctl) R8_OP(0, ctl) R8_OP(1, ctl) R8_OP(2, ctl) R8_OP(3, ctl)
    asm volatile("s_nop 1\n\t" R8_STAGE("quad_perm:[1,0,3,2]") R8_STAGE("quad_perm:[2,3,0,1]") R8_STAGE("row_half_mirror") "s_nop 1"
        : "+v"(a0), "+v"(a1), "+v"(a2), "+v"(a3));
#undef R8_STAGE
#undef R8_OP
}
struct StepOps { f32x4 a[2], w[2], b[2], k[2], r[2]; f32x2 v, brk; };
__device__ __forceinline__ void step_load(StepOps& o, const LAS float* bt, const LAS float* vt, const LAS float* brk) {
#pragma unroll
    for (int j = 0; j < 2; ++j) { o.a[j] = *(const LAS f32x4*)(bt + 4 * j); o.w[j] = *(const LAS f32x4*)(bt + TC * 64 + 4 * j); o.b[j] = *(const LAS f32x4*)(bt + 2 * TC * 64 + 4 * j); o.k[j] = *(const LAS f32x4*)(bt + 3 * TC * 64 + 4 * j); o.r[j] = *(const LAS f32x4*)(bt + 4 * TC * 64 + 4 * j); }
    o.v = *(const LAS f32x2*)vt; o.brk = *(const LAS f32x2*)brk;
}
__device__ __forceinline__ f32x2 lo2(const f32x4 v) { return (f32x2){v.x, v.y}; }
__device__ __forceinline__ f32x2 hi2(const f32x4 v) { return (f32x2){v.z, v.w}; }
#define PKB0 "op_sel:[0,0,0] op_sel_hi:[1,0,1]"
#define PKB1 "op_sel:[0,1,0] op_sel_hi:[1,1,1]"
__device__ __forceinline__ void blk_partials(const f32x2 (&S)[8], const f32x2 (&a2)[4], const f32x2 (&r2)[4], f32x2& s, f32x2& y) {
    f32x2 s1, y1;
    asm("v_pk_mul_f32 %0, %4, %12 op_sel:[0,0] op_sel_hi:[1,0]\n\tv_pk_mul_f32 %1, %8, %14 op_sel:[0,0] op_sel_hi:[1,0]\n\t"
        "v_pk_mul_f32 %2, %4, %16 op_sel:[0,0] op_sel_hi:[1,0]\n\tv_pk_mul_f32 %3, %8, %18 op_sel:[0,0] op_sel_hi:[1,0]\n\t"
        "v_pk_fma_f32 %0, %5, %12, %0 " PKB1 "\n\tv_pk_fma_f32 %1, %9, %14, %1 " PKB1 "\n\tv_pk_fma_f32 %2, %5, %16, %2 " PKB1 "\n\tv_pk_fma_f32 %3, %9, %18, %3 " PKB1 "\n\t"
        "v_pk_fma_f32 %0, %6, %13, %0 " PKB0 "\n\tv_pk_fma_f32 %1, %10, %15, %1 " PKB0 "\n\tv_pk_fma_f32 %2, %6, %17, %2 " PKB0 "\n\tv_pk_fma_f32 %3, %10, %19, %3 " PKB0 "\n\t"
        "v_pk_fma_f32 %0, %7, %13, %0 " PKB1 "\n\tv_pk_fma_f32 %1, %11, %15, %1 " PKB1 "\n\tv_pk_fma_f32 %2, %7, %17, %2 " PKB1 "\n\tv_pk_fma_f32 %3, %11, %19, %3 " PKB1 "\n\t"
        "v_pk_add_f32 %0, %0, %1\n\tv_pk_add_f32 %2, %2, %3"
        : "=&v"(s), "=&v"(s1), "=&v"(y), "=&v"(y1)
        : "v"(S[0]), "v"(S[1]), "v"(S[2]), "v"(S[3]), "v"(S[4]), "v"(S[5]), "v"(S[6]), "v"(S[7]), "v"(a2[0]), "v"(a2[1]), "v"(a2[2]), "v"(a2[3]), "v"(r2[0]), "v"(r2[1]), "v"(r2[2]), "v"(r2[3]));
}
__device__ __forceinline__ void blk_update(f32x2& Se, f32x2& So, const f32x2 sa, const f32x2 v, const f32x2 w2, const f32x2 b2, const f32x2 k2) {
    f32x2 t0, t1;
    asm("v_pk_mul_f32 %2, %5, %8 op_sel:[0,0] op_sel_hi:[1,0]\n\tv_pk_mul_f32 %3, %5, %8 op_sel:[0,1] op_sel_hi:[1,1]\n\t"
        "v_pk_fma_f32 %2, %4, %7, %2 " PKB0 "\n\tv_pk_fma_f32 %3, %4, %7, %3 " PKB1 "\n\t"
        "v_pk_fma_f32 %0, %0, %6, %2 " PKB0 "\n\tv_pk_fma_f32 %1, %1, %6, %3 " PKB1
        : "+v"(Se), "+v"(So), "=&v"(t0), "=&v"(t1) : "v"(sa), "v"(v), "v"(w2), "v"(b2), "v"(k2));
}
__device__ __forceinline__ void blk_yfin(f32x2& y, const f32x2 sa, const f32x2 v, const f32x2 brk) {
    asm("v_pk_fma_f32 %0, %1, %3, %0 " PKB0 "\n\tv_pk_fma_f32 %0, %2, %3, %0 " PKB1 : "+v"(y) : "v"(sa), "v"(v), "v"(brk));
}
#undef PKB0
#undef PKB1
__device__ __forceinline__ void step_math(const StepOps& o, f32x2 (&S)[8], LAS float* yp, bool wr) {
    const f32x2 a2[4] = {lo2(o.a[0]), hi2(o.a[0]), lo2(o.a[1]), hi2(o.a[1])}, r2[4] = {lo2(o.r[0]), hi2(o.r[0]), lo2(o.r[1]), hi2(o.r[1])};
    const f32x2 w2[4] = {lo2(o.w[0]), hi2(o.w[0]), lo2(o.w[1]), hi2(o.w[1])}, b2[4] = {lo2(o.b[0]), hi2(o.b[0]), lo2(o.b[1]), hi2(o.b[1])}, k2[4] = {lo2(o.k[0]), hi2(o.k[0]), lo2(o.k[1]), hi2(o.k[1])};
    f32x2 s, y; blk_partials(S, a2, r2, s, y);
    float r0 = s.x, r1 = s.y, r2v = y.x, r3 = y.y;
    row8_sum4(r0, r1, r2v, r3);
    const f32x2 sa = {r0, r1}; f32x2 yo = {r2v, r3};
#pragma unroll
    for (int p = 0; p < 4; ++p) blk_update(S[2 * p], S[2 * p + 1], sa, o.v, w2[p], b2[p], k2[p]);
    blk_yfin(yo, sa, o.v, o.brk);
    if (wr) *(LAS f32x2*)yp = yo;
}
__device__ __forceinline__ void scan_unit(const Ctx& C, const Args& a, int tok0, int T, const float* shift_prev, const float* s_in, float* s_out, int h) {
    LAS float* L = (LAS float*)C.lds; LAS float* Y = L + 2 * STG; LAS float* BRK = Y + 2 * TC * 64;
    const int NC = (T + TC - 1) / TC; const bool comp = C.wave < 4;
    const int t2 = C.tid - 256, st = t2 >> 4, cq = t2 & 15, cj = h * 64 + 4 * cq;
    bf16* yout = (bf16*)(a.ws + WS_YA) + (size_t)tok0 * DM + cj;
    StagePar P; StageRegs R; Carry cA, cB; f32x4 lnw, lnb; cA.rk = 0.f; cA.g = (v2u){0u, 0u}; cB = cA;
    const int row = 16 * C.wave + 2 * (C.lane >> 3), cg = C.lane & 7; const bool wr = (cg == 0);
    f32x2 S[8];
    if (comp) {
        if (s_in) {
#pragma unroll
            for (int j = 0; j < 2; ++j) { const f32x4 x0 = *(const f32x4*)(s_in + row * 64 + 8 * cg + 4 * j), x1 = *(const f32x4*)(s_in + (row + 1) * 64 + 8 * cg + 4 * j);
#pragma unroll
                for (int e = 0; e < 4; ++e) S[4 * j + e] = (f32x2){x0[e], x1[e]}; } }
        else {
#pragma unroll
            for (int e = 0; e < 8; ++e) S[e] = (f32x2){0.f, 0.f}; }
    } else {
        const float* mu = a.in[I_MU];
        P.mur = *(const f32x4*)(mu + cj); P.muk = *(const f32x4*)(mu + 2048 + cj); P.muv = *(const f32x4*)(mu + 4096 + cj); P.kkp = *(const f32x4*)(a.in[I_KK] + cj); P.kap = *(const f32x4*)(a.in[I_KA] + cj); P.rkp = *(const f32x4*)(a.in[I_RK] + cj);
        lnw = *(const f32x4*)(a.in[I_LNW] + cj); lnb = *(const f32x4*)(a.in[I_LNB] + cj);
        stage_load(R, a, shift_prev, tok0, st, T, cj); cB.g = R.g; cB.rk = stage_store(R, L, BRK, st, cq, P);
        if (NC > 1) stage_load(R, a, shift_prev, tok0, TC + st, T, cj);
    }
    __syncthreads();
#pragma unroll 1
    for (int c = 0; c < NC; ++c) {
        const int cur = c & 1;
        if (comp) {
            const LAS float* B = L + cur * STG + 8 * cg; const LAS float* V = L + cur * STG + 5 * TC * 64 + row; const LAS float* K2 = BRK + cur * TC * 2; LAS float* Yb = Y + cur * TC * 64 + row;
            const int ns = (T - c * TC) < TC ? (T - c * TC) : TC;
            if (ns == TC) {
                StepOps o0, o1; step_load(o0, B, V, K2);
#pragma unroll
                for (int t = 0; t < TC; t += 2) {
                    step_load(o1, B + (t + 1) * 64, V + (t + 1) * 64, K2 + (t + 1) * 2);
                    step_math(o0, S, Yb + t * 64, wr);
                    if (t + 2 < TC) step_load(o0, B + (t + 2) * 64, V + (t + 2) * 64, K2 + (t + 2) * 2);
                    step_math(o1, S, Yb + (t + 1) * 64, wr);
                }
            } else {
#pragma unroll 1
                for (int t = 0; t < ns; ++t) { StepOps o; step_load(o, B + t * 64, V + t * 64, K2 + t * 2); step_math(o, S, Yb + t * 64, wr); }
            }
        } else {
            if (c > 0 && (c - 1) * TC + st < T) post_store(Y + (cur ^ 1) * TC * 64 + st * 64 + 4 * cq, L + (cur ^ 1) * STG + 5 * TC * 64 + st * 64 + 4 * cq, cA, lnw, lnb, yout + (size_t)((c - 1) * TC + st) * DM);
            Carry cN = cB;
            if (c + 1 < NC) { cN.g = R.g; cN.rk = stage_store(R, L + (cur ^ 1) * STG, BRK + (cur ^ 1) * TC * 2, st, cq, P); if (c + 2 < NC) stage_load(R, a, shift_prev, tok0, (c + 2) * TC + st, T, cj); }
            cA = cB; cB = cN;
        }
        __syncthreads();
    }
    if (comp) {
#pragma unroll
        for (int j = 0; j < 2; ++j) { *(f32x4*)(s_out + row * 64 + 8 * cg + 4 * j) = (f32x4){S[4 * j].x, S[4 * j + 1].x, S[4 * j + 2].x, S[4 * j + 3].x};
            *(f32x4*)(s_out + (row + 1) * 64 + 8 * cg + 4 * j) = (f32x4){S[4 * j].y, S[4 * j + 1].y, S[4 * j + 2].y, S[4 * j + 3].y}; }
    } else {
        const int cl = NC - 1; if (cl * TC + st < T) post_store(Y + (cl & 1) * TC * 64 + st * 64 + 4 * cq, L + (cl & 1) * STG + 5 * TC * 64 + st * 64 + 4 * cq, cA, lnw, lnb, yout + (size_t)(cl * TC + st) * DM);
    }
}

__device__ __forceinline__ bf16x8 pack8(const f32x4 x, const f32x4 y) { v4u w; w.x = cvt_pk_bf16(x[0], x[1]); w.y = cvt_pk_bf16(x[2], x[3]); w.z = cvt_pk_bf16(y[0], y[1]); w.w = cvt_pk_bf16(y[2], y[3]); return __builtin_bit_cast(bf16x8, w); }
__device__ __forceinline__ void attn_prompt_unit(const Args& a, int u, int wave, int lane) {
    const int b = u >> 6, h = (u >> 4) & 3, qt = u & 15, fr = lane & 15, g = lane >> 4;
    const bf16* q = (const bf16*)(a.ws + WS_Q); const bf16* kb = (const bf16*)(a.ws + WS_KB); const bf16* vt = (const bf16*)(a.ws + WS_VT); bf16* yc = (bf16*)(a.ws + WS_YA) + 3072;
    const int tok = b * SEQ + qt * 128 + wave * 16 + fr;
    bf16x8 qf[8];
#pragma unroll
    for (int ks = 0; ks < 8; ++ks) qf[ks] = *(const bf16x8*)(q + (size_t)tok * 1024 + h * 256 + 32 * ks + 8 * g);
    f32x4 st[16];
#pragma unroll
    for (int T = 0; T < 16; ++T) { st[T] = (f32x4){0.f, 0.f, 0.f, 0.f}; const bf16* kr = kb + (size_t)(b * 256 + 16 * T + fr) * 1024 + h * 256 + 8 * g;
#pragma unroll
        for (int ks = 0; ks < 8; ++ks) { const bf16x8 kf = *(const bf16x8*)(kr + 32 * ks); st[T] = __builtin_amdgcn_mfma_f32_16x16x32_bf16(kf, qf[ks], st[T], 0, 0, 0); } }
    float mx = -3.0e38f;
#pragma unroll
    for (int T = 0; T < 16; ++T) mx = fmaxf(fmaxf(fmaxf(st[T][0], st[T][1]), fmaxf(st[T][2], st[T][3])), mx);
    mx = fmaxf(mx, __shfl_xor(mx, 16)); mx = fmaxf(mx, __shfl_xor(mx, 32));
    float sum = 0.f;
#pragma unroll
    for (int T = 0; T < 16; ++T)
#pragma unroll
        for (int r = 0; r < 4; ++r) { const float p = __builtin_amdgcn_exp2f(st[T][r] - mx); st[T][r] = p; sum += p; }
    sum += __shfl_xor(sum, 16); sum += __shfl_xor(sum, 32);
    const float inv = 1.0f / sum;
    bf16x8 pf[8];
#pragma unroll
    for (int ks = 0; ks < 8; ++ks) pf[ks] = pack8(st[2 * ks], st[2 * ks + 1]);
#pragma unroll
    for (int dt = 0; dt < 16; ++dt) { f32x4 o = {0.f, 0.f, 0.f, 0.f}; const bf16* vr = vt + ((size_t)(b * 4 + h) * 256 + 16 * dt + fr) * 256 + 8 * g;
#pragma unroll
        for (int ks = 0; ks < 8; ++ks) { const bf16x8 vf = *(const bf16x8*)(vr + 32 * ks); o = __builtin_amdgcn_mfma_f32_16x16x32_bf16(vf, pf[ks], o, 0, 0, 0); }
        o = o * inv; v2u w; w.x = cvt_pk_bf16(o[0], o[1]); w.y = cvt_pk_bf16(o[2], o[3]);
        *(v2u*)(yc + (size_t)tok * DM + h * 256 + 16 * dt + 4 * g) = w; }
}
__device__ __forceinline__ void attn_sample_unit(const Ctx& C, const Args& a, int u) {
    const int db = u >> 2, h = u & 3, lane = C.lane, wave = C.wave, fr = lane & 15, g = lane >> 4;
    LAS float* sc = (LAS float*)C.lds; LAS float* red = sc + 1024; LAS float* sinv = red + 8192;
    const float* ck = a.in[I_CK] + (size_t)db * 256 * 1024 + h * 256; const float* cv = a.in[I_CV] + (size_t)db * 256 * 1024 + h * 256;
    const bf16* q = (const bf16*)(a.ws + WS_Q) + (size_t)(NTP + db * 4) * 1024 + h * 256; bf16* yc = (bf16*)(a.ws + WS_YA) + 3072 + (size_t)(NTP + db * 4) * DM + h * 256;
    bf16x8 qf[8];
#pragma unroll
    for (int ks = 0; ks < 8; ++ks) { const v4u z = {0u, 0u, 0u, 0u}; qf[ks] = __builtin_bit_cast(bf16x8, z); if (fr < 4) qf[ks] = *(const bf16x8*)(q + (size_t)fr * 1024 + 32 * ks + 8 * g); }
#pragma unroll
    for (int T2 = 0; T2 < 2; ++T2) { const int key = 32 * wave + 16 * T2 + fr; f32x4 s = {0.f, 0.f, 0.f, 0.f}; const float* kp = ck + (size_t)key * 1024 + 8 * g;
#pragma unroll
        for (int ks = 0; ks < 8; ++ks) { const f32x4 k0 = *(const f32x4*)(kp + 32 * ks), k1 = *(const f32x4*)(kp + 32 * ks + 4); s = __builtin_amdgcn_mfma_f32_16x16x32_bf16(pack8(k0, k1), qf[ks], s, 0, 0, 0); }
        if (fr < 4) *(LAS f32x4*)(sc + fr * 256 + 32 * wave + 16 * T2 + 4 * g) = s; }
    __syncthreads();
    if (wave < 4) { f32x4 v = *(LAS f32x4*)(sc + wave * 256 + 4 * lane); float mx = fmaxf(fmaxf(v[0], v[1]), fmaxf(v[2], v[3]));
#pragma unroll
        for (int o = 1; o < 64; o <<= 1) mx = fmaxf(mx, __shfl_xor(mx, o));
        float s = 0.f;
#pragma unroll
        for (int e = 0; e < 4; ++e) { v[e] = __builtin_amdgcn_exp2f(v[e] - mx); s += v[e]; }
        s = wave_sum(s); *(LAS f32x4*)(sc + wave * 256 + 4 * lane) = v; if (lane == 0) sinv[wave] = 1.0f / s; }
    __syncthreads();
    f32x4 o[4];
#pragma unroll
    for (int t = 0; t < 4; ++t) o[t] = (f32x4){0.f, 0.f, 0.f, 0.f};
#pragma unroll 2
    for (int kk = 0; kk < 32; kk += 4) { f32x4 p[4];
#pragma unroll
        for (int t = 0; t < 4; ++t) p[t] = *(LAS f32x4*)(sc + t * 256 + 32 * wave + kk);
#pragma unroll
        for (int e = 0; e < 4; ++e) { const f32x4 v = *(const f32x4*)(cv + (size_t)(32 * wave + kk + e) * 1024 + 4 * lane);
#pragma unroll
            for (int t = 0; t < 4; ++t) o[t] += v * p[t][e]; } }
#pragma unroll
    for (int t = 0; t < 4; ++t) *(LAS f32x4*)(red + (wave * 4 + t) * 256 + 4 * lane) = o[t];
    __syncthreads();
    { const int t = C.tid >> 7, d = (C.tid & 127) * 2; f32x2 s = {0.f, 0.f};
#pragma unroll
        for (int w = 0; w < 8; ++w) s += *(LAS f32x2*)(red + (w * 4 + t) * 256 + d);
        s = s * sinv[t]; *(unsigned*)(yc + (size_t)t * DM + d) = cvt_pk_bf16(s.x, s.y); }
    __syncthreads();
}

template <class E> __device__ __forceinline__ void tail_combine(const Ctx& C, const E& e, const float* slab, int M, int N, int bx) {
    pg8::StaticOrder so; so.init(M, N, C.G, 0); const int R = so.nwg / C.G, rem = so.nwg - R * C.G; if (rem == 0) return; const int split = C.G / rem;
    const int l = bx / split, q = bx % split; if (l >= rem || q >= 8) return;
    pg8::Unit u; pg8::TailSplitOrder::leftover(N, R, l, u);
    const int ai = q >> 2, m = q & 3, w = C.wave, wr = w >> 2, wc = w & 3, fr = C.lane & 15, fq = C.lane >> 4;
    epi::A4 v[2][2];
#pragma unroll
    for (int bj = 0; bj < 2; ++bj)
#pragma unroll
        for (int n = 0; n < 2; ++n) v[bj][n] = (epi::A4){0.f, 0.f, 0.f, 0.f};
#pragma unroll
    for (int part = 0; part < 8; ++part) { if (part >= split) break; const float* p = slab + ((size_t)((l * split + part) * 8 + w) * 32 * 64 + C.lane) * 4;
#pragma unroll
        for (int bj = 0; bj < 2; ++bj)
#pragma unroll
            for (int n = 0; n < 2; ++n) v[bj][n] += *(const epi::A4*)(p + (size_t)(ai * 16 + bj * 8 + m * 2 + n) * 256); }
    e.row_op(v, u.pm * 256 + ai * 128 + wr * 64 + m * 16 + fr, u.pn, wc, fq);
}

#ifndef MK_ONE_LAUNCH
#define MK_ONE_LAUNCH 1
#endif
constexpr int NPHASE = 16;
constexpr int CW_SKF = 32768;
constexpr int CW_BAR = 4096;

__global__ void __launch_bounds__(NWAVES * 64, 2) mk_fwd(Args args) {
    extern __shared__ __attribute__((aligned(16))) unsigned char lds_raw[];
    Ctx C; C.lds = (LAS unsigned char*)lds_raw; C.tid = threadIdx.x; C.lane = C.tid & 63; C.wave = __builtin_amdgcn_readfirstlane(C.tid >> 6);
    C.G = gridDim.x; { const int bx = blockIdx.x; C.vcu = (C.G % 8 == 0) ? (bx % 8) * (C.G / 8) + bx / 8 : bx; }
    C.gw = C.vcu * NWAVES + C.wave; C.NGW = C.G * NWAVES;
    const Args& a = args; unsigned char* ws = a.ws;
    volatile LAS unsigned* MISC = (volatile LAS unsigned*)(C.lds + MISC_OFF);
    for (int u = C.tid; u < (LDS_BYTES - LDSCTL_OFF) / 4; u += NWAVES * 64) ((LAS unsigned*)(C.lds + LDSCTL_OFF))[u] = 0u;
    __syncthreads();
#if MK_ONE_LAUNCH
    XcdBarrier bar = xcd_barrier_post((unsigned*)(ws + WS_CTL) + CW_BAR + a.li * XCD_BAR_WORDS, MISC + 8);
#define GRID_BAR() xcd_barrier(bar)
#else
#define GRID_BAR() do { } while (0)
#endif
    const int lo = a.ph_lo, hi = a.ph_hi;
#ifndef PH_MASK
#define PH_MASK 0xFFFF
#endif
#define IN(k) ((((PH_MASK) >> (k)) & 1) && lo <= (k) && (k) < hi)
#define SEAM(k) do { if (IN(k) && IN((k) + 1)) GRID_BAR(); } while (0)
    LAS unsigned char* ring = C.lds + RING_OFF;
    const int bx = blockIdx.x;

    if (IN(0)) { p0_prologue(C, a); } SEAM(0);

    if (IN(1)) {
        { pg8::Gemm g{(const bf16*)(ws + WS_XB), (const bf16*)(ws + WS_W1A), MTOK, 2 * DFF, DM, DM, DM}; pg8::XcdOrder S; S.init(2 * DFF, bx);
          epi::SwiGLU E{(bf16*)(ws + WS_ACT), (const float*)(ws + WS_RSTD0)};
          pg8::gemm_phase<epi::SwiGLU, pg8::XcdOrder, PG8_ALIGN, PG8_SP2>(ring, g, S, E); }
        { const int c0 = 112; const int gsub = C.G - c0;
          if (bx >= c0) { pg8::Gemm g{(const bf16*)(ws + WS_MEMB), (const bf16*)(ws + WS_WMEM), 1024, 2048, DM, DM, DM}; pg8::StaticOrder S; S.init(1024, 2048, gsub, bx - c0);
            epi::MemKV E{a.out + O_MK, a.out + O_MV, (bf16*)(ws + WS_KB), (bf16*)(ws + WS_VT), (const float*)(ws + WS_RSTDM)};
            pg8::gemm_phase<epi::MemKV, pg8::StaticOrder, PG8_ALIGN, PG8_SP2>(ring, g, S, E); }
          { const int c1 = c0 + 32; if (bx >= c1) { __syncthreads(); Ctx C2 = C; C2.gw = (bx - c1) * NWAVES + C.wave; C2.NGW = (C.G - c1) * NWAVES; int base = 0;
              cvt_matrix<0>(C2, a.in[I_WF1O], DFF, DM, nullptr, (bf16*)(ws + WS_W1B), base); } } }
    } SEAM(1);

    if (IN(2)) {
        pg8::Gemm g{(const bf16*)(ws + WS_ACT), (const bf16*)(ws + WS_W1B), MTOK, DM, DFF, DFF, DFF}; pg8::TailSplitOrder S; S.init(MTOK, DM, g.K, C.G, bx, (float*)(ws + WS_SLAB));
        epi::Resid<true, false> E{a.out + O_Y, a.out + O_Y, a.out + O_Y, (bf16*)(ws + WS_XB), (float*)(ws + WS_SLOT), 0.5f};
        pg8::gemm_phase<epi::Resid<true, false>, pg8::TailSplitOrder, PG8_ALIGN, PG8_SP2>(ring, g, S, E);
        GRID_BAR(); tail_combine(C, E, (const float*)(ws + WS_SLAB), MTOK, DM, bx);
    } SEAM(2);

    if (IN(3)) { rstd_phase(C, (const float*)(ws + WS_SLOT), (float*)(ws + WS_RSTD1)); win_weights(C, a); } SEAM(3);

    if (IN(4)) {
        pg8::Gemm g{(const bf16*)(ws + WS_XB), (const bf16*)(ws + WS_WIN), MTOK, NWIN, DM, DM, DM}; pg8::XcdOrder S; S.init(NWIN, bx);
        epi::Win E{(bf16*)(ws + WS_PAF), (bf16*)(ws + WS_PB), (bf16*)(ws + WS_Q), (unsigned char*)(ws + WS_GATE), (const float*)(ws + WS_RSTD1), a.out + O_SHP, a.out + O_SHS};
        pg8::gemm_phase<epi::Win, pg8::XcdOrder, PG8_ALIGN, PG8_SP2>(ring, g, S, E);
    } SEAM(4);

    if (IN(5)) { r1_phase(C, a); } SEAM(5);

    if (IN(6)) {
        { pg8::Gemm g{(const bf16*)(ws + WS_LIN), (const bf16*)(ws + WS_WLWA), MTOK, 4096, 256, 512, 256}; pg8::XcdOrder S; S.init(4096, bx);
          epi::LoraWA E{(float*)(ws + WS_WDEC), (float*)(ws + WS_AVAL), a.in[I_W0], a.in[I_A0]};
          pg8::gemm_phase<epi::LoraWA, pg8::XcdOrder, PG8_ALIGN, PG8_SP2>(ring, g, S, E); }
        { pg8::Gemm g{(const bf16*)(ws + WS_LIN) + 256, (const bf16*)(ws + WS_WLG), MTOK, 2048, 256, 512, 256}; pg8::XcdOrder S; S.init(2048, bx);
          epi::LoraG E{(bf16*)(ws + WS_G)};
          pg8::gemm_phase<epi::LoraG, pg8::XcdOrder, PG8_ALIGN, PG8_SP2>(ring, g, S, E); }
    } SEAM(6);


    if (IN(8)) {
        const int nscan = (C.G > 128) ? 128 : C.G / 2, nother = C.G - nscan;
#ifdef MK_P8_PROBE
        const int p8m = (a.li == 1) ? MK_P8_PROBE : 0;
#else
        const int p8m = 0;
#endif
        if (bx < nscan) {
            if (p8m != 2) for (int u = bx; u < 128; u += nscan) { const int b = u >> 5, h = u & 31; scan_unit(C, a, b * SEQ, SEQ, nullptr, nullptr, a.out + O_RWP + (size_t)u * 4096, h); }
        } else {
            const int r = bx - nscan;
            if (p8m != 1) {
            for (int u = r; u < NDB * HA; u += nother) { const int db = u >> 5, h = u & 31;
                scan_unit(C, a, NTP + db * DSEQ, DSEQ, a.in[I_SSH] + (size_t)db * PA, a.in[I_SRW] + (size_t)u * 4096, a.out + O_RWS + (size_t)u * 4096, h); }
            for (int u = r; u < 256; u += nother) attn_prompt_unit(a, u, C.wave, C.lane);
            for (int u = r; u < 512; u += nother) attn_sample_unit(C, a, u);
            conv_phase(a, r * NWAVES + C.wave, nother * NWAVES, C.lane);
            { __syncthreads(); Ctx C2 = C; C2.gw = r * NWAVES + C.wave; C2.NGW = nother * NWAVES; late_weights(C2, a); }
            }
        }
    } SEAM(8);


    if (IN(10)) {
        pg8::Gemm g{(const bf16*)(ws + WS_YA), (const bf16*)(ws + WS_WBRA), MTOK, DM, DM, DM, DM}; pg8::TailSplitOrder S; S.init(MTOK, DM, g.K, C.G, bx, (float*)(ws + WS_SLAB));
        epi::GateCat E{(const unsigned char*)(ws + WS_GATE), (bf16*)(ws + WS_MRG)};
        pg8::gemm_phase<epi::GateCat, pg8::TailSplitOrder, PG8_ALIGN, PG8_SP2>(ring, g, S, E);
        GRID_BAR(); tail_combine(C, E, (const float*)(ws + WS_SLAB), MTOK, DM, bx);
    } SEAM(10);

    if (IN(11)) {
        pg8::Gemm g{(const bf16*)(ws + WS_MRG), (const bf16*)(ws + WS_WOUT), MTOK, DM, DM, DM, DM}; pg8::TailSplitOrder S; S.init(MTOK, DM, g.K, C.G, bx, (float*)(ws + WS_SLAB));
        epi::Resid<true, false> E{a.out + O_Y, a.out + O_Y, a.out + O_Y, (bf16*)(ws + WS_XB), (float*)(ws + WS_SLOT), 1.0f};
        pg8::gemm_phase<epi::Resid<true, false>, pg8::TailSplitOrder, PG8_ALIGN, PG8_SP2>(ring, g, S, E);
        GRID_BAR(); tail_combine(C, E, (const float*)(ws + WS_SLAB), MTOK, DM, bx);
    } SEAM(11);

    if (IN(12)) { rstd_phase(C, (const float*)(ws + WS_SLOT), (float*)(ws + WS_RSTD2)); } SEAM(12);

    if (IN(13)) {
        pg8::Gemm g{(const bf16*)(ws + WS_XB), (const bf16*)(ws + WS_W2A), MTOK, 2 * DFF, DM, DM, DM}; pg8::XcdOrder S; S.init(2 * DFF, bx);
        epi::SwiGLU E{(bf16*)(ws + WS_ACT), (const float*)(ws + WS_RSTD2)};
        pg8::gemm_phase<epi::SwiGLU, pg8::XcdOrder, PG8_ALIGN, PG8_SP2>(ring, g, S, E);
        { const int c1 = 112;
          if (bx >= c1) { __syncthreads(); Ctx C2 = C; C2.gw = (bx - c1) * NWAVES + C.wave; C2.NGW = (C.G - c1) * NWAVES; int base = 0; cvt_matrix<0>(C2, a.in[I_WF2O], DFF, DM, nullptr, (bf16*)(ws + WS_W2B), base); } }
    } SEAM(13);

    if (IN(14)) {
        pg8::Gemm g{(const bf16*)(ws + WS_ACT), (const bf16*)(ws + WS_W2B), MTOK, DM, DFF, DFF, DFF}; pg8::TailSplitOrder S; S.init(MTOK, DM, g.K, C.G, bx, (float*)(ws + WS_SLAB));
        epi::Resid<true, false> E{a.out + O_Y, a.out + O_Y, a.out + O_Y, (bf16*)(ws + WS_XB), (float*)(ws + WS_SLOT), 0.5f};
        pg8::gemm_phase<epi::Resid<true, false>, pg8::TailSplitOrder, PG8_ALIGN, PG8_SP2>(ring, g, S, E);
        GRID_BAR(); tail_combine(C, E, (const float*)(ws + WS_SLAB), MTOK, DM, bx);
    } SEAM(14);

    if (IN(15)) { final_norm(C, a); }
#undef IN
#undef SEAM
}

extern "C" void kernel_launch(void* const* d_in, const int* in_sizes, int n_in, void* d_out, int out_size, void* d_ws, size_t ws_size, hipStream_t stream) {
    static int grid = 0;
    if (grid == 0) {
        if (n_in != 35 || (size_t)out_size != O_END || ws_size < WS_END) { fprintf(stderr, "kernel_launch: unexpected problem: n_in %d out_size %d ws_size %zu (need %zu)\n", n_in, out_size, ws_size, (size_t)WS_END); grid = -1; return; }
        int dev = 0, cus = 0;
        if (hipGetDevice(&dev) != hipSuccess || hipDeviceGetAttribute(&cus, hipDeviceAttributeMultiprocessorCount, dev) != hipSuccess) { grid = -1; return; }
        if (hipFuncSetAttribute((const void*)mk_fwd, hipFuncAttributeMaxDynamicSharedMemorySize, LDS_BYTES) != hipSuccess) { fprintf(stderr, "kernel_launch: hipFuncSetAttribute failed\n"); grid = -1; return; }
        int per_cu = 0;
        if (hipOccupancyMaxActiveBlocksPerMultiprocessor(&per_cu, (const void*)mk_fwd, NWAVES * 64, LDS_BYTES) != hipSuccess || per_cu < 1) fprintf(stderr, "kernel_launch: occupancy query says %d\n", per_cu);
        (void)hipGetLastError();
        if (cus != 256) { fprintf(stderr, "kernel_launch: built for a 256-CU device (unit orders and tail splits), found %d CUs\n", cus); grid = -1; return; }
        grid = cus;
    }
    if (grid < 0) return;
    (void)hipMemsetAsync((char*)d_ws + WS_CTL, 0, CTL_BYTES, stream);
    Args a{};
    for (int i = 0; i < 35; ++i) a.in[i] = (const float*)d_in[i];
    a.out = (float*)d_out; a.ws = (unsigned char*)d_ws;
#if MK_ONE_LAUNCH
#ifdef MK_DUP_PHASE
    a.ph_lo = 0; a.ph_hi = MK_DUP_PHASE + 1; a.li = 0; hipLaunchKernelGGL(mk_fwd, dim3(grid), dim3(NWAVES * 64), LDS_BYTES, stream, a);
    a.ph_lo = MK_DUP_PHASE; a.ph_hi = MK_DUP_PHASE + 1; a.li = 1; hipLaunchKernelGGL(mk_fwd, dim3(grid), dim3(NWAVES * 64), LDS_BYTES, stream, a);
    if (MK_DUP_PHASE + 1 < NPHASE) { a.ph_lo = MK_DUP_PHASE + 1; a.ph_hi = NPHASE; a.li = 2; hipLaunchKernelGGL(mk_fwd, dim3(grid), dim3(NWAVES * 64), LDS_BYTES, stream, a); }
#else
    a.ph_lo = 0; a.ph_hi = NPHASE; a.li = 0;
    hipLaunchKernelGGL(mk_fwd, dim3(grid), dim3(NWAVES * 64), LDS_BYTES, stream, a);
#endif
#else
#ifndef MK_LAST_PHASE
#define MK_LAST_PHASE (NPHASE - 1)
#endif
    for (int p = 0; p <= MK_LAST_PHASE; ++p) { a.ph_lo = p; a.ph_hi = p + 1; hipLaunchKernelGGL(mk_fwd, dim3(grid), dim3(NWAVES * 64), LDS_BYTES, stream, a); }
#endif
}
```

```cpp
#include <hip/hip_runtime.h>
#include <cstdio>
#include <cstdint>
namespace pg8 {
#define PG8_LAS __attribute__((address_space(3)))
typedef unsigned short bf16_t;
typedef short bf16x8 __attribute__((ext_vector_type(8)));
typedef float f32x4 __attribute__((ext_vector_type(4)));
typedef unsigned u32x4 __attribute__((ext_vector_type(4)));
constexpr int BM = 256, BK = 64, HALF = 128, HTB = HALF * BK * 2  , STAGE_BYTES = 8 * HTB, NXCD = 8, WGM = 8;

__host__ __device__ __forceinline__ int lds_byte(int r, int c) { const int st = (r >> 4) * 2 + (c >> 5), rr = r & 15, cc = c & 31, ob = rr * 64 + cc * 2; return st * 1024 + (ob ^ (((ob >> 9) & 1) << 5)); }
__host__ __device__ __forceinline__ void stage_rc(int b, int& R, int& C) { const int st = b / 1024, sb = b % 1024, swz = sb ^ (((sb >> 9) & 1) << 5); R = (st >> 1) * 16 + swz / 64; C = (st & 1) * 32 + (swz % 64) / 2; }
__host__ __device__ __forceinline__ int perm32(int rho) { const int n = rho >> 4, i = rho & 15; return 8 * (i >> 2) + 4 * n + (i & 3); }

typedef __bf16 pk_bf16x2 __attribute__((ext_vector_type(2)));
typedef float pk_f32x2 __attribute__((ext_vector_type(2)));
__device__ __forceinline__ unsigned pk_bf16(float lo, float hi) { pk_f32x2 v = {lo, hi}; pk_bf16x2 b = __builtin_convertvector(v, pk_bf16x2); return __builtin_bit_cast(unsigned, b); }
struct Unit { int pm, pn, kt0, nt, kind, slab; };
struct Gemm { const bf16_t* A; const bf16_t* Bt; int M, N, K, lda, ldb; };

struct StaticOrder {
    int nM, nN, nwg, G, c;
    __host__ __device__ void init(int M, int N, int G_, int c_) { nM = M / BM; nN = N / BM; nwg = nM * nN; G = G_; c = c_; }
    __host__ __device__ bool next(int i, Unit& u) const {
        const long L = (long)i * G + c; if (L >= nwg) return false;
        int wgid = (int)L; { const int q = nwg / NXCD, r = nwg % NXCD, xcd = wgid % NXCD, off = wgid / NXCD; wgid = (xcd < r ? xcd * (q + 1) : r * (q + 1) + (xcd - r) * q) + off; }
        const int nig = WGM * nN, gid = wgid / nig, fm = gid * WGM, gsz = (nM - fm) < WGM ? (nM - fm) : WGM;
        u.pm = fm + ((wgid % nig) % gsz); u.pn = (wgid % nig) / gsz; u.kt0 = 0; u.nt = -1; u.kind = 0; u.slab = 0; return true;
    }
    static constexpr bool STREAMK = false;
    __device__ __forceinline__ void a_ready(const Unit&) const {}
    __device__ __forceinline__ void done(const Unit&) const {}
};


struct XcdOrder {
    static constexpr bool STREAMK = false;
    int nN, x, j;
    __host__ __device__ __forceinline__ void init(int N, int c) { nN = N / BM; x = c & 7; j = c >> 3; }
    __host__ __device__ __forceinline__ bool entry(int e, Unit& u) const {
        if (e < 4 * nN) { u.pn = 8 * (e >> 5) + ((e & 31) >> 2); u.pm = x + 8 * (e & 3); }
        else { const int s = x + 8 * (e - 4 * nN); if (s >= 2 * nN) return false; u.pn = s >> 1; u.pm = 32 + (s & 1); }
        u.kt0 = 0; u.nt = -1; u.kind = 0; u.slab = 0; return true;
    }
    __host__ __device__ __forceinline__ bool next(int i, Unit& u) const { return entry(j + 32 * i, u); }
    __device__ __forceinline__ void a_ready(const Unit&) const {}
    __device__ __forceinline__ void done(const Unit&) const {}
};
typedef __attribute__((address_space(1))) unsigned long long gu64_t; typedef __attribute__((address_space(1))) unsigned gu32_t;
struct StreamKOrder {
    static constexpr bool STREAMK = true;
    int nN, NB, s0, s1, rank;
    unsigned long long* slab; unsigned* flag; unsigned* tmo;
    __device__ __forceinline__ void init(int M, int N, int K, int G, int rank_, unsigned long long* slab_, unsigned* flag_, unsigned* tmo_) {
        nN = N / BM; NB = K / 128; const long I = (long)(M / BM) * nN * NB; s0 = (int)(I * rank_ / G); s1 = (int)(I * (rank_ + 1) / G); rank = rank_; slab = slab_; flag = flag_; tmo = tmo_; }
    __device__ __forceinline__ void set(Unit& u, int unit, int kb0, int nkb, int kind, int sl) const { u.pm = unit / nN; u.pn = unit % nN; u.kt0 = 2 * kb0; u.nt = 2 * nkb; u.kind = kind; u.slab = sl; }
    __device__ __forceinline__ bool next(int i, Unit& u) const {
        const int uf = s0 / NB, r0 = s0 % NB, ul = s1 / NB, r1 = s1 % NB; int idx = i;
        if (r0 != 0) { if (idx == 0) { set(u, uf, r0, NB - r0, 1, rank); return true; } idx -= 1; }
        const int f0 = uf + (r0 != 0 ? 1 : 0), nfull = ul - f0;
        if (idx < nfull) { set(u, f0 + idx, 0, NB, 0, 0); return true; }
        idx -= nfull;
        if (r1 != 0 && idx == 0) { set(u, ul, 0, r1, 2, rank + 1); return true; }
        return false;
    }
    __device__ __forceinline__ void a_ready(const Unit&) const {}
    __device__ __forceinline__ void done(const Unit&) const {}
    __device__ __forceinline__ void store_slab(const f32x4 (&acc)[2][2][4][2], const Unit& u, int wid, int lane) const {
        gu64_t* p = (gu64_t*)slab + ((size_t)(u.slab * 8 + wid) * 32 * 64 + lane) * 2;
#pragma unroll
        for (int r4 = 0; r4 < 8; ++r4) {
#pragma unroll
            for (int j = 0; j < 4; ++j) { const int r = 4 * r4 + j; const f32x4 v = acc[r >> 4][(r >> 3) & 1][(r >> 1) & 3][r & 1];
                const float f0 = v[0], f1 = v[1], f2 = v[2], f3 = v[3];
                __hip_atomic_store(p + j * 128, ((unsigned long long)__float_as_uint(f1) << 32) | __float_as_uint(f0), __ATOMIC_RELAXED, __HIP_MEMORY_SCOPE_AGENT);
                __hip_atomic_store(p + j * 128 + 1, ((unsigned long long)__float_as_uint(f3) << 32) | __float_as_uint(f2), __ATOMIC_RELAXED, __HIP_MEMORY_SCOPE_AGENT); }
            p += 512; asm volatile("" : "+v"(p) :: "memory"); }
        asm volatile("s_waitcnt vmcnt(0)" ::: "memory");
        if (lane == 0) __hip_atomic_fetch_add((gu32_t*)flag + 64 * u.slab, 1u, __ATOMIC_RELAXED, __HIP_MEMORY_SCOPE_AGENT);
    }
    __device__ __forceinline__ void add_slab(f32x4 (&acc)[2][2][4][2], const Unit& u, int wid, int lane) const {
        const unsigned long long t0 = __builtin_amdgcn_s_memrealtime();
        while ((unsigned)__builtin_amdgcn_readfirstlane(__hip_atomic_load((gu32_t*)flag + 64 * u.slab, __ATOMIC_RELAXED, __HIP_MEMORY_SCOPE_AGENT)) < 8u) {
            if (__builtin_amdgcn_s_memrealtime() - t0 > 2000000ull) { if (lane == 0) __hip_atomic_store((gu32_t*)tmo, 1u, __ATOMIC_RELAXED, __HIP_MEMORY_SCOPE_AGENT); break; }
            __builtin_amdgcn_s_sleep(2); }
        gu64_t* p = (gu64_t*)slab + ((size_t)(u.slab * 8 + wid) * 32 * 64 + lane) * 2;
#pragma unroll
        for (int r4 = 0; r4 < 8; ++r4) {
#pragma unroll
            for (int j = 0; j < 4; ++j) { const int r = 4 * r4 + j;
                const unsigned long long lo = __hip_atomic_load(p + j * 128, __ATOMIC_RELAXED, __HIP_MEMORY_SCOPE_AGENT), hi = __hip_atomic_load(p + j * 128 + 1, __ATOMIC_RELAXED, __HIP_MEMORY_SCOPE_AGENT);
                f32x4& a = acc[r >> 4][(r >> 3) & 1][(r >> 1) & 3][r & 1];
                a[0] += __uint_as_float((unsigned)lo); a[1] += __uint_as_float((unsigned)(lo >> 32)); a[2] += __uint_as_float((unsigned)hi); a[3] += __uint_as_float((unsigned)(hi >> 32)); }
            p += 512; asm volatile("" : "+v"(p) :: "memory"); }
    }
};

struct TailSplitOrder {
    static constexpr bool STREAMK = true;
    XcdOrder xo; int c, R, rem, split, NB; float* slabf;
    __device__ __forceinline__ void init(int M, int N, int K, int G, int c_, float* slab_) { xo.init(N, c_); c = c_; const int nwg = (M / BM) * (N / BM); R = nwg / G; rem = nwg - R * G; split = rem ? G / rem : 1; NB = K / 128; slabf = slab_; }
    __device__ __forceinline__ static void leftover(int N, int R, int l, Unit& u) { XcdOrder t; t.init(N, l & 7); t.entry(32 * R + (l >> 3), u); }
    __device__ __forceinline__ bool next(int i, Unit& u) const {
        if (i < R) return xo.next(i, u);
        if (i > R || rem == 0) return false;
        const int l = c / split, part = c % split; if (l >= rem) return false;
        leftover(xo.nN * BM, R, l, u);
        const int kb0 = part * NB / split, kb1 = (part + 1) * NB / split; u.kt0 = 2 * kb0; u.nt = 2 * (kb1 - kb0); u.kind = 1; u.slab = c; return true;
    }
    __device__ __forceinline__ void a_ready(const Unit&) const {}
    __device__ __forceinline__ void done(const Unit&) const {}
    __device__ __forceinline__ void store_slab(const f32x4 (&acc)[2][2][4][2], const Unit& u, int wid, int lane) const {
        unsigned* p = (unsigned*)slabf + ((size_t)(u.slab * 8 + wid) * 16 * 64 + lane) * 4;
#pragma unroll
        for (int r4 = 0; r4 < 4; ++r4) {
#pragma unroll
            for (int j = 0; j < 4; ++j) { const int r2 = 4 * r4 + j; const f32x4& a0 = acc[r2 >> 3][(r2 >> 2) & 1][r2 & 3][0]; const f32x4& a1 = acc[r2 >> 3][(r2 >> 2) & 1][r2 & 3][1];
                u32x4 w; w.x = pk_bf16(a0[0], a0[1]); w.y = pk_bf16(a0[2], a0[3]); w.z = pk_bf16(a1[0], a1[1]); w.w = pk_bf16(a1[2], a1[3]); *(u32x4*)(p + j * 256) = w; }
            p += 1024; asm volatile("" : "+v"(p) :: "memory"); }
    }
    __device__ __forceinline__ void add_slab(f32x4 (&)[2][2][4][2], const Unit&, int, int) const {}
};

template <class Epi, class Sched, bool ALIGN_EPI = false, bool SP2 = false>
__device__ __forceinline__ void gemm_phase(PG8_LAS unsigned char* lds, const Gemm g, const Sched& S, const Epi& E) {
    const int tid = threadIdx.x, wid = __builtin_amdgcn_readfirstlane(tid >> 6), lane = tid & 63, wr = wid >> 2, wc = wid & 3, fr = lane & 15, fq = lane >> 4;
    const int K = g.K, nt = K / BK;
    unsigned voffA[2], voffB[2];
#pragma unroll
    for (int i = 0; i < 2; ++i) { int R, C; stage_rc(tid * 16 + i * 8192, R, C); const int Rb = Epi::PERM ? ((R & ~31) + perm32(R & 31)) : R;
        voffA[i] = (unsigned)(R * g.lda + C) * 2u; voffB[i] = (unsigned)(Rb * g.ldb + C) * 2u; }
    const size_t kstep = (size_t)(BK * 2);
    const size_t hstepA = (size_t)HALF * g.lda * 2, hstepB = (size_t)HALF * g.ldb * 2;
    const size_t tstepA = 2 * hstepA, tstepB = 2 * hstepB;
    const unsigned ldsw = (unsigned)wid * 1024u;
    const int aoff = lds_byte(wr * 64 + fr, fq * 8), boff = lds_byte(wc * 32 + fr, fq * 8);
#define PG8_SA(b, h) (((b) * 2 + (h)) * HTB)
#define PG8_SB(b, h) ((4 + (b) * 2 + (h)) * HTB)
#define PG8_STAGE(bufoff, gbase, voff) do { _Pragma("unroll") for (int _i = 0; _i < 2; ++_i) \
        __builtin_amdgcn_global_load_lds((const unsigned*)((const char*)(gbase) + (voff)[_i]), (PG8_LAS unsigned*)(lds + (bufoff) + ldsw + _i * 8192), 16, 0, 0); } while (0)
#define PG8_LDA(dst, b, h) do { _Pragma("unroll") for (int m = 0; m < 4; ++m) _Pragma("unroll") for (int k = 0; k < 2; ++k) dst[m][k] = *(const PG8_LAS bf16x8*)(lds + PG8_SA(b, h) + aoff + m * 2048 + k * 1024); } while (0)
#define PG8_LDB(dst, b, h) do { _Pragma("unroll") for (int n = 0; n < 2; ++n) _Pragma("unroll") for (int k = 0; k < 2; ++k) dst[n][k] = *(const PG8_LAS bf16x8*)(lds + PG8_SB(b, h) + boff + n * 2048 + k * 1024); } while (0)
#define PG8_MMA(ai, bj, At, Bt) do { __builtin_amdgcn_s_setprio(1); _Pragma("unroll") for (int m = 0; m < 4; ++m) _Pragma("unroll") for (int n = 0; n < 2; ++n) _Pragma("unroll") for (int k = 0; k < 2; ++k) \
        acc[ai][bj][m][n] = __builtin_amdgcn_mfma_f32_16x16x32_bf16(Bt[n][k], At[m][k], acc[ai][bj][m][n], 0, 0, 0); __builtin_amdgcn_s_setprio(0); } while (0)
#define PG8_WAIT_V(n) asm volatile("s_waitcnt vmcnt(" #n ")" ::: "memory")
#define PG8_WAIT_L(n) asm volatile("s_waitcnt lgkmcnt(" #n ")" ::: "memory")
#define PG8_BAR __builtin_amdgcn_s_barrier()
#define PG8_SCHED __builtin_amdgcn_sched_barrier(0)
    Unit cur, nxt; int ui = 0;
    if (!S.next(0, cur)) return;
    int cnt = cur.nt < 0 ? nt : cur.nt;
    f32x4 acc[2][2][4][2];
#pragma unroll
    for (int a = 0; a < 2; ++a)
#pragma unroll
        for (int b = 0; b < 2; ++b)
#pragma unroll
            for (int m = 0; m < 4; ++m)
#pragma unroll
                for (int n = 0; n < 2; ++n) acc[a][b][m][n] = (f32x4){0.f, 0.f, 0.f, 0.f};
    bf16x8 At[4][2], B0[2][2], B1[2][2];
    const char* cA = (const char*)g.A + (size_t)cur.pm * tstepA + (size_t)cur.kt0 * kstep; const char* cB = (const char*)g.Bt + (size_t)cur.pn * tstepB + (size_t)cur.kt0 * kstep;
    S.a_ready(cur);
    if constexpr (SP2) {
        PG8_STAGE(PG8_SB(0, 0), cB, voffB); PG8_STAGE(PG8_SB(0, 1), cB + hstepB, voffB); PG8_STAGE(PG8_SA(0, 0), cA, voffA); PG8_STAGE(PG8_SA(0, 1), cA + hstepA, voffA);
        if (wr == 1) PG8_BAR;
        PG8_WAIT_V(2); PG8_BAR;
        PG8_STAGE(PG8_SB(1, 0), cB + kstep, voffB); PG8_STAGE(PG8_SA(1, 0), cA + kstep, voffA); PG8_STAGE(PG8_SB(1, 1), cB + hstepB + kstep, voffB);
        PG8_WAIT_V(6); PG8_BAR;
    } else {
        PG8_STAGE(PG8_SB(0, 0), cB, voffB); PG8_STAGE(PG8_SA(0, 0), cA, voffA); PG8_STAGE(PG8_SB(0, 1), cB + hstepB, voffB); PG8_STAGE(PG8_SA(0, 1), cA + hstepA, voffA);
        if (wr == 1) PG8_BAR;
        PG8_WAIT_V(4); PG8_BAR;
        PG8_STAGE(PG8_SB(1, 0), cB + kstep, voffB); PG8_STAGE(PG8_SA(1, 0), cA + kstep, voffA); PG8_STAGE(PG8_SB(1, 1), cB + hstepB + kstep, voffB);
        PG8_WAIT_V(6); PG8_BAR;
    }
    for (;;) {
        const bool has_next = S.next(ui + 1, nxt);
        const char* nA = has_next ? (const char*)g.A + (size_t)nxt.pm * tstepA + (size_t)nxt.kt0 * kstep : cA; const char* nB = has_next ? (const char*)g.Bt + (size_t)nxt.pn * tstepB + (size_t)nxt.kt0 * kstep : cB;
#pragma unroll 1
        for (int t = 0; t < cnt; t += 2) {
            const bool last = (t == cnt - 2);
            if constexpr (Epi::KHOOK) { const int kt = cur.kt0 + t; if (t > 0 && (kt == 32 || kt == 48)) E.khook(acc, cur, kt, wr, wc, fr, fq); }
            const char* a1 = cA + (size_t)(t + 1) * kstep;
            const char* a2 = last ? nA : cA + (size_t)(t + 2) * kstep; const char* b2 = last ? nB : cB + (size_t)(t + 2) * kstep;
            const char* a3 = a2 + kstep; const char* b3 = b2 + kstep;
            if (last && has_next) S.a_ready(nxt);
            if constexpr (SP2) {
            PG8_LDB(B0, 0, 0); PG8_LDB(B1, 0, 1); PG8_SCHED; PG8_LDA(At, 0, 0); PG8_STAGE(PG8_SA(1, 1), a1 + hstepA, voffA);
            PG8_WAIT_V(8); PG8_WAIT_L(0); PG8_BAR; PG8_MMA(0, 0, At, B0); PG8_MMA(0, 1, At, B1); PG8_BAR; PG8_SCHED;
            PG8_LDA(At, 0, 1); PG8_STAGE(PG8_SB(0, 0), b2, voffB); PG8_STAGE(PG8_SB(0, 1), b2 + hstepB, voffB); PG8_STAGE(PG8_SA(0, 0), a2, voffA);
            PG8_WAIT_V(8); PG8_WAIT_L(0); PG8_BAR; PG8_MMA(1, 0, At, B0); PG8_MMA(1, 1, At, B1); PG8_BAR; PG8_SCHED;
            PG8_LDB(B0, 1, 0); PG8_LDB(B1, 1, 1); PG8_SCHED; PG8_LDA(At, 1, 0); PG8_STAGE(PG8_SA(0, 1), a2 + hstepA, voffA);
            PG8_WAIT_V(8); PG8_WAIT_L(0); PG8_BAR; PG8_MMA(0, 0, At, B0); PG8_MMA(0, 1, At, B1); PG8_BAR; PG8_SCHED;
            PG8_LDA(At, 1, 1); PG8_STAGE(PG8_SB(1, 0), b3, voffB); PG8_STAGE(PG8_SB(1, 1), b3 + hstepB, voffB); PG8_STAGE(PG8_SA(1, 0), a3, voffA);
            PG8_WAIT_V(8); PG8_WAIT_L(0); PG8_BAR; PG8_MMA(1, 0, At, B0); PG8_MMA(1, 1, At, B1); PG8_BAR; PG8_SCHED;
            } else {
            PG8_LDB(B0, 0, 0); PG8_SCHED; PG8_LDA(At, 0, 0); PG8_STAGE(PG8_SA(1, 1), a1 + hstepA, voffA);
            PG8_WAIT_L(8); PG8_BAR; PG8_WAIT_L(0); PG8_MMA(0, 0, At, B0); PG8_BAR; PG8_SCHED;
            PG8_LDB(B1, 0, 1); PG8_STAGE(PG8_SB(0, 0), b2, voffB);
            PG8_BAR; PG8_WAIT_L(0); PG8_MMA(0, 1, At, B1); PG8_BAR;
            PG8_LDA(At, 0, 1); PG8_STAGE(PG8_SA(0, 0), a2, voffA);
            PG8_BAR; PG8_WAIT_L(0); PG8_MMA(1, 0, At, B0); PG8_BAR; PG8_SCHED;
            PG8_STAGE(PG8_SB(0, 1), b2 + hstepB, voffB);
            PG8_WAIT_V(6); PG8_BAR; PG8_MMA(1, 1, At, B1); PG8_BAR;
            PG8_LDB(B0, 1, 0); PG8_SCHED; PG8_LDA(At, 1, 0); PG8_STAGE(PG8_SA(0, 1), a2 + hstepA, voffA);
            PG8_WAIT_L(8); PG8_BAR; PG8_WAIT_L(0); PG8_MMA(0, 0, At, B0); PG8_BAR; PG8_SCHED;
            PG8_LDB(B1, 1, 1); PG8_STAGE(PG8_SB(1, 0), b3, voffB);
            PG8_BAR; PG8_WAIT_L(0); PG8_MMA(0, 1, At, B1); PG8_BAR;
            PG8_LDA(At, 1, 1); PG8_STAGE(PG8_SA(1, 0), a3, voffA);
            PG8_BAR; PG8_WAIT_L(0); PG8_MMA(1, 0, At, B0); PG8_BAR; PG8_SCHED;
            PG8_STAGE(PG8_SB(1, 1), b3 + hstepB, voffB);
            PG8_WAIT_V(6); PG8_BAR; PG8_MMA(1, 1, At, B1); PG8_BAR;
            }
        }
        if constexpr (ALIGN_EPI) { if (wr == 0) PG8_BAR; }
        if constexpr (Sched::STREAMK) { __builtin_amdgcn_sched_barrier(0); if (cur.kind == 2) S.add_slab(acc, cur, wid, lane); __builtin_amdgcn_sched_barrier(0);
            if (cur.kind == 1) { if constexpr (Epi::KHOOK) E.pre_slab(acc, cur, wr, wc, fr, fq); S.store_slab(acc, cur, wid, lane); } else E(acc, cur, wr, wc, fr, fq); __builtin_amdgcn_sched_barrier(0); }
        else if constexpr (!Epi::AFTER_DRAIN) { E(acc, cur, wr, wc, fr, fq); S.done(cur); }
        if (!has_next) break;
#pragma unroll
        for (int a = 0; a < 2; ++a)
#pragma unroll
            for (int b = 0; b < 2; ++b)
#pragma unroll
                for (int m = 0; m < 4; ++m)
#pragma unroll
                    for (int n = 0; n < 2; ++n) acc[a][b][m][n] = (f32x4){0.f, 0.f, 0.f, 0.f};
        cur = nxt; cA = nA; cB = nB; ++ui; cnt = cur.nt < 0 ? nt : cur.nt;
        if constexpr (ALIGN_EPI) { if (wr == 1) PG8_BAR; }
    }
    PG8_WAIT_V(0);
    if constexpr (!ALIGN_EPI) { if (wr == 0) PG8_BAR; }
    PG8_BAR;
    if constexpr (Epi::AFTER_DRAIN) { E.fused(acc, cur, wr, wc, fr, fq, lds, wid, lane); S.done(cur); }
#undef PG8_SA
#undef PG8_SB
#undef PG8_STAGE
#undef PG8_LDA
#undef PG8_LDB
#undef PG8_MMA
#undef PG8_WAIT_V
#undef PG8_WAIT_L
#undef PG8_BAR
#undef PG8_SCHED
}
}

#ifndef PG8_SP2
#define PG8_SP2 true
#endif
#ifndef PG8_ALIGN
#define PG8_ALIGN true
#endif

constexpr int DM = 4096, NTP = 8192, NTS = 512, MTOK = 8704, DFF = 11008, SEQ = 2048, NB = 4, NDB = 128, DSEQ = 4;
constexpr int PA = 6592, PA_PAD = 6656, PBW = 3072, PCW = 1024, PGW = 12288, NWIN = 23040, PIN = 22976;
constexpr int DA = 2048, HA = 32, NMEM = 256;
constexpr float EPS = 1e-6f, GN_EPS = 64e-5f;
constexpr float QSCALE = 0.0625f * 1.4426950408889634f;

constexpr size_t O_Y = 0, O_MK = 35651584, O_MV = 36700160, O_RWP = 37748736, O_SHP = 38273024, O_CVP = 38299392, O_RWS = 38307584, O_SHS = 55084800, O_CVS = 55928576, O_END = 56190720;

constexpr size_t al256(size_t x) { return (x + 255) & ~(size_t)255; }
constexpr size_t WS_CTL = 0, CTL_BYTES = 1u << 20;
constexpr size_t WS_W1A = WS_CTL + CTL_BYTES;
constexpr size_t WS_W1B = WS_W1A + (size_t)2 * DFF * DM * 2;
constexpr size_t WS_WIN = WS_W1B + (size_t)DM * DFF * 2;
constexpr size_t WS_WMEM = WS_WIN + (size_t)NWIN * DM * 2;
constexpr size_t WS_WBRA = WS_WMEM + (size_t)2048 * DM * 2;
constexpr size_t WS_WBRB = WS_WBRA + (size_t)DM * 2048 * 2;
constexpr size_t WS_WBRC = WS_WBRB + (size_t)DM * 1024 * 2;
constexpr size_t WS_WOUT = WS_WBRC + (size_t)DM * 1024 * 2;
constexpr size_t WS_W2A = WS_WOUT + (size_t)DM * DM * 2;
constexpr size_t WS_W2B = WS_W2A + (size_t)2 * DFF * DM * 2;
constexpr size_t WS_WLWA = WS_W2B + (size_t)DM * DFF * 2;
constexpr size_t WS_WLG = WS_WLWA + (size_t)4096 * 256 * 2;
constexpr size_t WS_XB = WS_WLG + (size_t)2048 * 256 * 2;
constexpr size_t WS_ACT = WS_XB + (size_t)MTOK * DM * 2;
constexpr size_t WS_PAF = WS_ACT + (size_t)MTOK * DFF * 2;
constexpr size_t WS_PB = WS_PAF + (size_t)MTOK * PA_PAD * 4;
constexpr size_t WS_Q = WS_PB + (size_t)MTOK * PBW * 2;
constexpr size_t WS_GATE = WS_Q + (size_t)MTOK * PCW * 2;
constexpr size_t WS_LIN = WS_GATE + (size_t)MTOK * PGW * 2;
constexpr size_t WS_G = WS_LIN + (size_t)MTOK * 512 * 2;
constexpr size_t WS_YA = WS_G + (size_t)MTOK * 2048 * 2;
constexpr size_t WS_YB = WS_YA + (size_t)MTOK * 2048 * 2;
constexpr size_t WS_YC = WS_YB + (size_t)MTOK * 1024 * 2;
constexpr size_t WS_MRG = WS_YC + (size_t)MTOK * 1024 * 2;
constexpr size_t WS_MEMB = WS_MRG + (size_t)MTOK * DM * 2;
constexpr size_t WS_KB = WS_MEMB + (size_t)1024 * DM * 2;
constexpr size_t WS_VT = WS_KB + (size_t)1024 * 1024 * 2;
constexpr size_t WS_SLOT = WS_VT + (size_t)1024 * 1024 * 2;
constexpr size_t WS_RSTD0 = WS_SLOT + (size_t)MTOK * 64 * 4;
constexpr size_t WS_RSTD1 = WS_RSTD0 + 65536;
constexpr size_t WS_RSTD2 = WS_RSTD1 + 65536;
constexpr size_t WS_RSTDM = WS_RSTD2 + 65536;
constexpr size_t WS_INVN = WS_RSTDM + 65536;
constexpr size_t WS_RK = WS_INVN + (size_t)MTOK * 32 * 4;
constexpr size_t WS_SLAB = WS_RK + (size_t)MTOK * 32 * 4;
constexpr size_t WS_END = WS_SLAB + (size_t)256 * 262144;
static_assert(WS_END <= (size_t)2029 * 1024 * 1024, "d_ws map exceeds the guaranteed workspace");
static_assert((size_t)MTOK * 2048 * 4 <= (size_t)MTOK * DM * 2 && (size_t)MTOK * DM * 4 <= (size_t)MTOK * DFF * 2 && (size_t)2 * MTOK * 2048 * 4 <= (size_t)MTOK * DFF * 2, "overlays");
constexpr size_t WS_YSCAN = WS_XB, WS_WDEC = WS_ACT, WS_AVAL = WS_ACT + (size_t)MTOK * 2048 * 4, WS_MACC = WS_ACT;

constexpr int RING_OFF = 0, RING_BYTES = 131072;
constexpr int LDSCTL_OFF = 135168, MISC_OFF = LDSCTL_OFF + 320;
constexpr int LDS_BYTES = 147456;
constexpr int NWAVES = 8;

#define GAS __attribute__((address_space(1)))
#define LAS __attribute__((address_space(3)))
typedef unsigned short bf16;
typedef unsigned v4u __attribute__((ext_vector_type(4)));
typedef unsigned v2u __attribute__((ext_vector_type(2)));
typedef float f32x4 __attribute__((ext_vector_type(4)));
typedef float f32x2 __attribute__((ext_vector_type(2)));
typedef short bf16x8 __attribute__((ext_vector_type(8)));
#define LDS_WAIT() asm volatile("s_waitcnt lgkmcnt(0)" ::: "memory")
#define VM_WAIT() asm volatile("s_waitcnt vmcnt(0)" ::: "memory")
__device__ __forceinline__ unsigned f2bf(float f) { unsigned u = __builtin_bit_cast(unsigned, f); return (u + 0x7fffu + ((u >> 16) & 1u)) >> 16; }
__device__ __forceinline__ unsigned pk2(float lo, float hi) { return f2bf(lo) | (f2bf(hi) << 16); }
__device__ __forceinline__ float bf_lo(unsigned w) { return __builtin_bit_cast(float, w << 16); }
__device__ __forceinline__ float bf_hi(unsigned w) { return __builtin_bit_cast(float, w & 0xffff0000u); }
__device__ __forceinline__ float fast_exp(float x) { return __builtin_amdgcn_exp2f(x * 1.4426950408889634f); }
__device__ __forceinline__ float fast_sigmoid(float x) { return __builtin_amdgcn_rcpf(1.0f + fast_exp(-x)); }
typedef __bf16 bf16x2_t __attribute__((ext_vector_type(2)));
__device__ __forceinline__ unsigned cvt_pk_bf16(float lo, float hi) { f32x2 v = {lo, hi}; bf16x2_t b = __builtin_convertvector(v, bf16x2_t); return __builtin_bit_cast(unsigned, b); }

namespace epi {
using pg8::Unit;
typedef pg8::f32x4 A4;
#define EPI_ACC const A4 (&acc)[2][2][4][2]

struct SwiGLU {
    static constexpr bool PERM = true, AFTER_DRAIN = false, KHOOK = false;
    bf16* O; const float* rstd;
    __device__ __forceinline__ void operator()(EPI_ACC, const Unit& u, int wr, int wc, int fr, int fq) const {
        const int row0 = u.pm * 256 + wr * 64 + fr, col0 = u.pn * 128 + wc * 32 + 8 * fq;
#pragma unroll
        for (int ai = 0; ai < 2; ++ai)
#pragma unroll
            for (int m = 0; m < 4; ++m) {
                const int row = row0 + ai * 128 + m * 16; const float rs = rstd[row];
                float o[8];
#pragma unroll
                for (int n = 0; n < 2; ++n)
#pragma unroll
                    for (int e = 0; e < 4; ++e) { const float g = acc[ai][0][m][n][e] * rs, up = acc[ai][1][m][n][e] * rs; o[n * 4 + e] = g * fast_sigmoid(g) * up; }
                v4u w; w.x = cvt_pk_bf16(o[0], o[1]); w.y = cvt_pk_bf16(o[2], o[3]); w.z = cvt_pk_bf16(o[4], o[5]); w.w = cvt_pk_bf16(o[6], o[7]);
                *(v4u*)(O + (size_t)row * DFF + col0) = w;
            }
    }
};

template <bool BASE_BF16, bool OUT_F32> struct Resid {
    static constexpr bool PERM = true, AFTER_DRAIN = false, KHOOK = false;
    const float* base_p; const float* base_s;
    float* out; bf16* xb; float* slots; float scale;
    __device__ __forceinline__ void row_op(const A4 (&v)[2][2], int row, int pn, int wc, int fq) const {
        const int colb = pn * 256 + wc * 32 + 8 * fq;
        bf16* xp = xb + (size_t)row * DM + colb;
        float ss = 0.f;
#pragma unroll
        for (int bj = 0; bj < 2; ++bj) {
            A4 b0, b1;
            if (BASE_BF16) { const v4u bw = *(const v4u*)(xp + bj * 128); b0 = (A4){bf_lo(bw.x), bf_hi(bw.x), bf_lo(bw.y), bf_hi(bw.y)}; b1 = (A4){bf_lo(bw.z), bf_hi(bw.z), bf_lo(bw.w), bf_hi(bw.w)}; }
            else { const float* bp = (row < NTP ? base_p : base_s) + (size_t)row * DM + colb; b0 = *(const A4*)(bp + bj * 128); b1 = *(const A4*)(bp + bj * 128 + 4); }
            const A4 v0 = b0 + v[bj][0] * scale, v1 = b1 + v[bj][1] * scale;
            if (OUT_F32) { float* op = out + (size_t)row * DM + colb; *(A4*)(op + bj * 128) = v0; *(A4*)(op + bj * 128 + 4) = v1; }
            else { v4u w; w.x = cvt_pk_bf16(v0[0], v0[1]); w.y = cvt_pk_bf16(v0[2], v0[3]); w.z = cvt_pk_bf16(v1[0], v1[1]); w.w = cvt_pk_bf16(v1[2], v1[3]); *(v4u*)(xp + bj * 128) = w; }
            ss += (v0[0] * v0[0] + v0[1] * v0[1]) + (v0[2] * v0[2] + v0[3] * v0[3]) + (v1[0] * v1[0] + v1[1] * v1[1]) + (v1[2] * v1[2] + v1[3] * v1[3]);
        }
        ss += __shfl_xor(ss, 16); ss += __shfl_xor(ss, 32);
        if (fq == 0) slots[(size_t)row * 64 + pn * 4 + wc] = ss;
    }
    __device__ __forceinline__ void operator()(EPI_ACC, const Unit& u, int wr, int wc, int fr, int fq) const {
        const int row0 = u.pm * 256 + wr * 64 + fr;
#pragma unroll
        for (int ai = 0; ai < 2; ++ai)
#pragma unroll
            for (int m = 0; m < 4; ++m) { const A4 v[2][2] = {{acc[ai][0][m][0], acc[ai][0][m][1]}, {acc[ai][1][m][0], acc[ai][1][m][1]}}; row_op(v, row0 + ai * 128 + m * 16, u.pn, wc, fq); }
    }
};

struct Win {
    static constexpr bool PERM = true, AFTER_DRAIN = false, KHOOK = false;
    bf16* pa; bf16* pb; bf16* q; unsigned char* gate; const float* rstd; float* shp; float* shs;
    __device__ __forceinline__ void st8(EPI_ACC, int colb, int row0) const {
#pragma unroll
        for (int ai = 0; ai < 2; ++ai)
#pragma unroll
            for (int m = 0; m < 4; ++m) { const int row = row0 + ai * 128 + m * 16; const float rs = rstd[row]; unsigned char* op = gate + (size_t)row * PGW + colb;
#pragma unroll
                for (int bj = 0; bj < 2; ++bj) { unsigned w[2];
#pragma unroll
                    for (int n = 0; n < 2; ++n) { float g[4];
#pragma unroll
                        for (int e = 0; e < 4; ++e) g[e] = fmaxf(fast_sigmoid(acc[ai][bj][m][n][e] * rs) * 255.0f, 1.0f);
                        unsigned x = __builtin_amdgcn_cvt_pk_u8_f32(g[0], 0, 0u); x = __builtin_amdgcn_cvt_pk_u8_f32(g[1], 1, x); x = __builtin_amdgcn_cvt_pk_u8_f32(g[2], 2, x); x = __builtin_amdgcn_cvt_pk_u8_f32(g[3], 3, x);
                        w[n] = x; }
                    *(v2u*)(op + bj * 128) = (v2u){w[0], w[1]}; } }
    }
    template <bool SG> __device__ __forceinline__ void st16(EPI_ACC, bf16* O, int ld, int colb, float sc, int row0) const {
#pragma unroll
        for (int ai = 0; ai < 2; ++ai)
#pragma unroll
            for (int m = 0; m < 4; ++m) { const int row = row0 + ai * 128 + m * 16; const float rs = rstd[row] * sc; bf16* op = O + (size_t)row * ld + colb;
#pragma unroll
                for (int bj = 0; bj < 2; ++bj) { A4 v0 = acc[ai][bj][m][0] * rs, v1 = acc[ai][bj][m][1] * rs;
                    if (SG) {
#pragma unroll
                        for (int e = 0; e < 4; ++e) { v0[e] = fast_sigmoid(v0[e]); v1[e] = fast_sigmoid(v1[e]); } }
                    v4u w; w.x = cvt_pk_bf16(v0[0], v0[1]); w.y = cvt_pk_bf16(v0[2], v0[3]); w.z = cvt_pk_bf16(v1[0], v1[1]); w.w = cvt_pk_bf16(v1[2], v1[3]);
                    *(v4u*)(op + bj * 128) = w; } }
    }
    __device__ __forceinline__ void operator()(EPI_ACC, const Unit& u, int wr, int wc, int fr, int fq) const {
        const int row0 = u.pm * 256 + wr * 64 + fr, cw = wc * 32 + 8 * fq;
        if (u.pn < 26) {
            const int colb = u.pn * 256 + cw;
#pragma unroll
            for (int ai = 0; ai < 2; ++ai)
#pragma unroll
                for (int m = 0; m < 4; ++m) { const int row = row0 + ai * 128 + m * 16; const float rs = rstd[row]; bf16* op = pa + (size_t)row * PA_PAD + colb;
                    const bool last = row < NTP ? ((row & (SEQ - 1)) == SEQ - 1) : (((row - NTP) & (DSEQ - 1)) == DSEQ - 1);
                    float* sh = row < NTP ? shp + (size_t)(row >> 11) * PA : shs + (size_t)((row - NTP) >> 2) * PA;
#pragma unroll
                    for (int bj = 0; bj < 2; ++bj) { const A4 v0 = acc[ai][bj][m][0] * rs, v1 = acc[ai][bj][m][1] * rs;
                        v4u w; w.x = cvt_pk_bf16(v0[0], v0[1]); w.y = cvt_pk_bf16(v0[2], v0[3]); w.z = cvt_pk_bf16(v1[0], v1[1]); w.w = cvt_pk_bf16(v1[2], v1[3]);
                        *(v4u*)(op + bj * 128) = w;
                        if (last && colb + bj * 128 < PA) { *(A4*)(sh + colb + bj * 128) = v0; *(A4*)(sh + colb + bj * 128 + 4) = v1; } } }
        } else if (u.pn < 38) st16<false>(acc, pb, PBW, (u.pn - 26) * 256 + cw, 1.f, row0);
        else if (u.pn < 42) st16<false>(acc, q, PCW, (u.pn - 38) * 256 + cw, QSCALE, row0);
        else st8(acc, (u.pn - 42) * 256 + cw, row0);
    }
};

struct MemKV {
    static constexpr bool PERM = true, AFTER_DRAIN = false, KHOOK = false;
    float* outk; float* outv; bf16* kb; bf16* vt; const float* rstd;
    __device__ __forceinline__ void operator()(EPI_ACC, const Unit& u, int wr, int wc, int fr, int fq) const {
        const int row0 = u.pm * 256 + wr * 64 + fr; const bool isv = u.pn >= 4; const int h = u.pn & 3; const int cw = wc * 32 + 8 * fq;
        float* of = isv ? outv : outk;
#pragma unroll
        for (int ai = 0; ai < 2; ++ai)
#pragma unroll
            for (int m = 0; m < 4; ++m) { const int row = row0 + ai * 128 + m * 16; const float rs = rstd[row];
                const int b = row >> 8, key = row & 255, kk = key & 31; const int pos = (key & ~31) + 8 * ((kk & 15) >> 2) + (kk & 3) + 4 * (kk >> 4);
#pragma unroll
                for (int bj = 0; bj < 2; ++bj) { const A4 v0 = acc[ai][bj][m][0] * rs, v1 = acc[ai][bj][m][1] * rs; const int d0 = bj * 128 + cw;
                    float* op = of + (size_t)row * 1024 + h * 256 + d0; *(A4*)op = v0; *(A4*)(op + 4) = v1;
                    if (!isv) { v4u w; w.x = cvt_pk_bf16(v0[0], v0[1]); w.y = cvt_pk_bf16(v0[2], v0[3]); w.z = cvt_pk_bf16(v1[0], v1[1]); w.w = cvt_pk_bf16(v1[2], v1[3]);
                        *(v4u*)(kb + (size_t)row * 1024 + h * 256 + d0) = w; }
                    else { bf16* vp = vt + ((size_t)(b * 4 + h) * 256 + d0) * 256 + pos;
#pragma unroll
                        for (int e = 0; e < 4; ++e) { vp[(size_t)e * 256] = (bf16)f2bf(v0[e]); vp[(size_t)(4 + e) * 256] = (bf16)f2bf(v1[e]); } }
                } }
    }
};

struct LoraWA {
    static constexpr bool PERM = true, AFTER_DRAIN = false, KHOOK = false;
    float* wdec; float* aval; const float* w0; const float* a0;
    template <bool ISA> __device__ __forceinline__ void run(EPI_ACC, float* O, const float* bias, int colb, int row0) const {
#pragma unroll
        for (int bj = 0; bj < 2; ++bj)
#pragma unroll
            for (int n = 0; n < 2; ++n) { const A4 bv = *(const A4*)(bias + colb + bj * 128 + 4 * n);
#pragma unroll
                for (int ai = 0; ai < 2; ++ai)
#pragma unroll
                    for (int m = 0; m < 4; ++m) { const int row = row0 + ai * 128 + m * 16; A4 v = acc[ai][bj][m][n] + bv;
#pragma unroll
                        for (int e = 0; e < 4; ++e) { const float x = v[e];
                            if (ISA) v[e] = fast_sigmoid(x);
                            else v[e] = fast_exp(-0.6065306597126334f * fast_sigmoid(x)); }
                        *(A4*)(O + (size_t)row * 2048 + colb + bj * 128 + 4 * n) = v; }
                asm volatile("" ::: "memory"); }
    }
    __device__ __forceinline__ void operator()(EPI_ACC, const Unit& u, int wr, int wc, int fr, int fq) const {
        const int row0 = u.pm * 256 + wr * 64 + fr; const int colb = (u.pn & 7) * 256 + wc * 32 + 8 * fq;
        if (u.pn >= 8) run<true>(acc, aval, a0, colb, row0); else run<false>(acc, wdec, w0, colb, row0);
    }
};
struct LoraG {
    static constexpr bool PERM = true, AFTER_DRAIN = false, KHOOK = false;
    bf16* O;
    __device__ __forceinline__ void operator()(EPI_ACC, const Unit& u, int wr, int wc, int fr, int fq) const {
        const int row0 = u.pm * 256 + wr * 64 + fr, colb = u.pn * 256 + wc * 32 + 8 * fq;
#pragma unroll
        for (int ai = 0; ai < 2; ++ai)
#pragma unroll
            for (int m = 0; m < 4; ++m) { const int row = row0 + ai * 128 + m * 16; bf16* op = O + (size_t)row * 2048 + colb;
#pragma unroll
                for (int bj = 0; bj < 2; ++bj) { const A4 v0 = acc[ai][bj][m][0], v1 = acc[ai][bj][m][1];
                    v4u w; w.x = cvt_pk_bf16(v0[0], v0[1]); w.y = cvt_pk_bf16(v0[2], v0[3]); w.z = cvt_pk_bf16(v1[0], v1[1]); w.w = cvt_pk_bf16(v1[2], v1[3]);
                    *(v4u*)(op + bj * 128) = w; } }
    }
};
struct GateCat {
    static constexpr bool PERM = true, AFTER_DRAIN = false, KHOOK = true;
    const unsigned char* gate; bf16* mrg;
    __device__ __forceinline__ static void unpack8(const v2u w, float (&g)[8]) { g[0] = (float)(w.x & 0xffu); g[1] = (float)((w.x >> 8) & 0xffu); g[2] = (float)((w.x >> 16) & 0xffu); g[3] = (float)(w.x >> 24); g[4] = (float)(w.y & 0xffu); g[5] = (float)((w.y >> 8) & 0xffu); g[6] = (float)((w.y >> 16) & 0xffu); g[7] = (float)(w.y >> 24); }
    template <int MODE> __device__ __forceinline__ void scale(A4 (&acc)[2][2][4][2], const Unit& u, int seg, int wr, int wc, int fr, int fq) const {
        const int row0 = u.pm * 256 + wr * 64 + fr, colb = u.pn * 256 + wc * 32 + 8 * fq;
#pragma unroll
        for (int ai = 0; ai < 2; ++ai)
#pragma unroll
            for (int m = 0; m < 4; ++m) { const unsigned char* gp = gate + (size_t)(row0 + ai * 128 + m * 16) * PGW + seg * DM + colb;
#pragma unroll
                for (int bj = 0; bj < 2; ++bj) { float g[8]; unpack8(*(const v2u*)(gp + bj * 128), g);
                    if (MODE == 1) { float h[8]; unpack8(*(const v2u*)(gp + DM + bj * 128), h);
#pragma unroll
                        for (int e = 0; e < 8; ++e) g[e] *= __builtin_amdgcn_rcpf(h[e]); }
                    else {
#pragma unroll
                        for (int e = 0; e < 8; ++e) g[e] *= (1.0f / 255.0f); }
#pragma unroll
                    for (int e = 0; e < 4; ++e) { acc[ai][bj][m][0][e] *= g[e]; acc[ai][bj][m][1][e] *= g[4 + e]; } }
                asm volatile("" ::: "memory"); }
    }
    __device__ __forceinline__ void khook(A4 (&acc)[2][2][4][2], const Unit& u, int kt, int wr, int wc, int fr, int fq) const { scale<1>(acc, u, kt == 32 ? 0 : 1, wr, wc, fr, fq); }
    __device__ __forceinline__ void pre_slab(A4 (&acc)[2][2][4][2], const Unit& u, int wr, int wc, int fr, int fq) const { scale<0>(acc, u, u.kt0 < 32 ? 0 : (u.kt0 < 48 ? 1 : 2), wr, wc, fr, fq); }
    __device__ __forceinline__ void row_op(const A4 (&v)[2][2], int row, int pn, int wc, int fq) const {
        bf16* op = mrg + (size_t)row * DM + pn * 256 + wc * 32 + 8 * fq;
#pragma unroll
        for (int bj = 0; bj < 2; ++bj) { v4u w; w.x = cvt_pk_bf16(v[bj][0][0], v[bj][0][1]); w.y = cvt_pk_bf16(v[bj][0][2], v[bj][0][3]); w.z = cvt_pk_bf16(v[bj][1][0], v[bj][1][1]); w.w = cvt_pk_bf16(v[bj][1][2], v[bj][1][3]);
            *(v4u*)(op + bj * 128) = w; }
    }
    __device__ __forceinline__ void operator()(EPI_ACC, const Unit& u, int wr, int wc, int fr, int fq) const {
        const int row0 = u.pm * 256 + wr * 64 + fr, colb = u.pn * 256 + wc * 32 + 8 * fq;
#pragma unroll
        for (int ai = 0; ai < 2; ++ai)
#pragma unroll
            for (int m = 0; m < 4; ++m) { const int row = row0 + ai * 128 + m * 16; const unsigned char* gp = gate + (size_t)row * PGW + 2 * DM + colb; A4 v[2][2];
#pragma unroll
                for (int bj = 0; bj < 2; ++bj) { float g[8]; unpack8(*(const v2u*)(gp + bj * 128), g);
#pragma unroll
                    for (int e = 0; e < 4; ++e) { v[bj][0][e] = acc[ai][bj][m][0][e] * (g[e] * (1.0f / 255.0f)); v[bj][1][e] = acc[ai][bj][m][1][e] * (g[4 + e] * (1.0f / 255.0f)); } }
                row_op(v, row, u.pn, wc, fq); }
    }
};
#undef EPI_ACC
}

#define XB_TMO      128
#define XB_XCNT(j)  (256  + 64 * (j))
#define XB_XSUB(j)  (1280 + 64 * (j))
#define XB_XGEN(j)  (2304 + 64 * (j))
#define XB_TOP      3328
#define XB_TOPGEN   3392
#define XCD_BAR_WORDS 3456
#define XB_SPIN_CAP (1u << 18)

__device__ __forceinline__ unsigned xb_ld(unsigned* p)              { return __hip_atomic_load(p, __ATOMIC_RELAXED, __HIP_MEMORY_SCOPE_AGENT); }
__device__ __forceinline__ unsigned xb_add(unsigned* p, unsigned v) { return __hip_atomic_fetch_add(p, v, __ATOMIC_RELAXED, __HIP_MEMORY_SCOPE_AGENT); }
__device__ __forceinline__ unsigned xb_xcc_id() { return (unsigned)__builtin_amdgcn_s_getreg((3 << 11) | 20) & 0xFu; }
#define XB_SPIN(cond, bar) do { unsigned _sp = 0; while (cond) { __builtin_amdgcn_s_sleep(1); \
    if ((++_sp & 255u) == 0u) { if (xb_ld(&(bar)[XB_TMO])) break; if (_sp > XB_SPIN_CAP) { atomicAdd(&(bar)[XB_TMO], 1u); break; } } } } while (0)

struct XcdBarrier {
    unsigned* bar; unsigned x;
    volatile LAS unsigned* st;
};

__device__ __forceinline__ XcdBarrier xcd_barrier_post(unsigned* bar, volatile LAS unsigned* st) {
    XcdBarrier b; b.bar = bar; b.x = xb_xcc_id(); b.st = st;
    if (threadIdx.x == 0) (void)xb_add(&bar[XB_XCNT(b.x)], 1u);
    return b;
}
__device__ __forceinline__ void xcd_barrier_complete(unsigned* bar, unsigned x, unsigned& nloc, unsigned& nx) {
    const unsigned G = gridDim.x * gridDim.y * gridDim.z;
    unsigned sum, cnt, mine, sp = 0u;
    for (;;) {
        sum = 0u; cnt = 0u; mine = 0u;
#pragma unroll
        for (unsigned j = 0; j < 16; ++j) { const unsigned c = xb_ld(&bar[XB_XCNT(j)]); sum += c; cnt += (c > 0u) ? 1u : 0u; mine = (j == x) ? c : mine; }
        if (sum == G) break;
        __builtin_amdgcn_s_sleep(1);
        if ((++sp & 255u) == 0u) { if (xb_ld(&bar[XB_TMO])) break; if (sp > XB_SPIN_CAP) { atomicAdd(&bar[XB_TMO], 1u); break; } }
    }
    nloc = mine > 0u ? mine : 1u; nx = cnt > 0u ? cnt : 1u;
}

__device__ __forceinline__ void xcd_barrier(const XcdBarrier& b) {
    asm volatile("s_waitcnt vmcnt(0)" ::: "memory");
    __syncthreads();
    if (threadIdx.x == 0) {
        unsigned* bar = b.bar;
        __builtin_amdgcn_s_waitcnt(0);
        unsigned nloc = b.st[0], nx = b.st[1];
        if (nloc == 0u) { xcd_barrier_complete(bar, b.x, nloc, nx); b.st[0] = nloc; b.st[1] = nx; }
        const unsigned old = xb_add(&bar[XB_XSUB(b.x)], 1u);
        const unsigned gen = old / nloc;
        if (old + 1u == (gen + 1u) * nloc) {
            __builtin_amdgcn_fence(__ATOMIC_RELEASE, "agent");
            asm volatile("s_waitcnt vmcnt(0)" ::: "memory");
            const unsigned og = xb_add(&bar[XB_TOP], 1u);
            const unsigned tg = og / nx;
            if (og + 1u == (tg + 1u) * nx) xb_add(&bar[XB_TOPGEN], 1u);
            else XB_SPIN(xb_ld(&bar[XB_TOPGEN]) == tg, bar);
            __builtin_amdgcn_fence(__ATOMIC_ACQUIRE, "agent");
            xb_add(&bar[XB_XGEN(b.x)], 1u);
            asm volatile("s_waitcnt vmcnt(0)" ::: "memory");
        } else {
            XB_SPIN(xb_ld(&bar[XB_XGEN(b.x)]) == gen, bar);
            __builtin_amdgcn_fence(__ATOMIC_ACQUIRE, "agent");
            asm volatile("s_waitcnt vmcnt(0)" ::: "memory");
        }
    }
    __syncthreads();
}

struct Args {
    const float* in[35];
    float* out; unsigned char* ws;
    int ph_lo, ph_hi, li, pad;
};
enum In { I_XP = 0, I_XS, I_MEM, I_CK, I_CV, I_SRW, I_SSH, I_SCV, I_GF1, I_WF1I, I_WF1O, I_GMIX, I_WIN, I_MU, I_W0, I_WLU, I_A0, I_ALU, I_GLU, I_KK, I_KA, I_RK, I_LNW, I_LNB, I_CW, I_GMEM, I_WMKV,
          I_WBA, I_WBB, I_WBC, I_WOUT, I_GF2, I_WF2I, I_WF2O, I_GFIN };

struct Ctx { LAS unsigned char* lds; int tid, lane, wave, G, vcu, gw, NGW; };

__device__ __forceinline__ float wave_sum(float v) {
#pragma unroll
    for (int o = 1; o < 64; o <<= 1) v += __shfl_xor(v, o);
    return v;
}
__device__ __forceinline__ float oct_sum(float v) { v += __shfl_xor(v, 1); v += __shfl_xor(v, 2); v += __shfl_xor(v, 4); return v; }

__device__ __forceinline__ void cvt_item(const float* W, int N, const float* gk, bf16* WT, int Kd, int k0, int n0, int drow0, LAS float* scr, int lane) {
    f32x4 v[16];
    const int r4 = lane >> 4, c4 = 4 * (lane & 15);
#pragma unroll
    for (int i = 0; i < 16; ++i) v[i] = *(const f32x4*)(W + (size_t)(k0 + 4 * i + r4) * N + n0 + c4);
    if (gk) {
#pragma unroll
        for (int i = 0; i < 16; ++i) { const float s = gk[k0 + 4 * i + r4]; v[i] = v[i] * s; } }
#pragma unroll
    for (int i = 0; i < 16; ++i) { LAS float* p = scr + (4 * i + r4) * 65 + c4; p[0] = v[i].x; p[1] = v[i].y; p[2] = v[i].z; p[3] = v[i].w; }
    LDS_WAIT(); asm volatile("" ::: "memory");
    const int c = lane & 7;
#pragma unroll
    for (int j = 0; j < 8; ++j) { const int n = (lane >> 3) + 8 * j; const LAS float* s = scr + (8 * c) * 65 + n;
        v4u o; o.x = cvt_pk_bf16(s[0 * 65], s[1 * 65]); o.y = cvt_pk_bf16(s[2 * 65], s[3 * 65]); o.z = cvt_pk_bf16(s[4 * 65], s[5 * 65]); o.w = cvt_pk_bf16(s[6 * 65], s[7 * 65]);
        *(v4u*)(WT + (size_t)(drow0 + n) * Kd + k0 + 8 * c) = o; }
    LDS_WAIT(); asm volatile("" ::: "memory");
}
template <int MAP> __device__ __forceinline__ void cvt_matrix(const Ctx& C, const float* W, int K, int N, const float* gk, bf16* WT, int& base, int Kd = 0) {
    if (Kd == 0) Kd = K;
    const int nblk = N / 64, nitems = (K / 64) * nblk; LAS float* scr = (LAS float*)(C.lds + C.wave * 16640);
    int first = (C.gw - base % C.NGW + C.NGW) % C.NGW;
    for (int it = first; it < nitems; it += C.NGW) {
        const int kb = it / nblk, nb = it % nblk, n0 = 64 * nb; int d;
        if (MAP == 1) { const int j = n0 < DFF ? n0 : n0 - DFF; d = 256 * (j >> 7) + (j & 127) + (n0 < DFF ? 0 : 128); }
        else if (MAP == 2) d = n0 + (n0 >= PA ? 64 : 0);
        else d = n0;
        cvt_item(W, N, gk, WT, Kd, 64 * kb, n0, d, scr, C.lane);
    }
    base += nitems;
}
__device__ __forceinline__ void row_to_bf16(const float* xrow, bf16* orow, float* rstd_out, int lane) {
    const f32x4* xr = (const f32x4*)xrow + lane; f32x4 v[16]; float s = 0.f;
#pragma unroll
    for (int j = 0; j < 16; ++j) { v[j] = xr[64 * j]; s += (v[j].x * v[j].x + v[j].y * v[j].y) + (v[j].z * v[j].z + v[j].w * v[j].w); }
    s = wave_sum(s);
    v2u* o8 = (v2u*)orow + lane;
#pragma unroll
    for (int j = 0; j < 16; ++j) { v2u w; w.x = cvt_pk_bf16(v[j].x, v[j].y); w.y = cvt_pk_bf16(v[j].z, v[j].w); o8[64 * j] = w; }
    if (lane == 0) *rstd_out = 1.0f / sqrtf(s * (1.0f / DM) + EPS);
}
__device__ __forceinline__ void p0_prologue(const Ctx& C, const Args& a) {
    unsigned char* ws = a.ws; int base = 0;
    cvt_matrix<1>(C, a.in[I_WF1I], DM, 2 * DFF, a.in[I_GF1], (bf16*)(ws + WS_W1A), base);
    cvt_matrix<0>(C, a.in[I_WMKV], DM, 2048, a.in[I_GMEM], (bf16*)(ws + WS_WMEM), base);
    { bf16* wl = (bf16*)(ws + WS_WLWA); bf16* wg = (bf16*)(ws + WS_WLG); const float* wu = a.in[I_WLU]; const float* au = a.in[I_ALU]; const float* gu = a.in[I_GLU];
      for (int i = C.gw * 64 + C.lane; i < 6144 * 32; i += C.NGW * 64) { const int n = i % 6144, k0 = 8 * (i / 6144); float f[8];
#pragma unroll
          for (int e = 0; e < 8; ++e) { const int k = k0 + e; float x = 0.f;
              if (n < 2048) { if (k < 96) x = wu[(size_t)k * 2048 + n]; }
              else if (n < 4096) { if (k >= 128 && k < 224) x = au[(size_t)(k - 128) * 2048 + (n - 2048)]; }
              else x = gu[(size_t)k * 2048 + (n - 4096)];
              f[e] = x; }
          v4u o; o.x = pk2(f[0], f[1]); o.y = pk2(f[2], f[3]); o.z = pk2(f[4], f[5]); o.w = pk2(f[6], f[7]);
          bf16* dst = n < 4096 ? wl + (size_t)n * 256 + k0 : wg + (size_t)(n - 4096) * 256 + k0;
          *(v4u*)dst = o; } }
    for (int m = C.gw; m < MTOK + 1024; m += C.NGW) {
        if (m < MTOK) { const float* xr = m < NTP ? a.in[I_XP] + (size_t)m * DM : a.in[I_XS] + (size_t)(m - NTP) * DM;
            row_to_bf16(xr, (bf16*)(ws + WS_XB) + (size_t)m * DM, (float*)(ws + WS_RSTD0) + m, C.lane); }
        else { const int r = m - MTOK; row_to_bf16(a.in[I_MEM] + (size_t)r * DM, (bf16*)(ws + WS_MEMB) + (size_t)r * DM, (float*)(ws + WS_RSTDM) + r, C.lane); }
    }
}
__device__ __forceinline__ void late_weights(const Ctx& C2, const Args& a) {
    unsigned char* ws = a.ws; int base = 0;
    cvt_matrix<0>(C2, a.in[I_WBA], 2048, DM, nullptr, (bf16*)(ws + WS_WBRA), base, DM);
    cvt_matrix<0>(C2, a.in[I_WBB], 1024, DM, nullptr, (bf16*)(ws + WS_WBRA) + 2048, base, DM);
    cvt_matrix<0>(C2, a.in[I_WBC], 1024, DM, nullptr, (bf16*)(ws + WS_WBRA) + 3072, base, DM);
    cvt_matrix<0>(C2, a.in[I_WOUT], DM, DM, nullptr, (bf16*)(ws + WS_WOUT), base);
    cvt_matrix<1>(C2, a.in[I_WF2I], DM, 2 * DFF, a.in[I_GF2], (bf16*)(ws + WS_W2A), base);
}
__device__ __forceinline__ void win_weights(const Ctx& C, const Args& a) {
    unsigned char* ws = a.ws; int base = 0;
    cvt_matrix<2>(C, a.in[I_WIN], DM, PIN, a.in[I_GMIX], (bf16*)(ws + WS_WIN), base);
    { v4u z = {0u, 0u, 0u, 0u}; v4u* p = (v4u*)((bf16*)(ws + WS_WIN) + (size_t)PA * DM);
      for (int i = C.gw * 64 + C.lane; i < 64 * DM / 8; i += C.NGW * 64) p[i] = z; }
}
__device__ __forceinline__ void rstd_phase(const Ctx& C, const float* slots, float* rstd) {
    for (int m = C.gw; m < MTOK; m += C.NGW) { const float s = wave_sum(slots[(size_t)m * 64 + C.lane]); if (C.lane == 0) rstd[m] = 1.0f / sqrtf(s * (1.0f / DM) + EPS); }
}
__device__ __forceinline__ void final_norm(const Ctx& C, const Args& a) {
    const float* slots = (const float*)(a.ws + WS_SLOT); const f32x4* gf = (const f32x4*)a.in[I_GFIN]; const bf16* xb = (const bf16*)(a.ws + WS_XB);
    for (int m = C.gw; m < MTOK; m += C.NGW) {
        const float s = wave_sum(slots[(size_t)m * 64 + C.lane]); const float rs = 1.0f / sqrtf(s * (1.0f / DM) + EPS);
        const v4u* xr = (const v4u*)(xb + (size_t)m * DM) + C.lane; f32x4* yr = (f32x4*)(a.out + O_Y + (size_t)m * DM);
#pragma unroll
        for (int j = 0; j < 8; ++j) { const v4u w = xr[64 * j]; const int c4 = (64 * j + C.lane) * 2;
            const f32x4 g0 = gf[c4], g1 = gf[c4 + 1];
            yr[c4] = (f32x4){bf_lo(w.x), bf_hi(w.x), bf_lo(w.y), bf_hi(w.y)} * rs * g0; yr[c4 + 1] = (f32x4){bf_lo(w.z), bf_hi(w.z), bf_lo(w.w), bf_hi(w.w)} * rs * g1; }
    }
}

__device__ __forceinline__ void ld8(const float* p, float (&f)[8]) { const f32x4 x = *(const f32x4*)p, y = *(const f32x4*)(p + 4); f[0] = x.x; f[1] = x.y; f[2] = x.z; f[3] = x.w; f[4] = y.x; f[5] = y.y; f[6] = y.z; f[7] = y.w; }
__device__ __forceinline__ void ld8b(const bf16* p, float (&f)[8]) { const v4u w = *(const v4u*)p; f[0] = bf_lo(w.x); f[1] = bf_hi(w.x); f[2] = bf_lo(w.y); f[3] = bf_hi(w.y); f[4] = bf_lo(w.z); f[5] = bf_hi(w.z); f[6] = bf_lo(w.w); f[7] = bf_hi(w.w); }
__device__ __forceinline__ void r1_phase(const Ctx& C, const Args& a) {
    const bf16* pa = (const bf16*)(a.ws + WS_PAF); bf16* lin = (bf16*)(a.ws + WS_LIN); const float* mu = a.in[I_MU];
    const int o = 8 * C.lane; int src = -1, mode = 0;
    if (o < 96) { src = 6144 + o; mode = 0; } else if (o < 128) src = -1; else if (o < 224) { src = 6240 + (o - 128); mode = 1; } else if (o < 256) src = -1; else { src = 6336 + (o - 256); mode = 2; }
    for (int m = C.gw; m < MTOK; m += C.NGW) {
        const int t = m < NTP ? (m & (SEQ - 1)) : ((m - NTP) & (DSEQ - 1)); const bf16* cur = pa + (size_t)m * PA_PAD;
        float f[8];
#pragma unroll
        for (int e = 0; e < 8; ++e) f[e] = 0.f;
        if (src >= 0) { float c[8], p[8], u[8]; ld8b(cur + src, c); ld8(mu + src, u);
            if (t) ld8b(cur - PA_PAD + src, p); else if (m >= NTP) ld8(a.in[I_SSH] + (size_t)((m - NTP) >> 2) * PA + src, p); else {
#pragma unroll
                for (int e = 0; e < 8; ++e) p[e] = 0.f; }
#pragma unroll
            for (int e = 0; e < 8; ++e) { const float x = c[e] + (p[e] - c[e]) * u[e]; f[e] = mode == 0 ? (1.0f - 2.0f * __builtin_amdgcn_rcpf(1.0f + fast_exp(2.0f * x))) : (mode == 2 ? fast_sigmoid(x) : x); } }
        v4u w; w.x = pk2(f[0], f[1]); w.y = pk2(f[2], f[3]); w.z = pk2(f[4], f[5]); w.w = pk2(f[6], f[7]);
        *(v4u*)(lin + (size_t)m * 512 + o) = w;
    }
}
__device__ __forceinline__ void ldu16(const bf16* row, int c0, float (&u)[16]) {
    const v4u g0 = *(const v4u*)(row + 1024 + c0), g1 = *(const v4u*)(row + 1024 + c0 + 8), u0 = *(const v4u*)(row + 2048 + c0), u1 = *(const v4u*)(row + 2048 + c0 + 8);
    const unsigned gw[8] = {g0.x, g0.y, g0.z, g0.w, g1.x, g1.y, g1.z, g1.w}, uw[8] = {u0.x, u0.y, u0.z, u0.w, u1.x, u1.y, u1.z, u1.w};
#pragma unroll
    for (int i = 0; i < 8; ++i) { u[2 * i] = bf_lo(gw[i]) * bf_lo(uw[i]); u[2 * i + 1] = bf_hi(gw[i]) * bf_hi(uw[i]); }
}
__device__ __forceinline__ void ldf16(const float* p, float (&u)[16]) {
#pragma unroll
    for (int i = 0; i < 4; ++i) { const f32x4 x = *(const f32x4*)(p + 4 * i); u[4 * i] = x.x; u[4 * i + 1] = x.y; u[4 * i + 2] = x.z; u[4 * i + 3] = x.w; }
}
__device__ __forceinline__ void conv_phase(const Args& a, int w, int nw, int lane) {
    const bf16* pb = (const bf16*)(a.ws + WS_PB); bf16* yb = (bf16*)(a.ws + WS_YA) + 2048; const float* cw = a.in[I_CW]; const int c0 = 16 * lane;
    float w0[16], w1[16], w2[16]; ldf16(cw + c0, w0); ldf16(cw + 1024 + c0, w1); ldf16(cw + 2048 + c0, w2);
    for (int m = w; m < MTOK; m += nw) {
        const bool smp = m >= NTP; const int t = smp ? ((m - NTP) & 3) : (m & (SEQ - 1)); const int T = smp ? DSEQ : SEQ;
        const float* buf = smp ? a.in[I_SCV] + (size_t)((m - NTP) >> 2) * 2048 : nullptr;
        const bf16* row = pb + (size_t)m * PBW;
        float u0[16], u1[16], u2[16];
        ldu16(row, c0, u0);
        if (t >= 1) ldu16(row - PBW, c0, u1); else if (smp) ldf16(buf + 1024 + c0, u1); else {
#pragma unroll
            for (int i = 0; i < 16; ++i) u1[i] = 0.f; }
        if (t >= 2) ldu16(row - 2 * PBW, c0, u2); else if (smp) ldf16(buf + (size_t)t * 1024 + c0, u2); else {
#pragma unroll
            for (int i = 0; i < 16; ++i) u2[i] = 0.f; }
        const v4u b0 = *(const v4u*)(row + c0), b1 = *(const v4u*)(row + c0 + 8); const unsigned bw[8] = {b0.x, b0.y, b0.z, b0.w, b1.x, b1.y, b1.z, b1.w};
        unsigned ow[8];
#pragma unroll
        for (int i = 0; i < 8; ++i) { const float z0 = u2[2 * i] * w0[2 * i] + u1[2 * i] * w1[2 * i] + u0[2 * i] * w2[2 * i], z1 = u2[2 * i + 1] * w0[2 * i + 1] + u1[2 * i + 1] * w1[2 * i + 1] + u0[2 * i + 1] * w2[2 * i + 1];
            ow[i] = pk2(bf_lo(bw[i]) * z0, bf_hi(bw[i]) * z1); }
        v4u o0 = {ow[0], ow[1], ow[2], ow[3]}, o1 = {ow[4], ow[5], ow[6], ow[7]};
        *(v4u*)(yb + (size_t)m * DM + c0) = o0; *(v4u*)(yb + (size_t)m * DM + c0 + 8) = o1;
        if (t >= T - 2) { float* dst = (smp ? a.out + O_CVS + (size_t)((m - NTP) >> 2) * 2048 : a.out + O_CVP + (size_t)(m >> 11) * 2048) + (size_t)(t - (T - 2)) * 1024 + c0;
#pragma unroll
            for (int i = 0; i < 4; ++i) *(f32x4*)(dst + 4 * i) = (f32x4){u0[4 * i], u0[4 * i + 1], u0[4 * i + 2], u0[4 * i + 3]}; }
    }
}

template <int CTRL> __device__ __forceinline__ float dpp_mov(float v) { return __builtin_bit_cast(float, __builtin_amdgcn_update_dpp(0, __builtin_bit_cast(int, v), CTRL, 0xf, 0xf, false)); }
__device__ __forceinline__ float oct_sum_dpp(float v) { v += dpp_mov<0xB1>(v); v += dpp_mov<0x4E>(v); v += dpp_mov<0x141>(v); return v; }
constexpr int TC = 16, STG = 6 * TC * 64;
template <int CTRL> __device__ __forceinline__ float dpp_add(float v) { return v + dpp_mov<CTRL>(v); }
__device__ __forceinline__ float row16_sum(float v) { v = dpp_add<0xB1>(v); v = dpp_add<0x4E>(v); v = dpp_add<0x141>(v); v = dpp_add<0x140>(v); return v; }
struct StageRegs { f32x4 cr, ck, cv, pr, pk, pv, la, lw; v2u g; };
struct StagePar { f32x4 mur, muk, muv, kkp, kap, rkp; };
__device__ __forceinline__ f32x4 ld4b(const bf16* p) { const v2u w = *(const v2u*)p; return (f32x4){bf_lo(w.x), bf_hi(w.x), bf_lo(w.y), bf_hi(w.y)}; }
__device__ __forceinline__ void stage_load(StageRegs& R, const Args& a, const float* shift_prev, int tok0, int tl, int T, int cj) {
    const f32x4 z = {0.f, 0.f, 0.f, 0.f};
    if (tl < T) {
        const int tok = tok0 + tl; const bf16* P = (const bf16*)(a.ws + WS_PAF) + (size_t)tok * PA_PAD + cj;
        R.cr = ld4b(P); R.ck = ld4b(P + 2048); R.cv = ld4b(P + 4096);
        if (tl > 0) { const bf16* Q = P - PA_PAD; R.pr = ld4b(Q); R.pk = ld4b(Q + 2048); R.pv = ld4b(Q + 4096); }
        else if (shift_prev) { const float* Q = shift_prev + cj; R.pr = *(const f32x4*)Q; R.pk = *(const f32x4*)(Q + 2048); R.pv = *(const f32x4*)(Q + 4096); }
        else { R.pr = z; R.pk = z; R.pv = z; }
        R.la = *(const f32x4*)((const float*)(a.ws + WS_AVAL) + (size_t)tok * 2048 + cj); R.lw = *(const f32x4*)((const float*)(a.ws + WS_WDEC) + (size_t)tok * 2048 + cj);
        R.g = *(const v2u*)((const bf16*)(a.ws + WS_G) + (size_t)tok * 2048 + cj);
    } else { R.cr = z; R.ck = z; R.cv = z; R.pr = z; R.pk = z; R.pv = z; R.la = z; R.lw = z; R.g = (v2u){0u, 0u}; }
}
__device__ __forceinline__ float sum4(const f32x4 v) { return (v.x + v.y) + (v.z + v.w); }
__device__ __forceinline__ float stage_store(const StageRegs& R, LAS float* B, LAS float* BRK, int st, int cq, const StagePar& P) {
    const f32x4 rs = R.cr + (R.pr - R.cr) * P.mur, ks = R.ck + (R.pk - R.ck) * P.muk, vs = R.cv + (R.pv - R.cv) * P.muv;
    const f32x4 kr_ = ks * P.kkp, kp = ks * (1.0f + (R.la - 1.0f) * P.kap);
    const float ss = row16_sum(sum4(kr_ * kr_));
    const float inv = 1.0f / fmaxf(sqrtf(ss), 1e-12f);
    const f32x4 kk = kr_ * inv, bv = kk * R.la;
    const float br = row16_sum(sum4(bv * rs)), kr = row16_sum(sum4(kp * rs)), rk = row16_sum(sum4(rs * kp * P.rkp));
    LAS float* p = B + st * 64 + 4 * cq;
    *(LAS f32x4*)(p) = -kk; *(LAS f32x4*)(p + TC * 64) = R.lw; *(LAS f32x4*)(p + 2 * TC * 64) = bv; *(LAS f32x4*)(p + 3 * TC * 64) = kp; *(LAS f32x4*)(p + 4 * TC * 64) = R.lw * rs; *(LAS f32x4*)(p + 5 * TC * 64) = vs;
    if (cq == 0) *(LAS f32x2*)(BRK + st * 2) = (f32x2){br, kr};
    return rk;
}
struct Carry { float rk; v2u g; };
__device__ __forceinline__ void post_store(const LAS float* yv, const LAS float* vv, const Carry& cy, const f32x4 lnw, const f32x4 lnb, bf16* dst) {
    f32x4 y = *(const LAS f32x4*)yv; const f32x4 v = *(const LAS f32x4*)vv;
    const float mean = row16_sum(sum4(y)) * (1.0f / 64.0f); y = y - mean;
    const float rs = 1.0f / sqrtf(row16_sum(sum4(y * y)) * (1.0f / 64.0f) + GN_EPS);
    const f32x4 g = {bf_lo(cy.g.x), bf_hi(cy.g.x), bf_lo(cy.g.y), bf_hi(cy.g.y)};
    const f32x4 o = (y * rs * lnw + lnb + v * cy.rk) * g;
    v2u w; w.x = cvt_pk_bf16(o.x, o.y); w.y = cvt_pk_bf16(o.z, o.w);
    *(v2u*)dst = w;
}
__device__ __forceinline__ void row8_sum4(float& a0, float& a1, float& a2, float& a3) {
#define R8_OP(n, ctl) "v_add_f32_dpp %" #n ", %" #n ", %" #n " " ctl " row_mask:0xf bank_mask:0xf bound_ctrl:1\n\t"
#define R8_STAGE(ctl) R8_OP(0, ctl) R8_OP(1, ctl) R8_OP(2, ctl) R8_OP(3, ctl)
    asm volatile("s_nop 1\n\t" R8_STAGE("quad_perm:[1,0,3,2]") R8_STAGE("quad_perm:[2,3,0,1]") R8_STAGE("row_half_mirror") "s_nop 1"
        : "+v"(a0), "+v"(a1), "+v"(a2), "+v"(a3));
#undef R8_STAGE
#undef R8_OP
}
struct StepOps { f32x4 a[2], w[2], b[2], k[2], r[2]; f32x2 v, brk; };
__device__ __forceinline__ void step_load(StepOps& o, const LAS float* bt, const LAS float* vt, const LAS float* brk) {
#pragma unroll
    for (int j = 0; j < 2; ++j) { o.a[j] = *(const LAS f32x4*)(bt + 4 * j); o.w[j] = *(const LAS f32x4*)(bt + TC * 64 + 4 * j); o.b[j] = *(const LAS f32x4*)(bt + 2 * TC * 64 + 4 * j); o.k[j] = *(const LAS f32x4*)(bt + 3 * TC * 64 + 4 * j); o.r[j] = *(const LAS f32x4*)(bt + 4 * TC * 64 + 4 * j); }
    o.v = *(const LAS f32x2*)vt; o.brk = *(const LAS f32x2*)brk;
}
__device__ __forceinline__ f32x2 lo2(const f32x4 v) { return (f32x2){v.x, v.y}; }
__device__ __forceinline__ f32x2 hi2(const f32x4 v) { return (f32x2){v.z, v.w}; }
#define PKB0 "op_sel:[0,0,0] op_sel_hi:[1,0,1]"
#define PKB1 "op_sel:[0,1,0] op_sel_hi:[1,1,1]"
__device__ __forceinline__ void blk_partials(const f32x2 (&S)[8], const f32x2 (&a2)[4], const f32x2 (&r2)[4], f32x2& s, f32x2& y) {
    f32x2 s1, y1;
    asm("v_pk_mul_f32 %0, %4, %12 op_sel:[0,0] op_sel_hi:[1,0]\n\tv_pk_mul_f32 %1, %8, %14 op_sel:[0,0] op_sel_hi:[1,0]\n\t"
        "v_pk_mul_f32 %2, %4, %16 op_sel:[0,0] op_sel_hi:[1,0]\n\tv_pk_mul_f32 %3, %8, %18 op_sel:[0,0] op_sel_hi:[1,0]\n\t"
        "v_pk_fma_f32 %0, %5, %12, %0 " PKB1 "\n\tv_pk_fma_f32 %1, %9, %14, %1 " PKB1 "\n\tv_pk_fma_f32 %2, %5, %16, %2 " PKB1 "\n\tv_pk_fma_f32 %3, %9, %18, %3 " PKB1 "\n\t"
        "v_pk_fma_f32 %0, %6, %13, %0 " PKB0 "\n\tv_pk_fma_f32 %1, %10, %15, %1 " PKB0 "\n\tv_pk_fma_f32 %2, %6, %17, %2 " PKB0 "\n\tv_pk_fma_f32 %3, %10, %19, %3 " PKB0 "\n\t"
        "v_pk_fma_f32 %0, %7, %13, %0 " PKB1 "\n\tv_pk_fma_f32 %1, %11, %15, %1 " PKB1 "\n\tv_pk_fma_f32 %2, %7, %17, %2 " PKB1 "\n\tv_pk_fma_f32 %3, %11, %19, %3 " PKB1 "\n\t"
        "v_pk_add_f32 %0, %0, %1\n\tv_pk_add_f32 %2, %2, %3"
        : "=&v"(s), "=&v"(s1), "=&v"(y), "=&v"(y1)
        : "v"(S[0]), "v"(S[1]), "v"(S[2]), "v"(S[3]), "v"(S[4]), "v"(S[5]), "v"(S[6]), "v"(S[7]), "v"(a2[0]), "v"(a2[1]), "v"(a2[2]), "v"(a2[3]), "v"(r2[0]), "v"(r2[1]), "v"(r2[2]), "v"(r2[3]));
}
__device__ __forceinline__ void blk_update(f32x2& Se, f32x2& So, const f32x2 sa, const f32x2 v, const f32x2 w2, const f32x2 b2, const f32x2 k2) {
    f32x2 t0, t1;
    asm("v_pk_mul_f32 %2, %5, %8 op_sel:[0,0] op_sel_hi:[1,0]\n\tv_pk_mul_f32 %3, %5, %8 op_sel:[0,1] op_sel_hi:[1,1]\n\t"
        "v_pk_fma_f32 %2, %4, %7, %2 " PKB0 "\n\tv_pk_fma_f32 %3, %4, %7, %3 " PKB1 "\n\t"
        "v_pk_fma_f32 %0, %0, %6, %2 " PKB0 "\n\tv_pk_fma_f32 %1, %1, %6, %3 " PKB1
        : "+v"(Se), "+v"(So), "=&v"(t0), "=&v"(t1) : "v"(sa), "v"(v), "v"(w2), "v"(b2), "v"(k2));
}
__device__ __forceinline__ void blk_yfin(f32x2& y, const f32x2 sa, const f32x2 v, const f32x2 brk) {
    asm("v_pk_fma_f32 %0, %1, %3, %0 " PKB0 "\n\tv_pk_fma_f32 %0, %2, %3, %0 " PKB1 : "+v"(y) : "v"(sa), "v"(v), "v"(brk));
}
#undef PKB0
#undef PKB1
__device__ __forceinline__ void step_math(const StepOps& o, f32x2 (&S)[8], LAS float* yp, bool wr) {
    const f32x2 a2[4] = {lo2(o.a[0]), hi2(o.a[0]), lo2(o.a[1]), hi2(o.a[1])}, r2[4] = {lo2(o.r[0]), hi2(o.r[0]), lo2(o.r[1]), hi2(o.r[1])};
    const f32x2 w2[4] = {lo2(o.w[0]), hi2(o.w[0]), lo2(o.w[1]), hi2(o.w[1])}, b2[4] = {lo2(o.b[0]), hi2(o.b[0]), lo2(o.b[1]), hi2(o.b[1])}, k2[4] = {lo2(o.k[0]), hi2(o.k[0]), lo2(o.k[1]), hi2(o.k[1])};
    f32x2 s, y; blk_partials(S, a2, r2, s, y);
    float r0 = s.x, r1 = s.y, r2v = y.x, r3 = y.y;
    row8_sum4(r0, r1, r2v, r3);
    const f32x2 sa = {r0, r1}; f32x2 yo = {r2v, r3};
#pragma unroll
    for (int p = 0; p < 4; ++p) blk_update(S[2 * p], S[2 * p + 1], sa, o.v, w2[p], b2[p], k2[p]);
    blk_yfin(yo, sa, o.v, o.brk);
    if (wr) *(LAS f32x2*)yp = yo;
}
__device__ __forceinline__ void scan_unit(const Ctx& C, const Args& a, int tok0, int T, const float* shift_prev, const float* s_in, float* s_out, int h) {
    LAS float* L = (LAS float*)C.lds; LAS float* Y = L + 2 * STG; LAS float* BRK = Y + 2 * TC * 64;
    const int NC = (T + TC - 1) / TC; const bool comp = C.wave < 4;
    const int t2 = C.tid - 256, st = t2 >> 4, cq = t2 & 15, cj = h * 64 + 4 * cq;
    bf16* yout = (bf16*)(a.ws + WS_YA) + (size_t)tok0 * DM + cj;
    StagePar P; StageRegs R; Carry cA, cB; f32x4 lnw, lnb; cA.rk = 0.f; cA.g = (v2u){0u, 0u}; cB = cA;
    const int row = 16 * C.wave + 2 * (C.lane >> 3), cg = C.lane & 7; const bool wr = (cg == 0);
    f32x2 S[8];
    if (comp) {
        if (s_in) {
#pragma unroll
            for (int j = 0; j < 2; ++j) { const f32x4 x0 = *(const f32x4*)(s_in + row * 64 + 8 * cg + 4 * j), x1 = *(const f32x4*)(s_in + (row + 1) * 64 + 8 * cg + 4 * j);
#pragma unroll
                for (int e = 0; e < 4; ++e) S[4 * j + e] = (f32x2){x0[e], x1[e]}; } }
        else {
#pragma unroll
            for (int e = 0; e < 8; ++e) S[e] = (f32x2){0.f, 0.f}; }
    } else {
        const float* mu = a.in[I_MU];
        P.mur = *(const f32x4*)(mu + cj); P.muk = *(const f32x4*)(mu + 2048 + cj); P.muv = *(const f32x4*)(mu + 4096 + cj); P.kkp = *(const f32x4*)(a.in[I_KK] + cj); P.kap = *(const f32x4*)(a.in[I_KA] + cj); P.rkp = *(const f32x4*)(a.in[I_RK] + cj);
        lnw = *(const f32x4*)(a.in[I_LNW] + cj); lnb = *(const f32x4*)(a.in[I_LNB] + cj);
        stage_load(R, a, shift_prev, tok0, st, T, cj); cB.g = R.g; cB.rk = stage_store(R, L, BRK, st, cq, P);
        if (NC > 1) stage_load(R, a, shift_prev, tok0, TC + st, T, cj);
    }
    __syncthreads();
#pragma unroll 1
    for (int c = 0; c < NC; ++c) {
        const int cur = c & 1;
        if (comp) {
            const LAS float* B = L + cur * STG + 8 * cg; const LAS float* V = L + cur * STG + 5 * TC * 64 + row; const LAS float* K2 = BRK + cur * TC * 2; LAS float* Yb = Y + cur * TC * 64 + row;
            const int ns = (T - c * TC) < TC ? (T - c * TC) : TC;
            if (ns == TC) {
                StepOps o0, o1; step_load(o0, B, V, K2);
#pragma unroll
                for (int t = 0; t < TC; t += 2) {
                    step_load(o1, B + (t + 1) * 64, V + (t + 1) * 64, K2 + (t + 1) * 2);
                    step_math(o0, S, Yb + t * 64, wr);
                    if (t + 2 < TC) step_load(o0, B + (t + 2) * 64, V + (t + 2) * 64, K2 + (t + 2) * 2);
                    step_math(o1, S, Yb + (t + 1) * 64, wr);
                }
            } else {
#pragma unroll 1
                for (int t = 0; t < ns; ++t) { StepOps o; step_load(o, B + t * 64, V + t * 64, K2 + t * 2); step_math(o, S, Yb + t * 64, wr); }
            }
        } else {
            if (c > 0 && (c - 1) * TC + st < T) post_store(Y + (cur ^ 1) * TC * 64 + st * 64 + 4 * cq, L + (cur ^ 1) * STG + 5 * TC * 64 + st * 64 + 4 * cq, cA, lnw, lnb, yout + (size_t)((c - 1) * TC + st) * DM);
            Carry cN = cB;
            if (c + 1 < NC) { cN.g = R.g; cN.rk = stage_store(R, L + (cur ^ 1) * STG, BRK + (cur ^ 1) * TC * 2, st, cq, P); if (c + 2 < NC) stage_load(R, a, shift_prev, tok0, (c + 2) * TC + st, T, cj); }
            cA = cB; cB = cN;
        }
        __syncthreads();
    }
    if (comp) {
#pragma unroll
        for (int j = 0; j < 2; ++j) { *(f32x4*)(s_out + row * 64 + 8 * cg + 4 * j) = (f32x4){S[4 * j].x, S[4 * j + 1].x, S[4 * j + 2].x, S[4 * j + 3].x};
            *(f32x4*)(s_out + (row + 1) * 64 + 8 * cg + 4 * j) = (f32x4){S[4 * j].y, S[4 * j + 1].y, S[4 * j + 2].y, S[4 * j + 3].y}; }
    } else {
        const int cl = NC - 1; if (cl * TC + st < T) post_store(Y + (cl & 1) * TC * 64 + st * 64 + 4 * cq, L + (cl & 1) * STG + 5 * TC * 64 + st * 64 + 4 * cq, cA, lnw, lnb, yout + (size_t)(cl * TC + st) * DM);
    }
}

__device__ __forceinline__ bf16x8 pack8(const f32x4 x, const f32x4 y) { v4u w; w.x = cvt_pk_bf16(x[0], x[1]); w.y = cvt_pk_bf16(x[2], x[3]); w.z = cvt_pk_bf16(y[0], y[1]); w.w = cvt_pk_bf16(y[2], y[3]); return __builtin_bit_cast(bf16x8, w); }
__device__ __forceinline__ void attn_prompt_unit(const Args& a, int u, int wave, int lane) {
    const int b = u >> 6, h = (u >> 4) & 3, qt = u & 15, fr = lane & 15, g = lane >> 4;
    const bf16* q = (const bf16*)(a.ws + WS_Q); const bf16* kb = (const bf16*)(a.ws + WS_KB); const bf16* vt = (const bf16*)(a.ws + WS_VT); bf16* yc = (bf16*)(a.ws + WS_YA) + 3072;
    const int tok = b * SEQ + qt * 128 + wave * 16 + fr;
    bf16x8 qf[8];
#pragma unroll
    for (int ks = 0; ks < 8; ++ks) qf[ks] = *(const bf16x8*)(q + (size_t)tok * 1024 + h * 256 + 32 * ks + 8 * g);
    f32x4 st[16];
#pragma unroll
    for (int T = 0; T < 16; ++T) { st[T] = (f32x4){0.f, 0.f, 0.f, 0.f}; const bf16* kr = kb + (size_t)(b * 256 + 16 * T + fr) * 1024 + h * 256 + 8 * g;
#pragma unroll
        for (int ks = 0; ks < 8; ++ks) { const bf16x8 kf = *(const bf16x8*)(kr + 32 * ks); st[T] = __builtin_amdgcn_mfma_f32_16x16x32_bf16(kf, qf[ks], st[T], 0, 0, 0); } }
    float mx = -3.0e38f;
#pragma unroll
    for (int T = 0; T < 16; ++T) mx = fmaxf(fmaxf(fmaxf(st[T][0], st[T][1]), fmaxf(st[T][2], st[T][3])), mx);
    mx = fmaxf(mx, __shfl_xor(mx, 16)); mx = fmaxf(mx, __shfl_xor(mx, 32));
    float sum = 0.f;
#pragma unroll
    for (int T = 0; T < 16; ++T)
#pragma unroll
        for (int r = 0; r < 4; ++r) { const float p = __builtin_amdgcn_exp2f(st[T][r] - mx); st[T][r] = p; sum += p; }
    sum += __shfl_xor(sum, 16); sum += __shfl_xor(sum, 32);
    const float inv = 1.0f / sum;
    bf16x8 pf[8];
#pragma unroll
    for (int ks = 0; ks < 8; ++ks) pf[ks] = pack8(st[2 * ks], st[2 * ks + 1]);
#pragma unroll
    for (int dt = 0; dt < 16; ++dt) { f32x4 o = {0.f, 0.f, 0.f, 0.f}; const bf16* vr = vt + ((size_t)(b * 4 + h) * 256 + 16 * dt + fr) * 256 + 8 * g;
#pragma unroll
        for (int ks = 0; ks < 8; ++ks) { const bf16x8 vf = *(const bf16x8*)(vr + 32 * ks); o = __builtin_amdgcn_mfma_f32_16x16x32_bf16(vf, pf[ks], o, 0, 0, 0); }
        o = o * inv; v2u w; w.x = cvt_pk_bf16(o[0], o[1]); w.y = cvt_pk_bf16(o[2], o[3]);
        *(v2u*)(yc + (size_t)tok * DM + h * 256 + 16 * dt + 4 * g) = w; }
}
__device__ __forceinline__ void attn_sample_unit(const Ctx& C, const Args& a, int u) {
    const int db = u >> 2, h = u & 3, lane = C.lane, wave = C.wave, fr = lane & 15, g = lane >> 4;
    LAS float* sc = (LAS float*)C.lds; LAS float* red = sc + 1024; LAS float* sinv = red + 8192;
    const float* ck = a.in[I_CK] + (size_t)db * 256 * 1024 + h * 256; const float* cv = a.in[I_CV] + (size_t)db * 256 * 1024 + h * 256;
    const bf16* q = (const bf16*)(a.ws + WS_Q) + (size_t)(NTP + db * 4) * 1024 + h * 256; bf16* yc = (bf16*)(a.ws + WS_YA) + 3072 + (size_t)(NTP + db * 4) * DM + h * 256;
    bf16x8 qf[8];
#pragma unroll
    for (int ks = 0; ks < 8; ++ks) { const v4u z = {0u, 0u, 0u, 0u}; qf[ks] = __builtin_bit_cast(bf16x8, z); if (fr < 4) qf[ks] = *(const bf16x8*)(q + (size_t)fr * 1024 + 32 * ks + 8 * g); }
#pragma unroll
    for (int T2 = 0; T2 < 2; ++T2) { const int key = 32 * wave + 16 * T2 + fr; f32x4 s = {0.f, 0.f, 0.f, 0.f}; const float* kp = ck + (size_t)key * 1024 + 8 * g;
#pragma unroll
        for (int ks = 0; ks < 8; ++ks) { const f32x4 k0 = *(const f32x4*)(kp + 32 * ks), k1 = *(const f32x4*)(kp + 32 * ks + 4); s = __builtin_amdgcn_mfma_f32_16x16x32_bf16(pack8(k0, k1), qf[ks], s, 0, 0, 0); }
        if (fr < 4) *(LAS f32x4*)(sc + fr * 256 + 32 * wave + 16 * T2 + 4 * g) = s; }
    __syncthreads();
    if (wave < 4) { f32x4 v = *(LAS f32x4*)(sc + wave * 256 + 4 * lane); float mx = fmaxf(fmaxf(v[0], v[1]), fmaxf(v[2], v[3]));
#pragma unroll
        for (int o = 1; o < 64; o <<= 1) mx = fmaxf(mx, __shfl_xor(mx, o));
        float s = 0.f;
#pragma unroll
        for (int e = 0; e < 4; ++e) { v[e] = __builtin_amdgcn_exp2f(v[e] - mx); s += v[e]; }
        s = wave_sum(s); *(LAS f32x4*)(sc + wave * 256 + 4 * lane) = v; if (lane == 0) sinv[wave] = 1.0f / s; }
    __syncthreads();
    f32x4 o[4];
#pragma unroll
    for (int t = 0; t < 4; ++t) o[t] = (f32x4){0.f, 0.f, 0.f, 0.f};
#pragma unroll 2
    for (int kk = 0; kk < 32; kk += 4) { f32x4 p[4];
#pragma unroll
        for (int t = 0; t < 4; ++t) p[t] = *(LAS f32x4*)(sc + t * 256 + 32 * wave + kk);
#pragma unroll
        for (int e = 0; e < 4; ++e) { const f32x4 v = *(const f32x4*)(cv + (size_t)(32 * wave + kk + e) * 1024 + 4 * lane);
#pragma unroll
            for (int t = 0; t < 4; ++t) o[t] += v * p[t][e]; } }
#pragma unroll
    for (int t = 0; t < 4; ++t) *(LAS f32x4*)(red + (wave * 4 + t) * 256 + 4 * lane) = o[t];
    __syncthreads();
    { const int t = C.tid >> 7, d = (C.tid & 127) * 2; f32x2 s = {0.f, 0.f};
#pragma unroll
        for (int w = 0; w < 8; ++w) s += *(LAS f32x2*)(red + (w * 4 + t) * 256 + d);
        s = s * sinv[t]; *(unsigned*)(yc + (size_t)t * DM + d) = cvt_pk_bf16(s.x, s.y); }
    __syncthreads();
}

template <class E> __device__ __forceinline__ void tail_combine(const Ctx& C, const E& e, const float* slab, int M, int N, int bx) {
    pg8::StaticOrder so; so.init(M, N, C.G, 0); const int R = so.nwg / C.G, rem = so.nwg - R * C.G; if (rem == 0) return; const int split = C.G / rem;
    const int l = bx / split, q = bx % split; if (l >= rem || q >= 8) return;
    pg8::Unit u; pg8::TailSplitOrder::leftover(N, R, l, u);
    const int ai = q >> 2, m = q & 3, w = C.wave, wr = w >> 2, wc = w & 3, fr = C.lane & 15, fq = C.lane >> 4;
    epi::A4 v[2][2];
#pragma unroll
    for (int bj = 0; bj < 2; ++bj)
#pragma unroll
        for (int n = 0; n < 2; ++n) v[bj][n] = (epi::A4){0.f, 0.f, 0.f, 0.f};
#pragma unroll
    for (int part = 0; part < 8; ++part) { if (part >= split) break; const unsigned* p = (const unsigned*)slab + ((size_t)((l * split + part) * 8 + w) * 16 * 64 + C.lane) * 4;
#pragma unroll
        for (int bj = 0; bj < 2; ++bj) { const v4u x = *(const v4u*)(p + (size_t)(ai * 8 + bj * 4 + m) * 256);
            v[bj][0] += (epi::A4){bf_lo(x.x), bf_hi(x.x), bf_lo(x.y), bf_hi(x.y)}; v[bj][1] += (epi::A4){bf_lo(x.z), bf_hi(x.z), bf_lo(x.w), bf_hi(x.w)}; } }
    e.row_op(v, u.pm * 256 + ai * 128 + wr * 64 + m * 16 + fr, u.pn, wc, fq);
}

#ifndef MK_ONE_LAUNCH
#define MK_ONE_LAUNCH 1
#endif
constexpr int NPHASE = 16;
constexpr int CW_SKF = 32768;
constexpr int CW_BAR = 4096;

__global__ void __launch_bounds__(NWAVES * 64, 2) mk_fwd(Args args) {
    extern __shared__ __attribute__((aligned(16))) unsigned char lds_raw[];
    Ctx C; C.lds = (LAS unsigned char*)lds_raw; C.tid = threadIdx.x; C.lane = C.tid & 63; C.wave = __builtin_amdgcn_readfirstlane(C.tid >> 6);
    C.G = gridDim.x; { const int bx = blockIdx.x; C.vcu = (C.G % 8 == 0) ? (bx % 8) * (C.G / 8) + bx / 8 : bx; }
    C.gw = C.vcu * NWAVES + C.wave; C.NGW = C.G * NWAVES;
    const Args& a = args; unsigned char* ws = a.ws;
    volatile LAS unsigned* MISC = (volatile LAS unsigned*)(C.lds + MISC_OFF);
    for (int u = C.tid; u < (LDS_BYTES - LDSCTL_OFF) / 4; u += NWAVES * 64) ((LAS unsigned*)(C.lds + LDSCTL_OFF))[u] = 0u;
    __syncthreads();
#if MK_ONE_LAUNCH
    XcdBarrier bar = xcd_barrier_post((unsigned*)(ws + WS_CTL) + CW_BAR + a.li * XCD_BAR_WORDS, MISC + 8);
#define GRID_BAR() xcd_barrier(bar)
#else
#define GRID_BAR() do { } while (0)
#endif
    const int lo = a.ph_lo, hi = a.ph_hi;
#ifndef PH_MASK
#define PH_MASK 0xFFFF
#endif
#define IN(k) ((((PH_MASK) >> (k)) & 1) && lo <= (k) && (k) < hi)
#define SEAM(k) do { if (IN(k) && IN((k) + 1)) GRID_BAR(); } while (0)
    LAS unsigned char* ring = C.lds + RING_OFF;
    const int bx = blockIdx.x;

    if (IN(0)) { p0_prologue(C, a); } SEAM(0);

    if (IN(1)) {
        { pg8::Gemm g{(const bf16*)(ws + WS_XB), (const bf16*)(ws + WS_W1A), MTOK, 2 * DFF, DM, DM, DM}; pg8::XcdOrder S; S.init(2 * DFF, bx);
          epi::SwiGLU E{(bf16*)(ws + WS_ACT), (const float*)(ws + WS_RSTD0)};
          pg8::gemm_phase<epi::SwiGLU, pg8::XcdOrder, PG8_ALIGN, PG8_SP2>(ring, g, S, E); }
        { const int c0 = 112; const int gsub = C.G - c0;
          if (bx >= c0) { pg8::Gemm g{(const bf16*)(ws + WS_MEMB), (const bf16*)(ws + WS_WMEM), 1024, 2048, DM, DM, DM}; pg8::StaticOrder S; S.init(1024, 2048, gsub, bx - c0);
            epi::MemKV E{a.out + O_MK, a.out + O_MV, (bf16*)(ws + WS_KB), (bf16*)(ws + WS_VT), (const float*)(ws + WS_RSTDM)};
            pg8::gemm_phase<epi::MemKV, pg8::StaticOrder, PG8_ALIGN, PG8_SP2>(ring, g, S, E); }
          { const int c1 = c0 + 32; if (bx >= c1) { __syncthreads(); Ctx C2 = C; C2.gw = (bx - c1) * NWAVES + C.wave; C2.NGW = (C.G - c1) * NWAVES; int base = 0;
              cvt_matrix<0>(C2, a.in[I_WF1O], DFF, DM, nullptr, (bf16*)(ws + WS_W1B), base); } } }
    } SEAM(1);

    if (IN(2)) {
        pg8::Gemm g{(const bf16*)(ws + WS_ACT), (const bf16*)(ws + WS_W1B), MTOK, DM, DFF, DFF, DFF}; pg8::TailSplitOrder S; S.init(MTOK, DM, g.K, C.G, bx, (float*)(ws + WS_SLAB));
        epi::Resid<true, false> E{a.out + O_Y, a.out + O_Y, a.out + O_Y, (bf16*)(ws + WS_XB), (float*)(ws + WS_SLOT), 0.5f};
        pg8::gemm_phase<epi::Resid<true, false>, pg8::TailSplitOrder, PG8_ALIGN, PG8_SP2>(ring, g, S, E);
        GRID_BAR(); tail_combine(C, E, (const float*)(ws + WS_SLAB), MTOK, DM, bx);
    } SEAM(2);

    if (IN(3)) { rstd_phase(C, (const float*)(ws + WS_SLOT), (float*)(ws + WS_RSTD1)); win_weights(C, a); } SEAM(3);

    if (IN(4)) {
        pg8::Gemm g{(const bf16*)(ws + WS_XB), (const bf16*)(ws + WS_WIN), MTOK, NWIN, DM, DM, DM}; pg8::XcdOrder S; S.init(NWIN, bx);
        epi::Win E{(bf16*)(ws + WS_PAF), (bf16*)(ws + WS_PB), (bf16*)(ws + WS_Q), (unsigned char*)(ws + WS_GATE), (const float*)(ws + WS_RSTD1), a.out + O_SHP, a.out + O_SHS};
        pg8::gemm_phase<epi::Win, pg8::XcdOrder, PG8_ALIGN, PG8_SP2>(ring, g, S, E);
    } SEAM(4);

    if (IN(5)) { r1_phase(C, a); } SEAM(5);

    if (IN(6)) {
        { pg8::Gemm g{(const bf16*)(ws + WS_LIN), (const bf16*)(ws + WS_WLWA), MTOK, 4096, 256, 512, 256}; pg8::XcdOrder S; S.init(4096, bx);
          epi::LoraWA E{(float*)(ws + WS_WDEC), (float*)(ws + WS_AVAL), a.in[I_W0], a.in[I_A0]};
          pg8::gemm_phase<epi::LoraWA, pg8::XcdOrder, PG8_ALIGN, PG8_SP2>(ring, g, S, E); }
        { pg8::Gemm g{(const bf16*)(ws + WS_LIN) + 256, (const bf16*)(ws + WS_WLG), MTOK, 2048, 256, 512, 256}; pg8::XcdOrder S; S.init(2048, bx);
          epi::LoraG E{(bf16*)(ws + WS_G)};
          pg8::gemm_phase<epi::LoraG, pg8::XcdOrder, PG8_ALIGN, PG8_SP2>(ring, g, S, E); }
    } SEAM(6);


    if (IN(8)) {
        const int nscan = (C.G > 128) ? 128 : C.G / 2, nother = C.G - nscan;
#ifdef MK_P8_PROBE
        const int p8m = (a.li == 1) ? MK_P8_PROBE : 0;
#else
        const int p8m = 0;
#endif
        if (bx < nscan) {
            if (p8m != 2) for (int u = bx; u < 128; u += nscan) { const int b = u >> 5, h = u & 31; scan_unit(C, a, b * SEQ, SEQ, nullptr, nullptr, a.out + O_RWP + (size_t)u * 4096, h); }
        } else {
            const int r = bx - nscan;
            if (p8m != 1) {
            for (int u = r; u < NDB * HA; u += nother) { const int db = u >> 5, h = u & 31;
                scan_unit(C, a, NTP + db * DSEQ, DSEQ, a.in[I_SSH] + (size_t)db * PA, a.in[I_SRW] + (size_t)u * 4096, a.out + O_RWS + (size_t)u * 4096, h); }
            for (int u = r; u < 256; u += nother) attn_prompt_unit(a, u, C.wave, C.lane);
            for (int u = r; u < 512; u += nother) attn_sample_unit(C, a, u);
            conv_phase(a, r * NWAVES + C.wave, nother * NWAVES, C.lane);
            { __syncthreads(); Ctx C2 = C; C2.gw = r * NWAVES + C.wave; C2.NGW = nother * NWAVES; late_weights(C2, a); }
            }
        }
    } SEAM(8);


    if (IN(10)) {
        pg8::Gemm g{(const bf16*)(ws + WS_YA), (const bf16*)(ws + WS_WBRA), MTOK, DM, DM, DM, DM}; pg8::TailSplitOrder S; S.init(MTOK, DM, g.K, C.G, bx, (float*)(ws + WS_SLAB));
        epi::GateCat E{(const unsigned char*)(ws + WS_GATE), (bf16*)(ws + WS_MRG)};
        pg8::gemm_phase<epi::GateCat, pg8::TailSplitOrder, PG8_ALIGN, PG8_SP2>(ring, g, S, E);
        GRID_BAR(); tail_combine(C, E, (const float*)(ws + WS_SLAB), MTOK, DM, bx);
    } SEAM(10);

    if (IN(11)) {
        pg8::Gemm g{(const bf16*)(ws + WS_MRG), (const bf16*)(ws + WS_WOUT), MTOK, DM, DM, DM, DM}; pg8::TailSplitOrder S; S.init(MTOK, DM, g.K, C.G, bx, (float*)(ws + WS_SLAB));
        epi::Resid<true, false> E{a.out + O_Y, a.out + O_Y, a.out + O_Y, (bf16*)(ws + WS_XB), (float*)(ws + WS_SLOT), 1.0f};
        pg8::gemm_phase<epi::Resid<true, false>, pg8::TailSplitOrder, PG8_ALIGN, PG8_SP2>(ring, g, S, E);
        GRID_BAR(); tail_combine(C, E, (const float*)(ws + WS_SLAB), MTOK, DM, bx);
    } SEAM(11);

    if (IN(12)) { rstd_phase(C, (const float*)(ws + WS_SLOT), (float*)(ws + WS_RSTD2)); } SEAM(12);

    if (IN(13)) {
        pg8::Gemm g{(const bf16*)(ws + WS_XB), (const bf16*)(ws + WS_W2A), MTOK, 2 * DFF, DM, DM, DM}; pg8::XcdOrder S; S.init(2 * DFF, bx);
        epi::SwiGLU E{(bf16*)(ws + WS_ACT), (const float*)(ws + WS_RSTD2)};
        pg8::gemm_phase<epi::SwiGLU, pg8::XcdOrder, PG8_ALIGN, PG8_SP2>(ring, g, S, E);
        { const int c1 = 112;
          if (bx >= c1) { __syncthreads(); Ctx C2 = C; C2.gw = (bx - c1) * NWAVES + C.wave; C2.NGW = (C.G - c1) * NWAVES; int base = 0; cvt_matrix<0>(C2, a.in[I_WF2O], DFF, DM, nullptr, (bf16*)(ws + WS_W2B), base); } }
    } SEAM(13);

    if (IN(14)) {
        pg8::Gemm g{(const bf16*)(ws + WS_ACT), (const bf16*)(ws + WS_W2B), MTOK, DM, DFF, DFF, DFF}; pg8::TailSplitOrder S; S.init(MTOK, DM, g.K, C.G, bx, (float*)(ws + WS_SLAB));
        epi::Resid<true, false> E{a.out + O_Y, a.out + O_Y, a.out + O_Y, (bf16*)(ws + WS_XB), (float*)(ws + WS_SLOT), 0.5f};
        pg8::gemm_phase<epi::Resid<true, false>, pg8::TailSplitOrder, PG8_ALIGN, PG8_SP2>(ring, g, S, E);
        GRID_BAR(); tail_combine(C, E, (const float*)(ws + WS_SLAB), MTOK, DM, bx);
    } SEAM(14);

    if (IN(15)) { final_norm(C, a); }
#undef IN
#undef SEAM
}

extern "C" void kernel_launch(void* const* d_in, const int* in_sizes, int n_in, void* d_out, int out_size, void* d_ws, size_t ws_size, hipStream_t stream) {
    static int grid = 0;
    if (grid == 0) {
        if (n_in != 35 || (size_t)out_size != O_END || ws_size < WS_END) { fprintf(stderr, "kernel_launch: unexpected problem: n_in %d out_size %d ws_size %zu (need %zu)\n", n_in, out_size, ws_size, (size_t)WS_END); grid = -1; return; }
        int dev = 0, cus = 0;
        if (hipGetDevice(&dev) != hipSuccess || hipDeviceGetAttribute(&cus, hipDeviceAttributeMultiprocessorCount, dev) != hipSuccess) { grid = -1; return; }
        if (hipFuncSetAttribute((const void*)mk_fwd, hipFuncAttributeMaxDynamicSharedMemorySize, LDS_BYTES) != hipSuccess) { fprintf(stderr, "kernel_launch: hipFuncSetAttribute failed\n"); grid = -1; return; }
        int per_cu = 0;
        if (hipOccupancyMaxActiveBlocksPerMultiprocessor(&per_cu, (const void*)mk_fwd, NWAVES * 64, LDS_BYTES) != hipSuccess || per_cu < 1) fprintf(stderr, "kernel_launch: occupancy query says %d\n", per_cu);
        (void)hipGetLastError();
        if (cus != 256) { fprintf(stderr, "kernel_launch: built for a 256-CU device (unit orders and tail splits), found %d CUs\n", cus); grid = -1; return; }
        grid = cus;
    }
    if (grid < 0) return;
    (void)hipMemsetAsync((char*)d_ws + WS_CTL, 0, CTL_BYTES, stream);
    Args a{};
    for (int i = 0; i < 35; ++i) a.in[i] = (const float*)d_in[i];
    a.out = (float*)d_out; a.ws = (unsigned char*)d_ws;
#if MK_ONE_LAUNCH
#ifdef MK_DUP_PHASE
    a.ph_lo = 0; a.ph_hi = MK_DUP_PHASE + 1; a.li = 0; hipLaunchKernelGGL(mk_fwd, dim3(grid), dim3(NWAVES * 64), LDS_BYTES, stream, a);
    a.ph_lo = MK_DUP_PHASE; a.ph_hi = MK_DUP_PHASE + 1; a.li = 1; hipLaunchKernelGGL(mk_fwd, dim3(grid), dim3(NWAVES * 64), LDS_BYTES, stream, a);
    if (MK_DUP_PHASE + 1 < NPHASE) { a.ph_lo = MK_DUP_PHASE + 1; a.ph_hi = NPHASE; a.li = 2; hipLaunchKernelGGL(mk_fwd, dim3(grid), dim3(NWAVES * 64), LDS_BYTES, stream, a); }
#else
    a.ph_lo = 0; a.ph_hi = NPHASE; a.li = 0;
    hipLaunchKernelGGL(mk_fwd, dim3(grid), dim3(NWAVES * 64), LDS_BYTES, stream, a);
#endif
#else
#ifndef MK_LAST_PHASE
#define MK_LAST_PHASE (NPHASE - 1)
#endif
    for (int p = 0; p <= MK_LAST_PHASE; ++p) { a.ph_lo = p; a.ph_hi = p + 1; hipLaunchKernelGGL(mk_fwd, dim3(grid), dim3(NWAVES * 64), LDS_BYTES, stream, a); }
#endif
}
```

```cpp
#include <hip/hip_runtime.h>
#include <cstdio>
#include <cstdint>
namespace pg8 {
#define PG8_LAS __attribute__((address_space(3)))
typedef unsigned short bf16_t;
typedef short bf16x8 __attribute__((ext_vector_type(8)));
typedef float f32x4 __attribute__((ext_vector_type(4)));
typedef unsigned u32x4 __attribute__((ext_vector_type(4)));
constexpr int BM = 256, BK = 64, HALF = 128, HTB = HALF * BK * 2  , STAGE_BYTES = 8 * HTB, NXCD = 8, WGM = 8;

__host__ __device__ __forceinline__ int lds_byte(int r, int c) { const int st = (r >> 4) * 2 + (c >> 5), rr = r & 15, cc = c & 31, ob = rr * 64 + cc * 2; return st * 1024 + (ob ^ (((ob >> 9) & 1) << 5)); }
__host__ __device__ __forceinline__ void stage_rc(int b, int& R, int& C) { const int st = b / 1024, sb = b % 1024, swz = sb ^ (((sb >> 9) & 1) << 5); R = (st >> 1) * 16 + swz / 64; C = (st & 1) * 32 + (swz % 64) / 2; }
__host__ __device__ __forceinline__ int perm32(int rho) { const int n = rho >> 4, i = rho & 15; return 8 * (i >> 2) + 4 * n + (i & 3); }

typedef __bf16 pk_bf16x2 __attribute__((ext_vector_type(2)));
typedef float pk_f32x2 __attribute__((ext_vector_type(2)));
__device__ __forceinline__ unsigned pk_bf16(float lo, float hi) { pk_f32x2 v = {lo, hi}; pk_bf16x2 b = __builtin_convertvector(v, pk_bf16x2); return __builtin_bit_cast(unsigned, b); }
struct Unit { int pm, pn, kt0, nt, kind, slab; };
struct Gemm { const bf16_t* A; const bf16_t* Bt; int M, N, K, lda, ldb; };

struct StaticOrder {
    int nM, nN, nwg, G, c;
    __host__ __device__ void init(int M, int N, int G_, int c_) { nM = M / BM; nN = N / BM; nwg = nM * nN; G = G_; c = c_; }
    __host__ __device__ bool next(int i, Unit& u) const {
        const long L = (long)i * G + c; if (L >= nwg) return false;
        int wgid = (int)L; { const int q = nwg / NXCD, r = nwg % NXCD, xcd = wgid % NXCD, off = wgid / NXCD; wgid = (xcd < r ? xcd * (q + 1) : r * (q + 1) + (xcd - r) * q) + off; }
        const int nig = WGM * nN, gid = wgid / nig, fm = gid * WGM, gsz = (nM - fm) < WGM ? (nM - fm) : WGM;
        u.pm = fm + ((wgid % nig) % gsz); u.pn = (wgid % nig) / gsz; u.kt0 = 0; u.nt = -1; u.kind = 0; u.slab = 0; return true;
    }
    static constexpr bool STREAMK = false;
    __device__ __forceinline__ void a_ready(const Unit&) const {}
    __device__ __forceinline__ void done(const Unit&) const {}
};


struct XcdOrder {
    static constexpr bool STREAMK = false;
    int nN, x, j;
    __host__ __device__ __forceinline__ void init(int N, int c) { nN = N / BM; x = c & 7; j = c >> 3; }
    __host__ __device__ __forceinline__ bool entry(int e, Unit& u) const {
        if (e < 4 * nN) { u.pn = 8 * (e >> 5) + ((e & 31) >> 2); u.pm = x + 8 * (e & 3); }
        else { const int s = x + 8 * (e - 4 * nN); if (s >= 2 * nN) return false; u.pn = s >> 1; u.pm = 32 + (s & 1); }
        u.kt0 = 0; u.nt = -1; u.kind = 0; u.slab = 0; return true;
    }
    __host__ __device__ __forceinline__ bool next(int i, Unit& u) const { return entry(j + 32 * i, u); }
    __device__ __forceinline__ void a_ready(const Unit&) const {}
    __device__ __forceinline__ void done(const Unit&) const {}
};
typedef __attribute__((address_space(1))) unsigned long long gu64_t; typedef __attribute__((address_space(1))) unsigned gu32_t;
struct StreamKOrder {
    static constexpr bool STREAMK = true;
    int nN, NB, s0, s1, rank;
    unsigned long long* slab; unsigned* flag; unsigned* tmo;
    __device__ __forceinline__ void init(int M, int N, int K, int G, int rank_, unsigned long long* slab_, unsigned* flag_, unsigned* tmo_) {
        nN = N / BM; NB = K / 128; const long I = (long)(M / BM) * nN * NB; s0 = (int)(I * rank_ / G); s1 = (int)(I * (rank_ + 1) / G); rank = rank_; slab = slab_; flag = flag_; tmo = tmo_; }
    __device__ __forceinline__ void set(Unit& u, int unit, int kb0, int nkb, int kind, int sl) const { u.pm = unit / nN; u.pn = unit % nN; u.kt0 = 2 * kb0; u.nt = 2 * nkb; u.kind = kind; u.slab = sl; }
    __device__ __forceinline__ bool next(int i, Unit& u) const {
        const int uf = s0 / NB, r0 = s0 % NB, ul = s1 / NB, r1 = s1 % NB; int idx = i;
        if (r0 != 0) { if (idx == 0) { set(u, uf, r0, NB - r0, 1, rank); return true; } idx -= 1; }
        const int f0 = uf + (r0 != 0 ? 1 : 0), nfull = ul - f0;
        if (idx < nfull) { set(u, f0 + idx, 0, NB, 0, 0); return true; }
        idx -= nfull;
        if (r1 != 0 && idx == 0) { set(u, ul, 0, r1, 2, rank + 1); return true; }
        return false;
    }
    __device__ __forceinline__ void a_ready(const Unit&) const {}
    __device__ __forceinline__ void done(const Unit&) const {}
    __device__ __forceinline__ void store_slab(const f32x4 (&acc)[2][2][4][2], const Unit& u, int wid, int lane) const {
        gu64_t* p = (gu64_t*)slab + ((size_t)(u.slab * 8 + wid) * 32 * 64 + lane) * 2;
#pragma unroll
        for (int r4 = 0; r4 < 8; ++r4) {
#pragma unroll
            for (int j = 0; j < 4; ++j) { const int r = 4 * r4 + j; const f32x4 v = acc[r >> 4][(r >> 3) & 1][(r >> 1) & 3][r & 1];
                const float f0 = v[0], f1 = v[1], f2 = v[2], f3 = v[3];
                __hip_atomic_store(p + j * 128, ((unsigned long long)__float_as_uint(f1) << 32) | __float_as_uint(f0), __ATOMIC_RELAXED, __HIP_MEMORY_SCOPE_AGENT);
                __hip_atomic_store(p + j * 128 + 1, ((unsigned long long)__float_as_uint(f3) << 32) | __float_as_uint(f2), __ATOMIC_RELAXED, __HIP_MEMORY_SCOPE_AGENT); }
            p += 512; asm volatile("" : "+v"(p) :: "memory"); }
        asm volatile("s_waitcnt vmcnt(0)" ::: "memory");
        if (lane == 0) __hip_atomic_fetch_add((gu32_t*)flag + 64 * u.slab, 1u, __ATOMIC_RELAXED, __HIP_MEMORY_SCOPE_AGENT);
    }
    __device__ __forceinline__ void add_slab(f32x4 (&acc)[2][2][4][2], const Unit& u, int wid, int lane) const {
        const unsigned long long t0 = __builtin_amdgcn_s_memrealtime();
        while ((unsigned)__builtin_amdgcn_readfirstlane(__hip_atomic_load((gu32_t*)flag + 64 * u.slab, __ATOMIC_RELAXED, __HIP_MEMORY_SCOPE_AGENT)) < 8u) {
            if (__builtin_amdgcn_s_memrealtime() - t0 > 2000000ull) { if (lane == 0) __hip_atomic_store((gu32_t*)tmo, 1u, __ATOMIC_RELAXED, __HIP_MEMORY_SCOPE_AGENT); break; }
            __builtin_amdgcn_s_sleep(2); }
        gu64_t* p = (gu64_t*)slab + ((size_t)(u.slab * 8 + wid) * 32 * 64 + lane) * 2;
#pragma unroll
        for (int r4 = 0; r4 < 8; ++r4) {
#pragma unroll
            for (int j = 0; j < 4; ++j) { const int r = 4 * r4 + j;
                const unsigned long long lo = __hip_atomic_load(p + j * 128, __ATOMIC_RELAXED, __HIP_MEMORY_SCOPE_AGENT), hi = __hip_atomic_load(p + j * 128 + 1, __ATOMIC_RELAXED, __HIP_MEMORY_SCOPE_AGENT);
                f32x4& a = acc[r >> 4][(r >> 3) & 1][(r >> 1) & 3][r & 1];
                a[0] += __uint_as_float((unsigned)lo); a[1] += __uint_as_float((unsigned)(lo >> 32)); a[2] += __uint_as_float((unsigned)hi); a[3] += __uint_as_float((unsigned)(hi >> 32)); }
            p += 512; asm volatile("" : "+v"(p) :: "memory"); }
    }
};

struct TailSplitOrder {
    static constexpr bool STREAMK = true;
    XcdOrder xo; int c, R, rem, split, NB; float* slabf;
    __device__ __forceinline__ void init(int M, int N, int K, int G, int c_, float* slab_) { xo.init(N, c_); c = c_; const int nwg = (M / BM) * (N / BM); R = nwg / G; rem = nwg - R * G; split = rem ? G / rem : 1; NB = K / 128; slabf = slab_; }
    __device__ __forceinline__ static void leftover(int N, int R, int l, Unit& u) { XcdOrder t; t.init(N, l & 7); t.entry(32 * R + (l >> 3), u); }
    __device__ __forceinline__ bool next(int i, Unit& u) const {
        if (i < R) return xo.next(i, u);
        if (i > R || rem == 0) return false;
        const int l = c / split, part = c % split; if (l >= rem) return false;
        leftover(xo.nN * BM, R, l, u);
        const int kb0 = part * NB / split, kb1 = (part + 1) * NB / split; u.kt0 = 2 * kb0; u.nt = 2 * (kb1 - kb0); u.kind = 1; u.slab = c; return true;
    }
    __device__ __forceinline__ void a_ready(const Unit&) const {}
    __device__ __forceinline__ void done(const Unit&) const {}
    __device__ __forceinline__ void store_slab(const f32x4 (&acc)[2][2][4][2], const Unit& u, int wid, int lane) const {
        unsigned* p = (unsigned*)slabf + ((size_t)(u.slab * 8 + wid) * 16 * 64 + lane) * 4;
#pragma unroll
        for (int r4 = 0; r4 < 4; ++r4) {
#pragma unroll
            for (int j = 0; j < 4; ++j) { const int r2 = 4 * r4 + j; const f32x4& a0 = acc[r2 >> 3][(r2 >> 2) & 1][r2 & 3][0]; const f32x4& a1 = acc[r2 >> 3][(r2 >> 2) & 1][r2 & 3][1];
                u32x4 w; w.x = pk_bf16(a0[0], a0[1]); w.y = pk_bf16(a0[2], a0[3]); w.z = pk_bf16(a1[0], a1[1]); w.w = pk_bf16(a1[2], a1[3]); *(u32x4*)(p + j * 256) = w; }
            p += 1024; asm volatile("" : "+v"(p) :: "memory"); }
    }
    __device__ __forceinline__ void add_slab(f32x4 (&)[2][2][4][2], const Unit&, int, int) const {}
};

template <class Epi, class Sched, bool ALIGN_EPI = false, bool SP2 = false>
__device__ __forceinline__ void gemm_phase(PG8_LAS unsigned char* lds, const Gemm g, const Sched& S, const Epi& E) {
    const int tid = threadIdx.x, wid = __builtin_amdgcn_readfirstlane(tid >> 6), lane = tid & 63, wr = wid >> 2, wc = wid & 3, fr = lane & 15, fq = lane >> 4;
    const int K = g.K, nt = K / BK;
    unsigned voffA[2], voffB[2];
#pragma unroll
    for (int i = 0; i < 2; ++i) { int R, C; stage_rc(tid * 16 + i * 8192, R, C); const int Rb = Epi::PERM ? ((R & ~31) + perm32(R & 31)) : R;
        voffA[i] = (unsigned)(R * g.lda + C) * 2u; voffB[i] = (unsigned)(Rb * g.ldb + C) * 2u; }
    const size_t kstep = (size_t)(BK * 2);
    const size_t hstepA = (size_t)HALF * g.lda * 2, hstepB = (size_t)HALF * g.ldb * 2;
    const size_t tstepA = 2 * hstepA, tstepB = 2 * hstepB;
    const unsigned ldsw = (unsigned)wid * 1024u;
    const int aoff = lds_byte(wr * 64 + fr, fq * 8), boff = lds_byte(wc * 32 + fr, fq * 8);
#define PG8_SA(b, h) (((b) * 2 + (h)) * HTB)
#define PG8_SB(b, h) ((4 + (b) * 2 + (h)) * HTB)
#define PG8_STAGE(bufoff, gbase, voff) do { _Pragma("unroll") for (int _i = 0; _i < 2; ++_i) \
        __builtin_amdgcn_global_load_lds((const unsigned*)((const char*)(gbase) + (voff)[_i]), (PG8_LAS unsigned*)(lds + (bufoff) + ldsw + _i * 8192), 16, 0, 0); } while (0)
#define PG8_LDA(dst, b, h) do { _Pragma("unroll") for (int m = 0; m < 4; ++m) _Pragma("unroll") for (int k = 0; k < 2; ++k) dst[m][k] = *(const PG8_LAS bf16x8*)(lds + PG8_SA(b, h) + aoff + m * 2048 + k * 1024); } while (0)
#define PG8_LDB(dst, b, h) do { _Pragma("unroll") for (int n = 0; n < 2; ++n) _Pragma("unroll") for (int k = 0; k < 2; ++k) dst[n][k] = *(const PG8_LAS bf16x8*)(lds + PG8_SB(b, h) + boff + n * 2048 + k * 1024); } while (0)
#define PG8_MMA(ai, bj, At, Bt) do { __builtin_amdgcn_s_setprio(1); _Pragma("unroll") for (int m = 0; m < 4; ++m) _Pragma("unroll") for (int n = 0; n < 2; ++n) _Pragma("unroll") for (int k = 0; k < 2; ++k) \
        acc[ai][bj][m][n] = __builtin_amdgcn_mfma_f32_16x16x32_bf16(Bt[n][k], At[m][k], acc[ai][bj][m][n], 0, 0, 0); __builtin_amdgcn_s_setprio(0); } while (0)
#define PG8_WAIT_V(n) asm volatile("s_waitcnt vmcnt(" #n ")" ::: "memory")
#define PG8_WAIT_L(n) asm volatile("s_waitcnt lgkmcnt(" #n ")" ::: "memory")
#define PG8_BAR __builtin_amdgcn_s_barrier()
#define PG8_SCHED __builtin_amdgcn_sched_barrier(0)
    Unit cur, nxt; int ui = 0;
    if (!S.next(0, cur)) return;
    int cnt = cur.nt < 0 ? nt : cur.nt;
    f32x4 acc[2][2][4][2];
#pragma unroll
    for (int a = 0; a < 2; ++a)
#pragma unroll
        for (int b = 0; b < 2; ++b)
#pragma unroll
            for (int m = 0; m < 4; ++m)
#pragma unroll
                for (int n = 0; n < 2; ++n) acc[a][b][m][n] = (f32x4){0.f, 0.f, 0.f, 0.f};
    bf16x8 At[4][2], B0[2][2], B1[2][2];
    const char* cA = (const char*)g.A + (size_t)cur.pm * tstepA + (size_t)cur.kt0 * kstep; const char* cB = (const char*)g.Bt + (size_t)cur.pn * tstepB + (size_t)cur.kt0 * kstep;
    S.a_ready(cur);
    if constexpr (SP2) {
        PG8_STAGE(PG8_SB(0, 0), cB, voffB); PG8_STAGE(PG8_SB(0, 1), cB + hstepB, voffB); PG8_STAGE(PG8_SA(0, 0), cA, voffA); PG8_STAGE(PG8_SA(0, 1), cA + hstepA, voffA);
        if (wr == 1) PG8_BAR;
        PG8_WAIT_V(2); PG8_BAR;
        PG8_STAGE(PG8_SB(1, 0), cB + kstep, voffB); PG8_STAGE(PG8_SA(1, 0), cA + kstep, voffA); PG8_STAGE(PG8_SB(1, 1), cB + hstepB + kstep, voffB);
        PG8_WAIT_V(6); PG8_BAR;
    } else {
        PG8_STAGE(PG8_SB(0, 0), cB, voffB); PG8_STAGE(PG8_SA(0, 0), cA, voffA); PG8_STAGE(PG8_SB(0, 1), cB + hstepB, voffB); PG8_STAGE(PG8_SA(0, 1), cA + hstepA, voffA);
        if (wr == 1) PG8_BAR;
        PG8_WAIT_V(4); PG8_BAR;
        PG8_STAGE(PG8_SB(1, 0), cB + kstep, voffB); PG8_STAGE(PG8_SA(1, 0), cA + kstep, voffA); PG8_STAGE(PG8_SB(1, 1), cB + hstepB + kstep, voffB);
        PG8_WAIT_V(6); PG8_BAR;
    }
    for (;;) {
        const bool has_next = S.next(ui + 1, nxt);
        const char* nA = has_next ? (const char*)g.A + (size_t)nxt.pm * tstepA + (size_t)nxt.kt0 * kstep : cA; const char* nB = has_next ? (const char*)g.Bt + (size_t)nxt.pn * tstepB + (size_t)nxt.kt0 * kstep : cB;
#pragma unroll 1
        for (int t = 0; t < cnt; t += 2) {
            const bool last = (t == cnt - 2);
            if constexpr (Epi::KHOOK) { const int kt = cur.kt0 + t; if (t > 0 && (kt == 32 || kt == 48)) E.khook(acc, cur, kt, wr, wc, fr, fq); }
            const char* a1 = cA + (size_t)(t + 1) * kstep;
            const char* a2 = last ? nA : cA + (size_t)(t + 2) * kstep; const char* b2 = last ? nB : cB + (size_t)(t + 2) * kstep;
            const char* a3 = a2 + kstep; const char* b3 = b2 + kstep;
            if (last && has_next) S.a_ready(nxt);
            if constexpr (SP2) {
            PG8_LDB(B0, 0, 0); PG8_LDB(B1, 0, 1); PG8_SCHED; PG8_LDA(At, 0, 0); PG8_STAGE(PG8_SA(1, 1), a1 + hstepA, voffA);
            PG8_WAIT_V(8); PG8_WAIT_L(0); PG8_BAR; PG8_MMA(0, 0, At, B0); PG8_MMA(0, 1, At, B1); PG8_BAR; PG8_SCHED;
            PG8_LDA(At, 0, 1); PG8_STAGE(PG8_SB(0, 0), b2, voffB); PG8_STAGE(PG8_SB(0, 1), b2 + hstepB, voffB); PG8_STAGE(PG8_SA(0, 0), a2, voffA);
            PG8_WAIT_V(8); PG8_WAIT_L(0); PG8_BAR; PG8_MMA(1, 0, At, B0); PG8_MMA(1, 1, At, B1); PG8_BAR; PG8_SCHED;
            PG8_LDB(B0, 1, 0); PG8_LDB(B1, 1, 1); PG8_SCHED; PG8_LDA(At, 1, 0); PG8_STAGE(PG8_SA(0, 1), a2 + hstepA, voffA);
            PG8_WAIT_V(8); PG8_WAIT_L(0); PG8_BAR; PG8_MMA(0, 0, At, B0); PG8_MMA(0, 1, At, B1); PG8_BAR; PG8_SCHED;
            PG8_LDA(At, 1, 1); PG8_STAGE(PG8_SB(1, 0), b3, voffB); PG8_STAGE(PG8_SB(1, 1), b3 + hstepB, voffB); PG8_STAGE(PG8_SA(1, 0), a3, voffA);
            PG8_WAIT_V(8); PG8_WAIT_L(0); PG8_BAR; PG8_MMA(1, 0, At, B0); PG8_MMA(1, 1, At, B1); PG8_BAR; PG8_SCHED;
            } else {
            PG8_LDB(B0, 0, 0); PG8_SCHED; PG8_LDA(At, 0, 0); PG8_STAGE(PG8_SA(1, 1), a1 + hstepA, voffA);
            PG8_WAIT_L(8); PG8_BAR; PG8_WAIT_L(0); PG8_MMA(0, 0, At, B0); PG8_BAR; PG8_SCHED;
            PG8_LDB(B1, 0, 1); PG8_STAGE(PG8_SB(0, 0), b2, voffB);
            PG8_BAR; PG8_WAIT_L(0); PG8_MMA(0, 1, At, B1); PG8_BAR;
            PG8_LDA(At, 0, 1); PG8_STAGE(PG8_SA(0, 0), a2, voffA);
            PG8_BAR; PG8_WAIT_L(0); PG8_MMA(1, 0, At, B0); PG8_BAR; PG8_SCHED;
            PG8_STAGE(PG8_SB(0, 1), b2 + hstepB, voffB);
            PG8_WAIT_V(6); PG8_BAR; PG8_MMA(1, 1, At, B1); PG8_BAR;
            PG8_LDB(B0, 1, 0); PG8_SCHED; PG8_LDA(At, 1, 0); PG8_STAGE(PG8_SA(0, 1), a2 + hstepA, voffA);
            PG8_WAIT_L(8); PG8_BAR; PG8_WAIT_L(0); PG8_MMA(0, 0, At, B0); PG8_BAR; PG8_SCHED;
            PG8_LDB(B1, 1, 1); PG8_STAGE(PG8_SB(1, 0), b3, voffB);
            PG8_BAR; PG8_WAIT_L(0); PG8_MMA(0, 1, At, B1); PG8_BAR;
            PG8_LDA(At, 1, 1); PG8_STAGE(PG8_SA(1, 0), a3, voffA);
            PG8_BAR; PG8_WAIT_L(0); PG8_MMA(1, 0, At, B0); PG8_BAR; PG8_SCHED;
            PG8_STAGE(PG8_SB(1, 1), b3 + hstepB, voffB);
            PG8_WAIT_V(6); PG8_BAR; PG8_MMA(1, 1, At, B1); PG8_BAR;
            }
        }
        if constexpr (ALIGN_EPI) { if (wr == 0) PG8_BAR; }
        if constexpr (Sched::STREAMK) { __builtin_amdgcn_sched_barrier(0); if (cur.kind == 2) S.add_slab(acc, cur, wid, lane); __builtin_amdgcn_sched_barrier(0);
            if (cur.kind == 1) { if constexpr (Epi::KHOOK) E.pre_slab(acc, cur, wr, wc, fr, fq); S.store_slab(acc, cur, wid, lane); } else E(acc, cur, wr, wc, fr, fq); __builtin_amdgcn_sched_barrier(0); }
        else if constexpr (!Epi::AFTER_DRAIN) { E(acc, cur, wr, wc, fr, fq); S.done(cur); }
        if (!has_next) break;
#pragma unroll
        for (int a = 0; a < 2; ++a)
#pragma unroll
            for (int b = 0; b < 2; ++b)
#pragma unroll
                for (int m = 0; m < 4; ++m)
#pragma unroll
                    for (int n = 0; n < 2; ++n) acc[a][b][m][n] = (f32x4){0.f, 0.f, 0.f, 0.f};
        cur = nxt; cA = nA; cB = nB; ++ui; cnt = cur.nt < 0 ? nt : cur.nt;
        if constexpr (ALIGN_EPI) { if (wr == 1) PG8_BAR; }
    }
    PG8_WAIT_V(0);
    if constexpr (!ALIGN_EPI) { if (wr == 0) PG8_BAR; }
    PG8_BAR;
    if constexpr (Epi::AFTER_DRAIN) { E.fused(acc, cur, wr, wc, fr, fq, lds, wid, lane); S.done(cur); }
#undef PG8_SA
#undef PG8_SB
#undef PG8_STAGE
#undef PG8_LDA
#undef PG8_LDB
#undef PG8_MMA
#undef PG8_WAIT_V
#undef PG8_WAIT_L
#undef PG8_BAR
#undef PG8_SCHED
}
}

#ifndef PG8_SP2
#define PG8_SP2 true
#endif
#ifndef PG8_ALIGN
#define PG8_ALIGN true
#endif

constexpr int DM = 4096, NTP = 8192, NTS = 512, MTOK = 8704, DFF = 11008, SEQ = 2048, NB = 4, NDB = 128, DSEQ = 4;
constexpr int PA = 6592, PA_PAD = 6656, PBW = 3072, PCW = 1024, PGW = 12288, NWIN = 23040, PIN = 22976;
constexpr int DA = 2048, HA = 32, NMEM = 256;
constexpr float EPS = 1e-6f, GN_EPS = 64e-5f;
constexpr float QSCALE = 0.0625f * 1.4426950408889634f;

constexpr size_t O_Y = 0, O_MK = 35651584, O_MV = 36700160, O_RWP = 37748736, O_SHP = 38273024, O_CVP = 38299392, O_RWS = 38307584, O_SHS = 55084800, O_CVS = 55928576, O_END = 56190720;

constexpr size_t al256(size_t x) { return (x + 255) & ~(size_t)255; }
constexpr size_t WS_CTL = 0, CTL_BYTES = 1u << 20;
constexpr size_t WS_W1A = WS_CTL + CTL_BYTES;
constexpr size_t WS_W1B = WS_W1A + (size_t)2 * DFF * DM * 2;
constexpr size_t WS_WIN = WS_W1B + (size_t)DM * DFF * 2;
constexpr size_t WS_WMEM = WS_WIN + (size_t)NWIN * DM * 2;
constexpr size_t WS_WBRA = WS_WMEM + (size_t)2048 * DM * 2;
constexpr size_t WS_WBRB = WS_WBRA + (size_t)DM * 2048 * 2;
constexpr size_t WS_WBRC = WS_WBRB + (size_t)DM * 1024 * 2;
constexpr size_t WS_WOUT = WS_WBRC + (size_t)DM * 1024 * 2;
constexpr size_t WS_W2A = WS_WOUT + (size_t)DM * DM * 2;
constexpr size_t WS_W2B = WS_W2A + (size_t)2 * DFF * DM * 2;
constexpr size_t WS_WLWA = WS_W2B + (size_t)DM * DFF * 2;
constexpr size_t WS_WLG = WS_WLWA + (size_t)4096 * 256 * 2;
constexpr size_t WS_XB = WS_WLG + (size_t)2048 * 256 * 2;
constexpr size_t WS_ACT = WS_XB + (size_t)MTOK * DM * 2;
constexpr size_t WS_PAF = WS_ACT + (size_t)MTOK * DFF * 2;
constexpr size_t WS_PB = WS_PAF + (size_t)MTOK * PA_PAD * 4;
constexpr size_t WS_Q = WS_PB + (size_t)MTOK * PBW * 2;
constexpr size_t WS_GATE = WS_Q + (size_t)MTOK * PCW * 2;
constexpr size_t WS_LIN = WS_GATE + (size_t)MTOK * PGW * 2;
constexpr size_t WS_G = WS_LIN + (size_t)MTOK * 512 * 2;
constexpr size_t WS_YA = WS_G + (size_t)MTOK * 2048 * 2;
constexpr size_t WS_YB = WS_YA + (size_t)MTOK * 2048 * 2;
constexpr size_t WS_YC = WS_YB + (size_t)MTOK * 1024 * 2;
constexpr size_t WS_MRG = WS_YC + (size_t)MTOK * 1024 * 2;
constexpr size_t WS_MEMB = WS_MRG + (size_t)MTOK * DM * 2;
constexpr size_t WS_KB = WS_MEMB + (size_t)1024 * DM * 2;
constexpr size_t WS_VT = WS_KB + (size_t)1024 * 1024 * 2;
constexpr size_t WS_SLOT = WS_VT + (size_t)1024 * 1024 * 2;
constexpr size_t WS_RSTD0 = WS_SLOT + (size_t)MTOK * 64 * 4;
constexpr size_t WS_RSTD1 = WS_RSTD0 + 65536;
constexpr size_t WS_RSTD2 = WS_RSTD1 + 65536;
constexpr size_t WS_RSTDM = WS_RSTD2 + 65536;
constexpr size_t WS_INVN = WS_RSTDM + 65536;
constexpr size_t WS_RK = WS_INVN + (size_t)MTOK * 32 * 4;
constexpr size_t WS_SLAB = WS_RK + (size_t)MTOK * 32 * 4;
constexpr size_t WS_END = WS_SLAB + (size_t)256 * 262144;
static_assert(WS_END <= (size_t)2029 * 1024 * 1024, "d_ws map exceeds the guaranteed workspace");
static_assert((size_t)MTOK * 2048 * 4 <= (size_t)MTOK * DM * 2 && (size_t)MTOK * DM * 4 <= (size_t)MTOK * DFF * 2 && (size_t)2 * MTOK * 2048 * 4 <= (size_t)MTOK * DFF * 2, "overlays");
constexpr size_t WS_YSCAN = WS_XB, WS_WDEC = WS_ACT, WS_AVAL = WS_ACT + (size_t)MTOK * 2048 * 4, WS_MACC = WS_ACT;

constexpr int RING_OFF = 0, RING_BYTES = 131072;
constexpr int LDSCTL_OFF = 135168, MISC_OFF = LDSCTL_OFF + 320;
constexpr int LDS_BYTES = 147456;
constexpr int NWAVES = 8;

#define GAS __attribute__((address_space(1)))
#define LAS __attribute__((address_space(3)))
typedef unsigned short bf16;
typedef unsigned v4u __attribute__((ext_vector_type(4)));
typedef unsigned v2u __attribute__((ext_vector_type(2)));
typedef float f32x4 __attribute__((ext_vector_type(4)));
typedef float f32x2 __attribute__((ext_vector_type(2)));
typedef short bf16x8 __attribute__((ext_vector_type(8)));
#define LDS_WAIT() asm volatile("s_waitcnt lgkmcnt(0)" ::: "memory")
#define VM_WAIT() asm volatile("s_waitcnt vmcnt(0)" ::: "memory")
__device__ __forceinline__ unsigned f2bf(float f) { unsigned u = __builtin_bit_cast(unsigned, f); return (u + 0x7fffu + ((u >> 16) & 1u)) >> 16; }
__device__ __forceinline__ unsigned pk2(float lo, float hi) { return f2bf(lo) | (f2bf(hi) << 16); }
__device__ __forceinline__ float bf_lo(unsigned w) { return __builtin_bit_cast(float, w << 16); }
__device__ __forceinline__ float bf_hi(unsigned w) { return __builtin_bit_cast(float, w & 0xffff0000u); }
__device__ __forceinline__ float fast_exp(float x) { return __builtin_amdgcn_exp2f(x * 1.4426950408889634f); }
__device__ __forceinline__ float fast_sigmoid(float x) { return __builtin_amdgcn_rcpf(1.0f + fast_exp(-x)); }
typedef __bf16 bf16x2_t __attribute__((ext_vector_type(2)));
__device__ __forceinline__ unsigned cvt_pk_bf16(float lo, float hi) { f32x2 v = {lo, hi}; bf16x2_t b = __builtin_convertvector(v, bf16x2_t); return __builtin_bit_cast(unsigned, b); }

namespace epi {
using pg8::Unit;
typedef pg8::f32x4 A4;
#define EPI_ACC const A4 (&acc)[2][2][4][2]

template <bool LOCAL> struct SwiGLU_ {
    static constexpr bool PERM = true, AFTER_DRAIN = false, KHOOK = false;
    bf16* O; const float* rstd; const LAS float* rl;
    __device__ __forceinline__ void operator()(EPI_ACC, const Unit& u, int wr, int wc, int fr, int fq) const {
        const int row0 = u.pm * 256 + wr * 64 + fr, col0 = u.pn * 128 + wc * 32 + 8 * fq;
        const int rb = (u.pm >= 32 ? 256 + (u.pm - 32) * 256 : 0) - u.pm * 256;
#pragma unroll
        for (int ai = 0; ai < 2; ++ai)
#pragma unroll
            for (int m = 0; m < 4; ++m) {
                const int row = row0 + ai * 128 + m * 16; const float rs = LOCAL ? rl[row + rb] : rstd[row];
                float o[8];
#pragma unroll
                for (int n = 0; n < 2; ++n)
#pragma unroll
                    for (int e = 0; e < 4; ++e) { const float g = acc[ai][0][m][n][e] * rs, up = acc[ai][1][m][n][e] * rs; o[n * 4 + e] = g * fast_sigmoid(g) * up; }
                v4u w; w.x = cvt_pk_bf16(o[0], o[1]); w.y = cvt_pk_bf16(o[2], o[3]); w.z = cvt_pk_bf16(o[4], o[5]); w.w = cvt_pk_bf16(o[6], o[7]);
                *(v4u*)(O + (size_t)row * DFF + col0) = w;
            }
    }
};
typedef SwiGLU_<false> SwiGLU;
typedef SwiGLU_<true> SwiGLUL;

template <bool BASE_BF16, bool OUT_F32> struct Resid {
    static constexpr bool PERM = true, AFTER_DRAIN = false, KHOOK = false;
    const float* base_p; const float* base_s;
    float* out; bf16* xb; float* slots; float scale;
    __device__ __forceinline__ void row_op(const A4 (&v)[2][2], int row, int pn, int wc, int fq) const {
        const int colb = pn * 256 + wc * 32 + 8 * fq;
        bf16* xp = xb + (size_t)row * DM + colb;
        float ss = 0.f;
#pragma unroll
        for (int bj = 0; bj < 2; ++bj) {
            A4 b0, b1;
            if (BASE_BF16) { const v4u bw = *(const v4u*)(xp + bj * 128); b0 = (A4){bf_lo(bw.x), bf_hi(bw.x), bf_lo(bw.y), bf_hi(bw.y)}; b1 = (A4){bf_lo(bw.z), bf_hi(bw.z), bf_lo(bw.w), bf_hi(bw.w)}; }
            else { const float* bp = (row < NTP ? base_p : base_s) + (size_t)row * DM + colb; b0 = *(const A4*)(bp + bj * 128); b1 = *(const A4*)(bp + bj * 128 + 4); }
            const A4 v0 = b0 + v[bj][0] * scale, v1 = b1 + v[bj][1] * scale;
            if (OUT_F32) { float* op = out + (size_t)row * DM + colb; *(A4*)(op + bj * 128) = v0; *(A4*)(op + bj * 128 + 4) = v1; }
            else { v4u w; w.x = cvt_pk_bf16(v0[0], v0[1]); w.y = cvt_pk_bf16(v0[2], v0[3]); w.z = cvt_pk_bf16(v1[0], v1[1]); w.w = cvt_pk_bf16(v1[2], v1[3]); *(v4u*)(xp + bj * 128) = w; }
            ss += (v0[0] * v0[0] + v0[1] * v0[1]) + (v0[2] * v0[2] + v0[3] * v0[3]) + (v1[0] * v1[0] + v1[1] * v1[1]) + (v1[2] * v1[2] + v1[3] * v1[3]);
        }
        ss += __shfl_xor(ss, 16); ss += __shfl_xor(ss, 32);
        if (fq == 0) slots[(size_t)row * 64 + pn * 4 + wc] = ss;
    }
    __device__ __forceinline__ void operator()(EPI_ACC, const Unit& u, int wr, int wc, int fr, int fq) const {
        const int row0 = u.pm * 256 + wr * 64 + fr;
#pragma unroll
        for (int ai = 0; ai < 2; ++ai)
#pragma unroll
            for (int m = 0; m < 4; ++m) { const A4 v[2][2] = {{acc[ai][0][m][0], acc[ai][0][m][1]}, {acc[ai][1][m][0], acc[ai][1][m][1]}}; row_op(v, row0 + ai * 128 + m * 16, u.pn, wc, fq); }
    }
};

struct Win {
    static constexpr bool PERM = true, AFTER_DRAIN = false, KHOOK = false;
    bf16* pa; bf16* pb; bf16* q; unsigned char* gate; const LAS float* rl; float* shp; float* shs;
    __device__ __forceinline__ void st8(EPI_ACC, int rb, int colb, int row0) const {
#pragma unroll
        for (int ai = 0; ai < 2; ++ai)
#pragma unroll
            for (int m = 0; m < 4; ++m) { const int row = row0 + ai * 128 + m * 16; const float rs = rl[row + rb]; unsigned char* op = gate + (size_t)row * PGW + colb;
#pragma unroll
                for (int bj = 0; bj < 2; ++bj) { unsigned w[2];
#pragma unroll
                    for (int n = 0; n < 2; ++n) { float g[4];
#pragma unroll
                        for (int e = 0; e < 4; ++e) g[e] = fmaxf(fast_sigmoid(acc[ai][bj][m][n][e] * rs) * 255.0f, 1.0f);
                        unsigned x = __builtin_amdgcn_cvt_pk_u8_f32(g[0], 0, 0u); x = __builtin_amdgcn_cvt_pk_u8_f32(g[1], 1, x); x = __builtin_amdgcn_cvt_pk_u8_f32(g[2], 2, x); x = __builtin_amdgcn_cvt_pk_u8_f32(g[3], 3, x);
                        w[n] = x; }
                    *(v2u*)(op + bj * 128) = (v2u){w[0], w[1]}; } }
    }
    template <bool SG> __device__ __forceinline__ void st16(EPI_ACC, int rb, bf16* O, int ld, int colb, float sc, int row0) const {
#pragma unroll
        for (int ai = 0; ai < 2; ++ai)
#pragma unroll
            for (int m = 0; m < 4; ++m) { const int row = row0 + ai * 128 + m * 16; const float rs = rl[row + rb] * sc; bf16* op = O + (size_t)row * ld + colb;
#pragma unroll
                for (int bj = 0; bj < 2; ++bj) { A4 v0 = acc[ai][bj][m][0] * rs, v1 = acc[ai][bj][m][1] * rs;
                    if (SG) {
#pragma unroll
                        for (int e = 0; e < 4; ++e) { v0[e] = fast_sigmoid(v0[e]); v1[e] = fast_sigmoid(v1[e]); } }
                    v4u w; w.x = cvt_pk_bf16(v0[0], v0[1]); w.y = cvt_pk_bf16(v0[2], v0[3]); w.z = cvt_pk_bf16(v1[0], v1[1]); w.w = cvt_pk_bf16(v1[2], v1[3]);
                    *(v4u*)(op + bj * 128) = w; } }
    }
    __device__ __forceinline__ void operator()(EPI_ACC, const Unit& u, int wr, int wc, int fr, int fq) const {
        const int row0 = u.pm * 256 + wr * 64 + fr, cw = wc * 32 + 8 * fq;
        const int rb = (u.pm >= 32 ? 256 + (u.pm - 32) * 256 : 0) - u.pm * 256;
        if (u.pn < 26) {
            const int colb = u.pn * 256 + cw;
#pragma unroll
            for (int ai = 0; ai < 2; ++ai)
#pragma unroll
                for (int m = 0; m < 4; ++m) { const int row = row0 + ai * 128 + m * 16; const float rs = rl[row + rb]; bf16* op = pa + (size_t)row * PA_PAD + colb;
                    const bool last = row < NTP ? ((row & (SEQ - 1)) == SEQ - 1) : (((row - NTP) & (DSEQ - 1)) == DSEQ - 1);
                    float* sh = row < NTP ? shp + (size_t)(row >> 11) * PA : shs + (size_t)((row - NTP) >> 2) * PA;
#pragma unroll
                    for (int bj = 0; bj < 2; ++bj) { const A4 v0 = acc[ai][bj][m][0] * rs, v1 = acc[ai][bj][m][1] * rs;
                        v4u w; w.x = cvt_pk_bf16(v0[0], v0[1]); w.y = cvt_pk_bf16(v0[2], v0[3]); w.z = cvt_pk_bf16(v1[0], v1[1]); w.w = cvt_pk_bf16(v1[2], v1[3]);
                        *(v4u*)(op + bj * 128) = w;
                        if (last && colb + bj * 128 < PA) { *(A4*)(sh + colb + bj * 128) = v0; *(A4*)(sh + colb + bj * 128 + 4) = v1; } } }
        } else if (u.pn < 38) st16<false>(acc, rb, pb, PBW, (u.pn - 26) * 256 + cw, 1.f, row0);
        else if (u.pn < 42) st16<false>(acc, rb, q, PCW, (u.pn - 38) * 256 + cw, QSCALE, row0);
        else st8(acc, rb, (u.pn - 42) * 256 + cw, row0);
    }
};

struct MemKV {
    static constexpr bool PERM = true, AFTER_DRAIN = false, KHOOK = false;
    float* outk; float* outv; bf16* kb; bf16* vt; const float* rstd;
    __device__ __forceinline__ void operator()(EPI_ACC, const Unit& u, int wr, int wc, int fr, int fq) const {
        const int row0 = u.pm * 256 + wr * 64 + fr; const bool isv = u.pn >= 4; const int h = u.pn & 3; const int cw = wc * 32 + 8 * fq;
        float* of = isv ? outv : outk;
#pragma unroll
        for (int ai = 0; ai < 2; ++ai)
#pragma unroll
            for (int m = 0; m < 4; ++m) { const int row = row0 + ai * 128 + m * 16; const float rs = rstd[row];
                const int b = row >> 8, key = row & 255, kk = key & 31; const int pos = (key & ~31) + 8 * ((kk & 15) >> 2) + (kk & 3) + 4 * (kk >> 4);
#pragma unroll
                for (int bj = 0; bj < 2; ++bj) { const A4 v0 = acc[ai][bj][m][0] * rs, v1 = acc[ai][bj][m][1] * rs; const int d0 = bj * 128 + cw;
                    float* op = of + (size_t)row * 1024 + h * 256 + d0; *(A4*)op = v0; *(A4*)(op + 4) = v1;
                    if (!isv) { v4u w; w.x = cvt_pk_bf16(v0[0], v0[1]); w.y = cvt_pk_bf16(v0[2], v0[3]); w.z = cvt_pk_bf16(v1[0], v1[1]); w.w = cvt_pk_bf16(v1[2], v1[3]);
                        *(v4u*)(kb + (size_t)row * 1024 + h * 256 + d0) = w; }
                    else { bf16* vp = vt + ((size_t)(b * 4 + h) * 256 + d0) * 256 + pos;
#pragma unroll
                        for (int e = 0; e < 4; ++e) { vp[(size_t)e * 256] = (bf16)f2bf(v0[e]); vp[(size_t)(4 + e) * 256] = (bf16)f2bf(v1[e]); } }
                } }
    }
};

struct LoraWA {
    static constexpr bool PERM = true, AFTER_DRAIN = false, KHOOK = false;
    bf16* wdec; bf16* aval; const float* w0; const float* a0;
    template <bool ISA> __device__ __forceinline__ void run(EPI_ACC, bf16* O, const float* bias, int colb, int row0) const {
#pragma unroll
        for (int bj = 0; bj < 2; ++bj) { const A4 bv0 = *(const A4*)(bias + colb + bj * 128), bv1 = *(const A4*)(bias + colb + bj * 128 + 4);
#pragma unroll
            for (int ai = 0; ai < 2; ++ai)
#pragma unroll
                for (int m = 0; m < 4; ++m) { const int row = row0 + ai * 128 + m * 16; A4 v0 = acc[ai][bj][m][0] + bv0, v1 = acc[ai][bj][m][1] + bv1;
#pragma unroll
                    for (int e = 0; e < 4; ++e) { v0[e] = fast_sigmoid(v0[e]); v1[e] = fast_sigmoid(v1[e]); }
                    if (!ISA) { v0 = v0 * 0.8750387749145276f; v1 = v1 * 0.8750387749145276f; }
                    v4u w; w.x = cvt_pk_bf16(v0[0], v0[1]); w.y = cvt_pk_bf16(v0[2], v0[3]); w.z = cvt_pk_bf16(v1[0], v1[1]); w.w = cvt_pk_bf16(v1[2], v1[3]);
                    *(v4u*)(O + (size_t)row * 2048 + colb + bj * 128) = w; }
            asm volatile("" ::: "memory"); }
    }
    __device__ __forceinline__ void operator()(EPI_ACC, const Unit& u, int wr, int wc, int fr, int fq) const {
        const int row0 = u.pm * 256 + wr * 64 + fr; const int colb = (u.pn & 7) * 256 + wc * 32 + 8 * fq;
        if (u.pn >= 8) run<true>(acc, aval, a0, colb, row0); else run<false>(acc, wdec, w0, colb, row0);
    }
};
struct LoraG {
    static constexpr bool PERM = true, AFTER_DRAIN = false, KHOOK = false;
    bf16* O;
    __device__ __forceinline__ void operator()(EPI_ACC, const Unit& u, int wr, int wc, int fr, int fq) const {
        const int row0 = u.pm * 256 + wr * 64 + fr, colb = u.pn * 256 + wc * 32 + 8 * fq;
#pragma unroll
        for (int ai = 0; ai < 2; ++ai)
#pragma unroll
            for (int m = 0; m < 4; ++m) { const int row = row0 + ai * 128 + m * 16; bf16* op = O + (size_t)row * 2048 + colb;
#pragma unroll
                for (int bj = 0; bj < 2; ++bj) { const A4 v0 = acc[ai][bj][m][0], v1 = acc[ai][bj][m][1];
                    v4u w; w.x = cvt_pk_bf16(v0[0], v0[1]); w.y = cvt_pk_bf16(v0[2], v0[3]); w.z = cvt_pk_bf16(v1[0], v1[1]); w.w = cvt_pk_bf16(v1[2], v1[3]);
                    *(v4u*)(op + bj * 128) = w; } }
    }
};
struct GateCat {
    static constexpr bool PERM = true, AFTER_DRAIN = false, KHOOK = true;
    const unsigned char* gate; bf16* mrg;
    __device__ __forceinline__ static void unpack8(const v2u w, float (&g)[8]) { g[0] = (float)(w.x & 0xffu); g[1] = (float)((w.x >> 8) & 0xffu); g[2] = (float)((w.x >> 16) & 0xffu); g[3] = (float)(w.x >> 24); g[4] = (float)(w.y & 0xffu); g[5] = (float)((w.y >> 8) & 0xffu); g[6] = (float)((w.y >> 16) & 0xffu); g[7] = (float)(w.y >> 24); }
    template <int MODE> __device__ __forceinline__ void scale(A4 (&acc)[2][2][4][2], const Unit& u, int seg, int wr, int wc, int fr, int fq) const {
        const int row0 = u.pm * 256 + wr * 64 + fr, colb = u.pn * 256 + wc * 32 + 8 * fq;
#pragma unroll
        for (int ai = 0; ai < 2; ++ai) {
            v2u gw[4][2], hw[4][2];
#pragma unroll
            for (int m = 0; m < 4; ++m) { const unsigned char* gp = gate + (size_t)(row0 + ai * 128 + m * 16) * PGW + seg * DM + colb;
#pragma unroll
                for (int bj = 0; bj < 2; ++bj) { gw[m][bj] = *(const v2u*)(gp + bj * 128); if (MODE == 1) hw[m][bj] = *(const v2u*)(gp + DM + bj * 128); else hw[m][bj] = gw[m][bj]; } }
#pragma unroll
            for (int m = 0; m < 4; ++m)
#pragma unroll
                for (int bj = 0; bj < 2; ++bj) { float g[8]; unpack8(gw[m][bj], g);
                    if (MODE == 1) { float h[8]; unpack8(hw[m][bj], h);
#pragma unroll
                        for (int e = 0; e < 8; ++e) g[e] *= __builtin_amdgcn_rcpf(h[e]); }
                    else {
#pragma unroll
                        for (int e = 0; e < 8; ++e) g[e] *= (1.0f / 255.0f); }
#pragma unroll
                    for (int e = 0; e < 4; ++e) { acc[ai][bj][m][0][e] *= g[e]; acc[ai][bj][m][1][e] *= g[4 + e]; } }
            asm volatile("" ::: "memory"); }
    }
    __device__ __forceinline__ void khook(A4 (&acc)[2][2][4][2], const Unit& u, int kt, int wr, int wc, int fr, int fq) const { scale<1>(acc, u, kt == 32 ? 0 : 1, wr, wc, fr, fq); }
    __device__ __forceinline__ void pre_slab(A4 (&acc)[2][2][4][2], const Unit& u, int wr, int wc, int fr, int fq) const { scale<0>(acc, u, u.kt0 < 32 ? 0 : (u.kt0 < 48 ? 1 : 2), wr, wc, fr, fq); }
    __device__ __forceinline__ void row_op(const A4 (&v)[2][2], int row, int pn, int wc, int fq) const {
        bf16* op = mrg + (size_t)row * DM + pn * 256 + wc * 32 + 8 * fq;
#pragma unroll
        for (int bj = 0; bj < 2; ++bj) { v4u w; w.x = cvt_pk_bf16(v[bj][0][0], v[bj][0][1]); w.y = cvt_pk_bf16(v[bj][0][2], v[bj][0][3]); w.z = cvt_pk_bf16(v[bj][1][0], v[bj][1][1]); w.w = cvt_pk_bf16(v[bj][1][2], v[bj][1][3]);
            *(v4u*)(op + bj * 128) = w; }
    }
    __device__ __forceinline__ void operator()(EPI_ACC, const Unit& u, int wr, int wc, int fr, int fq) const {
        const int row0 = u.pm * 256 + wr * 64 + fr, colb = u.pn * 256 + wc * 32 + 8 * fq;
#pragma unroll
        for (int ai = 0; ai < 2; ++ai)
#pragma unroll
            for (int m = 0; m < 4; ++m) { const int row = row0 + ai * 128 + m * 16; const unsigned char* gp = gate + (size_t)row * PGW + 2 * DM + colb; A4 v[2][2];
#pragma unroll
                for (int bj = 0; bj < 2; ++bj) { float g[8]; unpack8(*(const v2u*)(gp + bj * 128), g);
#pragma unroll
                    for (int e = 0; e < 4; ++e) { v[bj][0][e] = acc[ai][bj][m][0][e] * (g[e] * (1.0f / 255.0f)); v[bj][1][e] = acc[ai][bj][m][1][e] * (g[4 + e] * (1.0f / 255.0f)); } }
                row_op(v, row, u.pn, wc, fq); }
    }
};
#undef EPI_ACC
}

#define XB_TMO      128
#define XB_XCNT(j)  (256  + 64 * (j))
#define XB_XSUB(j)  (1280 + 64 * (j))
#define XB_XGEN(j)  (2304 + 64 * (j))
#define XB_TOP      3328
#define XB_TOPGEN   3392
#define XCD_BAR_WORDS 3456
#define XB_SPIN_CAP (1u << 18)

__device__ __forceinline__ unsigned xb_ld(unsigned* p)              { return __hip_atomic_load(p, __ATOMIC_RELAXED, __HIP_MEMORY_SCOPE_AGENT); }
__device__ __forceinline__ unsigned xb_add(unsigned* p, unsigned v) { return __hip_atomic_fetch_add(p, v, __ATOMIC_RELAXED, __HIP_MEMORY_SCOPE_AGENT); }
__device__ __forceinline__ unsigned xb_xcc_id() { return (unsigned)__builtin_amdgcn_s_getreg((3 << 11) | 20) & 0xFu; }
#define XB_SPIN(cond, bar) do { unsigned _sp = 0; while (cond) { __builtin_amdgcn_s_sleep(1); \
    if ((++_sp & 255u) == 0u) { if (xb_ld(&(bar)[XB_TMO])) break; if (_sp > XB_SPIN_CAP) { atomicAdd(&(bar)[XB_TMO], 1u); break; } } } } while (0)

struct XcdBarrier {
    unsigned* bar; unsigned x;
    volatile LAS unsigned* st;
};

__device__ __forceinline__ XcdBarrier xcd_barrier_post(unsigned* bar, volatile LAS unsigned* st) {
    XcdBarrier b; b.bar = bar; b.x = xb_xcc_id(); b.st = st;
    if (threadIdx.x == 0) (void)xb_add(&bar[XB_XCNT(b.x)], 1u);
    return b;
}
__device__ __forceinline__ void xcd_barrier_complete(unsigned* bar, unsigned x, unsigned& nloc, unsigned& nx) {
    const unsigned G = gridDim.x * gridDim.y * gridDim.z;
    unsigned sum, cnt, mine, sp = 0u;
    for (;;) {
        sum = 0u; cnt = 0u; mine = 0u;
#pragma unroll
        for (unsigned j = 0; j < 16; ++j) { const unsigned c = xb_ld(&bar[XB_XCNT(j)]); sum += c; cnt += (c > 0u) ? 1u : 0u; mine = (j == x) ? c : mine; }
        if (sum == G) break;
        __builtin_amdgcn_s_sleep(1);
        if ((++sp & 255u) == 0u) { if (xb_ld(&bar[XB_TMO])) break; if (sp > XB_SPIN_CAP) { atomicAdd(&bar[XB_TMO], 1u); break; } }
    }
    nloc = mine > 0u ? mine : 1u; nx = cnt > 0u ? cnt : 1u;
}

__device__ __forceinline__ void xcd_barrier(const XcdBarrier& b) {
    asm volatile("s_waitcnt vmcnt(0)" ::: "memory");
    __syncthreads();
    if (threadIdx.x == 0) {
        unsigned* bar = b.bar;
        __builtin_amdgcn_s_waitcnt(0);
        unsigned nloc = b.st[0], nx = b.st[1];
        if (nloc == 0u) { xcd_barrier_complete(bar, b.x, nloc, nx); b.st[0] = nloc; b.st[1] = nx; }
        const unsigned old = xb_add(&bar[XB_XSUB(b.x)], 1u);
        const unsigned gen = old / nloc;
        if (old + 1u == (gen + 1u) * nloc) {
            __builtin_amdgcn_fence(__ATOMIC_RELEASE, "agent");
            asm volatile("s_waitcnt vmcnt(0)" ::: "memory");
            const unsigned og = xb_add(&bar[XB_TOP], 1u);
            const unsigned tg = og / nx;
            if (og + 1u == (tg + 1u) * nx) xb_add(&bar[XB_TOPGEN], 1u);
            else XB_SPIN(xb_ld(&bar[XB_TOPGEN]) == tg, bar);
            __builtin_amdgcn_fence(__ATOMIC_ACQUIRE, "agent");
            xb_add(&bar[XB_XGEN(b.x)], 1u);
            asm volatile("s_waitcnt vmcnt(0)" ::: "memory");
        } else {
            XB_SPIN(xb_ld(&bar[XB_XGEN(b.x)]) == gen, bar);
            __builtin_amdgcn_fence(__ATOMIC_ACQUIRE, "agent");
            asm volatile("s_waitcnt vmcnt(0)" ::: "memory");
        }
    }
    __syncthreads();
}

struct Args {
    const float* in[35];
    float* out; unsigned char* ws;
    int ph_lo, ph_hi, li, pad;
};
enum In { I_XP = 0, I_XS, I_MEM, I_CK, I_CV, I_SRW, I_SSH, I_SCV, I_GF1, I_WF1I, I_WF1O, I_GMIX, I_WIN, I_MU, I_W0, I_WLU, I_A0, I_ALU, I_GLU, I_KK, I_KA, I_RK, I_LNW, I_LNB, I_CW, I_GMEM, I_WMKV,
          I_WBA, I_WBB, I_WBC, I_WOUT, I_GF2, I_WF2I, I_WF2O, I_GFIN };

struct Ctx { LAS unsigned char* lds; int tid, lane, wave, G, vcu, gw, NGW; };

__device__ __forceinline__ float wave_sum(float v) {
#pragma unroll
    for (int o = 1; o < 64; o <<= 1) v += __shfl_xor(v, o);
    return v;
}
__device__ __forceinline__ float oct_sum(float v) { v += __shfl_xor(v, 1); v += __shfl_xor(v, 2); v += __shfl_xor(v, 4); return v; }

__device__ __forceinline__ void cvt_item(const float* W, int N, const float* gk, bf16* WT, int Kd, int k0, int n0, int drow0, LAS float* scr, int lane) {
    f32x4 v[16];
    const int r4 = lane >> 4, c4 = 4 * (lane & 15);
#pragma unroll
    for (int i = 0; i < 16; ++i) v[i] = *(const f32x4*)(W + (size_t)(k0 + 4 * i + r4) * N + n0 + c4);
    if (gk) {
#pragma unroll
        for (int i = 0; i < 16; ++i) { const float s = gk[k0 + 4 * i + r4]; v[i] = v[i] * s; } }
#pragma unroll
    for (int i = 0; i < 16; ++i) { LAS float* p = scr + (4 * i + r4) * 65 + c4; p[0] = v[i].x; p[1] = v[i].y; p[2] = v[i].z; p[3] = v[i].w; }
    LDS_WAIT(); asm volatile("" ::: "memory");
    const int c = lane & 7;
#pragma unroll
    for (int j = 0; j < 8; ++j) { const int n = (lane >> 3) + 8 * j; const LAS float* s = scr + (8 * c) * 65 + n;
        v4u o; o.x = cvt_pk_bf16(s[0 * 65], s[1 * 65]); o.y = cvt_pk_bf16(s[2 * 65], s[3 * 65]); o.z = cvt_pk_bf16(s[4 * 65], s[5 * 65]); o.w = cvt_pk_bf16(s[6 * 65], s[7 * 65]);
        *(v4u*)(WT + (size_t)(drow0 + n) * Kd + k0 + 8 * c) = o; }
    LDS_WAIT(); asm volatile("" ::: "memory");
}
template <int MAP> __device__ __forceinline__ void cvt_matrix(const Ctx& C, const float* W, int K, int N, const float* gk, bf16* WT, int& base, int Kd = 0) {
    if (Kd == 0) Kd = K;
    const int nblk = N / 64, nitems = (K / 64) * nblk; LAS float* scr = (LAS float*)(C.lds + C.wave * 16640);
    int first = (C.gw - base % C.NGW + C.NGW) % C.NGW;
    for (int it = first; it < nitems; it += C.NGW) {
        const int kb = it / nblk, nb = it % nblk, n0 = 64 * nb; int d;
        if (MAP == 1) { const int j = n0 < DFF ? n0 : n0 - DFF; d = 256 * (j >> 7) + (j & 127) + (n0 < DFF ? 0 : 128); }
        else if (MAP == 2) d = n0 + (n0 >= PA ? 64 : 0);
        else d = n0;
        cvt_item(W, N, gk, WT, Kd, 64 * kb, n0, d, scr, C.lane);
    }
    base += nitems;
}
__device__ __forceinline__ void row_to_bf16(const float* xrow, bf16* orow, float* rstd_out, int lane) {
    const f32x4* xr = (const f32x4*)xrow + lane; f32x4 v[16]; float s = 0.f;
#pragma unroll
    for (int j = 0; j < 16; ++j) { v[j] = xr[64 * j]; s += (v[j].x * v[j].x + v[j].y * v[j].y) + (v[j].z * v[j].z + v[j].w * v[j].w); }
    s = wave_sum(s);
    v2u* o8 = (v2u*)orow + lane;
#pragma unroll
    for (int j = 0; j < 16; ++j) { v2u w; w.x = cvt_pk_bf16(v[j].x, v[j].y); w.y = cvt_pk_bf16(v[j].z, v[j].w); o8[64 * j] = w; }
    if (lane == 0) *rstd_out = 1.0f / sqrtf(s * (1.0f / DM) + EPS);
}
__device__ __forceinline__ void p0_prologue(const Ctx& C, const Args& a) {
    unsigned char* ws = a.ws; int base = 0;
    cvt_matrix<1>(C, a.in[I_WF1I], DM, 2 * DFF, a.in[I_GF1], (bf16*)(ws + WS_W1A), base);
    cvt_matrix<0>(C, a.in[I_WMKV], DM, 2048, a.in[I_GMEM], (bf16*)(ws + WS_WMEM), base);
    { bf16* wl = (bf16*)(ws + WS_WLWA); bf16* wg = (bf16*)(ws + WS_WLG); const float* wu = a.in[I_WLU]; const float* au = a.in[I_ALU]; const float* gu = a.in[I_GLU];
      for (int i = C.gw * 64 + C.lane; i < 6144 * 32; i += C.NGW * 64) { const int n = i % 6144, k0 = 8 * (i / 6144); float f[8];
#pragma unroll
          for (int e = 0; e < 8; ++e) { const int k = k0 + e; float x = 0.f;
              if (n < 2048) { if (k < 96) x = wu[(size_t)k * 2048 + n]; }
              else if (n < 4096) { if (k >= 128 && k < 224) x = au[(size_t)(k - 128) * 2048 + (n - 2048)]; }
              else x = gu[(size_t)k * 2048 + (n - 4096)];
              f[e] = x; }
          v4u o; o.x = pk2(f[0], f[1]); o.y = pk2(f[2], f[3]); o.z = pk2(f[4], f[5]); o.w = pk2(f[6], f[7]);
          bf16* dst = n < 4096 ? wl + (size_t)n * 256 + k0 : wg + (size_t)(n - 4096) * 256 + k0;
          *(v4u*)dst = o; } }
    for (int m = C.gw; m < MTOK + 1024; m += C.NGW) {
        if (m < MTOK) { const float* xr = m < NTP ? a.in[I_XP] + (size_t)m * DM : a.in[I_XS] + (size_t)(m - NTP) * DM;
            row_to_bf16(xr, (bf16*)(ws + WS_XB) + (size_t)m * DM, (float*)(ws + WS_RSTD0) + m, C.lane); }
        else { const int r = m - MTOK; row_to_bf16(a.in[I_MEM] + (size_t)r * DM, (bf16*)(ws + WS_MEMB) + (size_t)r * DM, (float*)(ws + WS_RSTDM) + r, C.lane); }
    }
}
__device__ __forceinline__ void late_weights(const Ctx& C2, const Args& a) {
    unsigned char* ws = a.ws; int base = 0;
    cvt_matrix<0>(C2, a.in[I_WBA], 2048, DM, nullptr, (bf16*)(ws + WS_WBRA), base, DM);
    cvt_matrix<0>(C2, a.in[I_WBB], 1024, DM, nullptr, (bf16*)(ws + WS_WBRA) + 2048, base, DM);
    cvt_matrix<0>(C2, a.in[I_WBC], 1024, DM, nullptr, (bf16*)(ws + WS_WBRA) + 3072, base, DM);
    cvt_matrix<0>(C2, a.in[I_WOUT], DM, DM, nullptr, (bf16*)(ws + WS_WOUT), base);
    cvt_matrix<1>(C2, a.in[I_WF2I], DM, 2 * DFF, a.in[I_GF2], (bf16*)(ws + WS_W2A), base);
}
__device__ __forceinline__ void win_weights(const Ctx& C, const Args& a) {
    unsigned char* ws = a.ws; int base = 0;
    cvt_matrix<2>(C, a.in[I_WIN], DM, PIN, a.in[I_GMIX], (bf16*)(ws + WS_WIN), base);
    { v4u z = {0u, 0u, 0u, 0u}; v4u* p = (v4u*)((bf16*)(ws + WS_WIN) + (size_t)PA * DM);
      for (int i = C.gw * 64 + C.lane; i < 64 * DM / 8; i += C.NGW * 64) p[i] = z; }
}
__device__ __forceinline__ void rstd_phase(const Ctx& C, const float* slots, float* rstd);
__device__ __forceinline__ void final_norm(const Ctx& C, const Args& a, int m0, int m1) {
    const float* slots = (const float*)(a.ws + WS_SLOT); const f32x4* gf = (const f32x4*)a.in[I_GFIN]; const bf16* xb = (const bf16*)(a.ws + WS_XB);
    for (int m = m0 + C.gw; m < m1; m += C.NGW) {
        const v4u* xr = (const v4u*)(xb + (size_t)m * DM) + C.lane; f32x4* yr = (f32x4*)(a.out + O_Y + (size_t)m * DM);
        const float sl = slots[(size_t)m * 64 + C.lane]; v4u w[8];
#pragma unroll
        for (int j = 0; j < 8; ++j) w[j] = xr[64 * j];
        const float s = wave_sum(sl); const float rs = 1.0f / sqrtf(s * (1.0f / DM) + EPS);
#pragma unroll
        for (int j = 0; j < 8; ++j) { const int c4 = (64 * j + C.lane) * 2;
            const f32x4 g0 = gf[c4], g1 = gf[c4 + 1];
            yr[c4] = (f32x4){bf_lo(w[j].x), bf_hi(w[j].x), bf_lo(w[j].y), bf_hi(w[j].y)} * rs * g0; yr[c4 + 1] = (f32x4){bf_lo(w[j].z), bf_hi(w[j].z), bf_lo(w[j].w), bf_hi(w[j].w)} * rs * g1; }
    }
}

__device__ __forceinline__ void ld8(const float* p, float (&f)[8]) { const f32x4 x = *(const f32x4*)p, y = *(const f32x4*)(p + 4); f[0] = x.x; f[1] = x.y; f[2] = x.z; f[3] = x.w; f[4] = y.x; f[5] = y.y; f[6] = y.z; f[7] = y.w; }
__device__ __forceinline__ void ld8b(const bf16* p, float (&f)[8]) { const v4u w = *(const v4u*)p; f[0] = bf_lo(w.x); f[1] = bf_hi(w.x); f[2] = bf_lo(w.y); f[3] = bf_hi(w.y); f[4] = bf_lo(w.z); f[5] = bf_hi(w.z); f[6] = bf_lo(w.w); f[7] = bf_hi(w.w); }
__device__ __forceinline__ void r1_phase(const Ctx& C, const Args& a) {
    const bf16* __restrict__ pa = (const bf16*)(a.ws + WS_PAF); bf16* __restrict__ lin = (bf16*)(a.ws + WS_LIN); const float* mu = a.in[I_MU];
    const int o = 8 * C.lane; int src = -1, mode = 0;
    if (o < 96) { src = 6144 + o; mode = 0; } else if (o < 128) src = -1; else if (o < 224) { src = 6240 + (o - 128); mode = 1; } else if (o < 256) src = -1; else { src = 6336 + (o - 256); mode = 2; }
    float u[8];
#pragma unroll
    for (int e = 0; e < 8; ++e) u[e] = 0.f;
    if (src >= 0) ld8(mu + src, u);
#pragma unroll 2
    for (int m = C.gw; m < MTOK; m += C.NGW) {
        const int t = m < NTP ? (m & (SEQ - 1)) : ((m - NTP) & (DSEQ - 1)); const bf16* cur = pa + (size_t)m * PA_PAD;
        float f[8];
#pragma unroll
        for (int e = 0; e < 8; ++e) f[e] = 0.f;
        if (src >= 0) { float c[8], p[8]; ld8b(cur + src, c);
            if (t) ld8b(cur - PA_PAD + src, p); else if (m >= NTP) ld8(a.in[I_SSH] + (size_t)((m - NTP) >> 2) * PA + src, p); else {
#pragma unroll
                for (int e = 0; e < 8; ++e) p[e] = 0.f; }
#pragma unroll
            for (int e = 0; e < 8; ++e) { const float x = c[e] + (p[e] - c[e]) * u[e]; f[e] = mode == 0 ? (1.0f - 2.0f * __builtin_amdgcn_rcpf(1.0f + fast_exp(2.0f * x))) : (mode == 2 ? fast_sigmoid(x) : x); } }
        v4u w; w.x = pk2(f[0], f[1]); w.y = pk2(f[2], f[3]); w.z = pk2(f[4], f[5]); w.w = pk2(f[6], f[7]);
        *(v4u*)(lin + (size_t)m * 512 + o) = w;
    }
}
__device__ __forceinline__ void ldu16(const bf16* row, int c0, float (&u)[16]) {
    const v4u g0 = *(const v4u*)(row + 1024 + c0), g1 = *(const v4u*)(row + 1024 + c0 + 8), u0 = *(const v4u*)(row + 2048 + c0), u1 = *(const v4u*)(row + 2048 + c0 + 8);
    const unsigned gw[8] = {g0.x, g0.y, g0.z, g0.w, g1.x, g1.y, g1.z, g1.w}, uw[8] = {u0.x, u0.y, u0.z, u0.w, u1.x, u1.y, u1.z, u1.w};
#pragma unroll
    for (int i = 0; i < 8; ++i) { u[2 * i] = bf_lo(gw[i]) * bf_lo(uw[i]); u[2 * i + 1] = bf_hi(gw[i]) * bf_hi(uw[i]); }
}
__device__ __forceinline__ void ldf16(const float* p, float (&u)[16]) {
#pragma unroll
    for (int i = 0; i < 4; ++i) { const f32x4 x = *(const f32x4*)(p + 4 * i); u[4 * i] = x.x; u[4 * i + 1] = x.y; u[4 * i + 2] = x.z; u[4 * i + 3] = x.w; }
}
__device__ __forceinline__ void conv_phase(const Args& a, int w, int nw, int lane) {
    const bf16* pb = (const bf16*)(a.ws + WS_PB); bf16* yb = (bf16*)(a.ws + WS_YA) + 2048; const float* cw = a.in[I_CW]; const int c0 = 16 * lane;
    float w0[16], w1[16], w2[16]; ldf16(cw + c0, w0); ldf16(cw + 1024 + c0, w1); ldf16(cw + 2048 + c0, w2);
    for (int m = w; m < MTOK; m += nw) {
        const bool smp = m >= NTP; const int t = smp ? ((m - NTP) & 3) : (m & (SEQ - 1)); const int T = smp ? DSEQ : SEQ;
        const float* buf = smp ? a.in[I_SCV] + (size_t)((m - NTP) >> 2) * 2048 : nullptr;
        const bf16* row = pb + (size_t)m * PBW;
        float u0[16], u1[16], u2[16];
        ldu16(row, c0, u0);
        if (t >= 1) ldu16(row - PBW, c0, u1); else if (smp) ldf16(buf + 1024 + c0, u1); else {
#pragma unroll
            for (int i = 0; i < 16; ++i) u1[i] = 0.f; }
        if (t >= 2) ldu16(row - 2 * PBW, c0, u2); else if (smp) ldf16(buf + (size_t)t * 1024 + c0, u2); else {
#pragma unroll
            for (int i = 0; i < 16; ++i) u2[i] = 0.f; }
        const v4u b0 = *(const v4u*)(row + c0), b1 = *(const v4u*)(row + c0 + 8); const unsigned bw[8] = {b0.x, b0.y, b0.z, b0.w, b1.x, b1.y, b1.z, b1.w};
        unsigned ow[8];
#pragma unroll
        for (int i = 0; i < 8; ++i) { const float z0 = u2[2 * i] * w0[2 * i] + u1[2 * i] * w1[2 * i] + u0[2 * i] * w2[2 * i], z1 = u2[2 * i + 1] * w0[2 * i + 1] + u1[2 * i + 1] * w1[2 * i + 1] + u0[2 * i + 1] * w2[2 * i + 1];
            ow[i] = pk2(bf_lo(bw[i]) * z0, bf_hi(bw[i]) * z1); }
        v4u o0 = {ow[0], ow[1], ow[2], ow[3]}, o1 = {ow[4], ow[5], ow[6], ow[7]};
        *(v4u*)(yb + (size_t)m * DM + c0) = o0; *(v4u*)(yb + (size_t)m * DM + c0 + 8) = o1;
        if (t >= T - 2) { float* dst = (smp ? a.out + O_CVS + (size_t)((m - NTP) >> 2) * 2048 : a.out + O_CVP + (size_t)(m >> 11) * 2048) + (size_t)(t - (T - 2)) * 1024 + c0;
#pragma unroll
            for (int i = 0; i < 4; ++i) *(f32x4*)(dst + 4 * i) = (f32x4){u0[4 * i], u0[4 * i + 1], u0[4 * i + 2], u0[4 * i + 3]}; }
    }
}

template <int CTRL> __device__ __forceinline__ float dpp_mov(float v) { return __builtin_bit_cast(float, __builtin_amdgcn_update_dpp(0, __builtin_bit_cast(int, v), CTRL, 0xf, 0xf, false)); }
__device__ __forceinline__ float oct_sum_dpp(float v) { v += dpp_mov<0xB1>(v); v += dpp_mov<0x4E>(v); v += dpp_mov<0x141>(v); return v; }
constexpr int TC = 16, STG = 6 * TC * 64;
template <int CTRL> __device__ __forceinline__ float dpp_add(float v) { return v + dpp_mov<CTRL>(v); }
__device__ __forceinline__ float row16_sum(float v) { v = dpp_add<0xB1>(v); v = dpp_add<0x4E>(v); v = dpp_add<0x141>(v); v = dpp_add<0x140>(v); return v; }
struct StageRegs { f32x4 cr, ck, cv, pr, pk, pv, la, lw; v2u g; };
struct StagePar { f32x4 mur, muk, muv, kkp, kap, rkp; };
__device__ __forceinline__ f32x4 ld4b(const bf16* p) { const v2u w = *(const v2u*)p; return (f32x4){bf_lo(w.x), bf_hi(w.x), bf_lo(w.y), bf_hi(w.y)}; }
__device__ __forceinline__ void stage_load(StageRegs& R, const Args& a, const float* shift_prev, int tok0, int tl, int T, int cj) {
    const f32x4 z = {0.f, 0.f, 0.f, 0.f};
    if (tl < T) {
        const int tok = tok0 + tl; const bf16* P = (const bf16*)(a.ws + WS_PAF) + (size_t)tok * PA_PAD + cj;
        R.cr = ld4b(P); R.ck = ld4b(P + 2048); R.cv = ld4b(P + 4096);
        if (tl > 0) { const bf16* Q = P - PA_PAD; R.pr = ld4b(Q); R.pk = ld4b(Q + 2048); R.pv = ld4b(Q + 4096); }
        else if (shift_prev) { const float* Q = shift_prev + cj; R.pr = *(const f32x4*)Q; R.pk = *(const f32x4*)(Q + 2048); R.pv = *(const f32x4*)(Q + 4096); }
        else { R.pr = z; R.pk = z; R.pv = z; }
        R.la = ld4b((const bf16*)(a.ws + WS_AVAL) + (size_t)tok * 2048 + cj); { const f32x4 lw = ld4b((const bf16*)(a.ws + WS_WDEC) + (size_t)tok * 2048 + cj);
            R.lw = (f32x4){__builtin_amdgcn_exp2f(-lw.x), __builtin_amdgcn_exp2f(-lw.y), __builtin_amdgcn_exp2f(-lw.z), __builtin_amdgcn_exp2f(-lw.w)}; }
        R.g = *(const v2u*)((const bf16*)(a.ws + WS_G) + (size_t)tok * 2048 + cj);
    } else { R.cr = z; R.ck = z; R.cv = z; R.pr = z; R.pk = z; R.pv = z; R.la = z; R.lw = z; R.g = (v2u){0u, 0u}; }
}
__device__ __forceinline__ float sum4(const f32x4 v) { return (v.x + v.y) + (v.z + v.w); }
__device__ __forceinline__ float stage_store(const StageRegs& R, LAS float* B, LAS float* BRK, int st, int cq, const StagePar& P) {
    const f32x4 rs = R.cr + (R.pr - R.cr) * P.mur, ks = R.ck + (R.pk - R.ck) * P.muk, vs = R.cv + (R.pv - R.cv) * P.muv;
    const f32x4 kr_ = ks * P.kkp, kp = ks * (1.0f + (R.la - 1.0f) * P.kap);
    const float ss = row16_sum(sum4(kr_ * kr_));
    const float inv = 1.0f / fmaxf(sqrtf(ss), 1e-12f);
    const f32x4 kk = kr_ * inv, bv = kk * R.la;
    const float br = row16_sum(sum4(bv * rs)), kr = row16_sum(sum4(kp * rs)), rk = row16_sum(sum4(rs * kp * P.rkp));
    LAS float* p = B + st * 64 + 4 * cq;
    *(LAS f32x4*)(p) = -kk; *(LAS f32x4*)(p + TC * 64) = R.lw; *(LAS f32x4*)(p + 2 * TC * 64) = bv; *(LAS f32x4*)(p + 3 * TC * 64) = kp; *(LAS f32x4*)(p + 4 * TC * 64) = R.lw * rs; *(LAS f32x4*)(p + 5 * TC * 64) = vs;
    if (cq == 0) *(LAS f32x2*)(BRK + st * 2) = (f32x2){br * 0.125f, kr * 0.125f};
    return rk;
}
struct Carry { float rk; v2u g; };
constexpr int YRP = 20, YSTEP = 32 * YRP;
__device__ __forceinline__ void post_store(const LAS float* yrow, int cq, const LAS float* vv, const Carry& cy, const f32x4 lnw, const f32x4 lnb, bf16* dst) {
    f32x4 y; const f32x4 v = *(const LAS f32x4*)vv;
    { const LAS float* p0 = yrow + (2 * cq) * YRP; const LAS float* p1 = p0 + YRP;
      const f32x4 q0 = *(const LAS f32x4*)p0, q1 = *(const LAS f32x4*)(p0 + 4), q2 = *(const LAS f32x4*)(p0 + 8), q3 = *(const LAS f32x4*)(p0 + 12);
      const f32x4 u0 = *(const LAS f32x4*)p1, u1 = *(const LAS f32x4*)(p1 + 4), u2 = *(const LAS f32x4*)(p1 + 8), u3 = *(const LAS f32x4*)(p1 + 12);
      const f32x4 qs = (q0 + q1) + (q2 + q3), us = (u0 + u1) + (u2 + u3);
      y = (f32x4){qs.x + qs.z, qs.y + qs.w, us.x + us.z, us.y + us.w}; }
    const float mean = row16_sum(sum4(y)) * (1.0f / 64.0f); y = y - mean;
    const float rs = 1.0f / sqrtf(row16_sum(sum4(y * y)) * (1.0f / 64.0f) + GN_EPS);
    const f32x4 g = {bf_lo(cy.g.x), bf_hi(cy.g.x), bf_lo(cy.g.y), bf_hi(cy.g.y)};
    const f32x4 o = (y * rs * lnw + lnb + v * cy.rk) * g;
    v2u w; w.x = cvt_pk_bf16(o.x, o.y); w.y = cvt_pk_bf16(o.z, o.w);
    *(v2u*)dst = w;
}
__device__ __forceinline__ void row8_sum4(float& a0, float& a1, float& a2, float& a3) {
#define R8_OP(n, ctl) "v_add_f32_dpp %" #n ", %" #n ", %" #n " " ctl " row_mask:0xf bank_mask:0xf bound_ctrl:1\n\t"
#define R8_STAGE(ctl) R8_OP(0, ctl) R8_OP(1, ctl) R8_OP(2, ctl) R8_OP(3, ctl)
    asm volatile("s_nop 1\n\t" R8_STAGE("quad_perm:[1,0,3,2]") R8_STAGE("quad_perm:[2,3,0,1]") R8_STAGE("row_half_mirror") "s_nop 1"
        : "+v"(a0), "+v"(a1), "+v"(a2), "+v"(a3));
#undef R8_STAGE
#undef R8_OP
}
__device__ __forceinline__ void row8_sum2(float& a0, float& a1) {
#define R8_OP(n, ctl) "v_add_f32_dpp %" #n ", %" #n ", %" #n " " ctl " row_mask:0xf bank_mask:0xf bound_ctrl:1\n\t"
    asm volatile("s_nop 1\n\t" R8_OP(0, "quad_perm:[1,0,3,2]") R8_OP(1, "quad_perm:[1,0,3,2]") "s_nop 0\n\t" R8_OP(0, "quad_perm:[2,3,0,1]") R8_OP(1, "quad_perm:[2,3,0,1]") "s_nop 0\n\t"
                 R8_OP(0, "row_half_mirror") R8_OP(1, "row_half_mirror") "s_nop 1"
        : "+v"(a0), "+v"(a1));
#undef R8_OP
}
struct StepOps { f32x4 a[2], w[2], b[2], k[2], r[2]; f32x2 v, brk; };
__device__ __forceinline__ void step_load(StepOps& o, const LAS float* bt, const LAS float* vt, const LAS float* brk) {
#pragma unroll
    for (int j = 0; j < 2; ++j) { o.a[j] = *(const LAS f32x4*)(bt + 4 * j); o.w[j] = *(const LAS f32x4*)(bt + TC * 64 + 4 * j); o.b[j] = *(const LAS f32x4*)(bt + 2 * TC * 64 + 4 * j); o.k[j] = *(const LAS f32x4*)(bt + 3 * TC * 64 + 4 * j); o.r[j] = *(const LAS f32x4*)(bt + 4 * TC * 64 + 4 * j); }
    o.v = *(const LAS f32x2*)vt; o.brk = *(const LAS f32x2*)brk;
}
__device__ __forceinline__ f32x2 lo2(const f32x4 v) { return (f32x2){v.x, v.y}; }
__device__ __forceinline__ f32x2 hi2(const f32x4 v) { return (f32x2){v.z, v.w}; }
#define PKB0 "op_sel:[0,0,0] op_sel_hi:[1,0,1]"
#define PKB1 "op_sel:[0,1,0] op_sel_hi:[1,1,1]"
__device__ __forceinline__ void blk_partials(const f32x2 (&S)[8], const f32x2 (&a2)[4], const f32x2 (&r2)[4], f32x2& s, f32x2& y) {
    f32x2 s1, y1;
    asm("v_pk_mul_f32 %0, %4, %12 op_sel:[0,0] op_sel_hi:[1,0]\n\tv_pk_mul_f32 %1, %8, %14 op_sel:[0,0] op_sel_hi:[1,0]\n\t"
        "v_pk_mul_f32 %2, %4, %16 op_sel:[0,0] op_sel_hi:[1,0]\n\tv_pk_mul_f32 %3, %8, %18 op_sel:[0,0] op_sel_hi:[1,0]\n\t"
        "v_pk_fma_f32 %0, %5, %12, %0 " PKB1 "\n\tv_pk_fma_f32 %1, %9, %14, %1 " PKB1 "\n\tv_pk_fma_f32 %2, %5, %16, %2 " PKB1 "\n\tv_pk_fma_f32 %3, %9, %18, %3 " PKB1 "\n\t"
        "v_pk_fma_f32 %0, %6, %13, %0 " PKB0 "\n\tv_pk_fma_f32 %1, %10, %15, %1 " PKB0 "\n\tv_pk_fma_f32 %2, %6, %17, %2 " PKB0 "\n\tv_pk_fma_f32 %3, %10, %19, %3 " PKB0 "\n\t"
        "v_pk_fma_f32 %0, %7, %13, %0 " PKB1 "\n\tv_pk_fma_f32 %1, %11, %15, %1 " PKB1 "\n\tv_pk_fma_f32 %2, %7, %17, %2 " PKB1 "\n\tv_pk_fma_f32 %3, %11, %19, %3 " PKB1 "\n\t"
        "v_pk_add_f32 %0, %0, %1\n\tv_pk_add_f32 %2, %2, %3"
        : "=&v"(s), "=&v"(s1), "=&v"(y), "=&v"(y1)
        : "v"(S[0]), "v"(S[1]), "v"(S[2]), "v"(S[3]), "v"(S[4]), "v"(S[5]), "v"(S[6]), "v"(S[7]), "v"(a2[0]), "v"(a2[1]), "v"(a2[2]), "v"(a2[3]), "v"(r2[0]), "v"(r2[1]), "v"(r2[2]), "v"(r2[3]));
}
__device__ __forceinline__ void blk_update(f32x2& Se, f32x2& So, const f32x2 sa, const f32x2 v, const f32x2 w2, const f32x2 b2, const f32x2 k2) {
    f32x2 t0, t1;
    asm("v_pk_mul_f32 %2, %5, %8 op_sel:[0,0] op_sel_hi:[1,0]\n\tv_pk_mul_f32 %3, %5, %8 op_sel:[0,1] op_sel_hi:[1,1]\n\t"
        "v_pk_fma_f32 %2, %4, %7, %2 " PKB0 "\n\tv_pk_fma_f32 %3, %4, %7, %3 " PKB1 "\n\t"
        "v_pk_fma_f32 %0, %0, %6, %2 " PKB0 "\n\tv_pk_fma_f32 %1, %1, %6, %3 " PKB1
        : "+v"(Se), "+v"(So), "=&v"(t0), "=&v"(t1) : "v"(sa), "v"(v), "v"(w2), "v"(b2), "v"(k2));
}
__device__ __forceinline__ void blk_yfin(f32x2& y, const f32x2 sa, const f32x2 v, const f32x2 brk) {
    asm("v_pk_fma_f32 %0, %1, %3, %0 " PKB0 "\n\tv_pk_fma_f32 %0, %2, %3, %0 " PKB1 : "+v"(y) : "v"(sa), "v"(v), "v"(brk));
}
#undef PKB0
#undef PKB1
__device__ __forceinline__ void step_math(const StepOps& o, f32x2 (&S)[8], LAS float* yp) {
    const f32x2 a2[4] = {lo2(o.a[0]), hi2(o.a[0]), lo2(o.a[1]), hi2(o.a[1])}, r2[4] = {lo2(o.r[0]), hi2(o.r[0]), lo2(o.r[1]), hi2(o.r[1])};
    const f32x2 w2[4] = {lo2(o.w[0]), hi2(o.w[0]), lo2(o.w[1]), hi2(o.w[1])}, b2[4] = {lo2(o.b[0]), hi2(o.b[0]), lo2(o.b[1]), hi2(o.b[1])}, k2[4] = {lo2(o.k[0]), hi2(o.k[0]), lo2(o.k[1]), hi2(o.k[1])};
    f32x2 s, y; blk_partials(S, a2, r2, s, y);
    float r0 = s.x, r1 = s.y;
    row8_sum2(r0, r1);
    const f32x2 sa = {r0, r1}; f32x2 yo = y;
#pragma unroll
    for (int p = 0; p < 4; ++p) blk_update(S[2 * p], S[2 * p + 1], sa, o.v, w2[p], b2[p], k2[p]);
    blk_yfin(yo, sa, o.v, o.brk);
    *(LAS f32x2*)yp = yo;
}
__device__ __forceinline__ void scan_unit(const Ctx& C, const Args& a, int tok0, int T, const float* shift_prev, const float* s_in, float* s_out, int h) {
    LAS float* L = (LAS float*)C.lds; LAS float* Y = L + 2 * STG; LAS float* BRK = Y + 2 * TC * YSTEP;
    const int NC = (T + TC - 1) / TC; const bool comp = C.wave < 4;
    const int t2 = C.tid - 256, st = t2 >> 4, cq = t2 & 15, cj = h * 64 + 4 * cq;
    bf16* yout = (bf16*)(a.ws + WS_YA) + (size_t)tok0 * DM + cj;
    StagePar P; StageRegs R; Carry cA, cB; f32x4 lnw, lnb; cA.rk = 0.f; cA.g = (v2u){0u, 0u}; cB = cA;
    const int row = 16 * C.wave + 2 * (C.lane >> 3), cg = C.lane & 7; const bool wr = (cg == 0);
    f32x2 S[8];
    if (comp) {
        if (s_in) {
#pragma unroll
            for (int j = 0; j < 2; ++j) { const f32x4 x0 = *(const f32x4*)(s_in + row * 64 + 8 * cg + 4 * j), x1 = *(const f32x4*)(s_in + (row + 1) * 64 + 8 * cg + 4 * j);
#pragma unroll
                for (int e = 0; e < 4; ++e) S[4 * j + e] = (f32x2){x0[e], x1[e]}; } }
        else {
#pragma unroll
            for (int e = 0; e < 8; ++e) S[e] = (f32x2){0.f, 0.f}; }
    } else {
        const float* mu = a.in[I_MU];
        P.mur = *(const f32x4*)(mu + cj); P.muk = *(const f32x4*)(mu + 2048 + cj); P.muv = *(const f32x4*)(mu + 4096 + cj); P.kkp = *(const f32x4*)(a.in[I_KK] + cj); P.kap = *(const f32x4*)(a.in[I_KA] + cj); P.rkp = *(const f32x4*)(a.in[I_RK] + cj);
        lnw = *(const f32x4*)(a.in[I_LNW] + cj); lnb = *(const f32x4*)(a.in[I_LNB] + cj);
        stage_load(R, a, shift_prev, tok0, st, T, cj); cB.g = R.g; cB.rk = stage_store(R, L, BRK, st, cq, P);
        if (NC > 1) stage_load(R, a, shift_prev, tok0, TC + st, T, cj);
    }
    __syncthreads();
#pragma unroll 1
    for (int c = 0; c < NC; ++c) {
        const int cur = c & 1;
        if (comp) {
            const LAS float* B = L + cur * STG + 8 * cg; const LAS float* V = L + cur * STG + 5 * TC * 64 + row; const LAS float* K2 = BRK + cur * TC * 2; LAS float* Yb = Y + cur * TC * YSTEP + (row >> 1) * YRP + 2 * cg;
            const int ns = (T - c * TC) < TC ? (T - c * TC) : TC;
            if (ns == TC) {
                StepOps o0, o1; step_load(o0, B, V, K2);
#pragma unroll
                for (int t = 0; t < TC; t += 2) {
                    step_load(o1, B + (t + 1) * 64, V + (t + 1) * 64, K2 + (t + 1) * 2);
                    step_math(o0, S, Yb + t * YSTEP);
                    if (t + 2 < TC) step_load(o0, B + (t + 2) * 64, V + (t + 2) * 64, K2 + (t + 2) * 2);
                    step_math(o1, S, Yb + (t + 1) * YSTEP);
                }
            } else {
#pragma unroll 1
                for (int t = 0; t < ns; ++t) { StepOps o; step_load(o, B + t * 64, V + t * 64, K2 + t * 2); step_math(o, S, Yb + t * YSTEP); }
            }
        } else {
            if (c > 0 && (c - 1) * TC + st < T) post_store(Y + (cur ^ 1) * TC * YSTEP + st * YSTEP, cq, L + (cur ^ 1) * STG + 5 * TC * 64 + st * 64 + 4 * cq, cA, lnw, lnb, yout + (size_t)((c - 1) * TC + st) * DM);
            Carry cN = cB;
            if (c + 1 < NC) { cN.g = R.g; cN.rk = stage_store(R, L + (cur ^ 1) * STG, BRK + (cur ^ 1) * TC * 2, st, cq, P); if (c + 2 < NC) stage_load(R, a, shift_prev, tok0, (c + 2) * TC + st, T, cj); }
            cA = cB; cB = cN;
        }
        __syncthreads();
    }
    if (comp) {
#pragma unroll
        for (int j = 0; j < 2; ++j) { *(f32x4*)(s_out + row * 64 + 8 * cg + 4 * j) = (f32x4){S[4 * j].x, S[4 * j + 1].x, S[4 * j + 2].x, S[4 * j + 3].x};
            *(f32x4*)(s_out + (row + 1) * 64 + 8 * cg + 4 * j) = (f32x4){S[4 * j].y, S[4 * j + 1].y, S[4 * j + 2].y, S[4 * j + 3].y}; }
    } else {
        const int cl = NC - 1; if (cl * TC + st < T) post_store(Y + (cl & 1) * TC * YSTEP + st * YSTEP, cq, L + (cl & 1) * STG + 5 * TC * 64 + st * 64 + 4 * cq, cA, lnw, lnb, yout + (size_t)(cl * TC + st) * DM);
    }
}

__device__ __forceinline__ bf16x8 pack8(const f32x4 x, const f32x4 y) { v4u w; w.x = cvt_pk_bf16(x[0], x[1]); w.y = cvt_pk_bf16(x[2], x[3]); w.z = cvt_pk_bf16(y[0], y[1]); w.w = cvt_pk_bf16(y[2], y[3]); return __builtin_bit_cast(bf16x8, w); }
__device__ __forceinline__ void attn_prompt_unit(const Args& a, int u, int wave, int lane) {
    const int b = u >> 6, h = (u >> 4) & 3, qt = u & 15, fr = lane & 15, g = lane >> 4;
    const bf16* q = (const bf16*)(a.ws + WS_Q); const bf16* kb = (const bf16*)(a.ws + WS_KB); const bf16* vt = (const bf16*)(a.ws + WS_VT); bf16* yc = (bf16*)(a.ws + WS_YA) + 3072;
    const int tok = b * SEQ + qt * 128 + wave * 16 + fr;
    bf16x8 qf[8];
#pragma unroll
    for (int ks = 0; ks < 8; ++ks) qf[ks] = *(const bf16x8*)(q + (size_t)tok * 1024 + h * 256 + 32 * ks + 8 * g);
    f32x4 st[16];
#pragma unroll
    for (int T = 0; T < 16; ++T) { st[T] = (f32x4){0.f, 0.f, 0.f, 0.f}; const bf16* kr = kb + (size_t)(b * 256 + 16 * T + fr) * 1024 + h * 256 + 8 * g;
#pragma unroll
        for (int ks = 0; ks < 8; ++ks) { const bf16x8 kf = *(const bf16x8*)(kr + 32 * ks); st[T] = __builtin_amdgcn_mfma_f32_16x16x32_bf16(kf, qf[ks], st[T], 0, 0, 0); } }
    float mx = -3.0e38f;
#pragma unroll
    for (int T = 0; T < 16; ++T) mx = fmaxf(fmaxf(fmaxf(st[T][0], st[T][1]), fmaxf(st[T][2], st[T][3])), mx);
    mx = fmaxf(mx, __shfl_xor(mx, 16)); mx = fmaxf(mx, __shfl_xor(mx, 32));
    float sum = 0.f;
#pragma unroll
    for (int T = 0; T < 16; ++T)
#pragma unroll
        for (int r = 0; r < 4; ++r) { const float p = __builtin_amdgcn_exp2f(st[T][r] - mx); st[T][r] = p; sum += p; }
    sum += __shfl_xor(sum, 16); sum += __shfl_xor(sum, 32);
    const float inv = 1.0f / sum;
    bf16x8 pf[8];
#pragma unroll
    for (int ks = 0; ks < 8; ++ks) pf[ks] = pack8(st[2 * ks], st[2 * ks + 1]);
#pragma unroll
    for (int dt = 0; dt < 16; ++dt) { f32x4 o = {0.f, 0.f, 0.f, 0.f}; const bf16* vr = vt + ((size_t)(b * 4 + h) * 256 + 16 * dt + fr) * 256 + 8 * g;
#pragma unroll
        for (int ks = 0; ks < 8; ++ks) { const bf16x8 vf = *(const bf16x8*)(vr + 32 * ks); o = __builtin_amdgcn_mfma_f32_16x16x32_bf16(vf, pf[ks], o, 0, 0, 0); }
        o = o * inv; v2u w; w.x = cvt_pk_bf16(o[0], o[1]); w.y = cvt_pk_bf16(o[2], o[3]);
        *(v2u*)(yc + (size_t)tok * DM + h * 256 + 16 * dt + 4 * g) = w; }
}
__device__ __forceinline__ void attn_sample_unit(const Ctx& C, const Args& a, int u) {
    const int db = u >> 2, h = u & 3, lane = C.lane, wave = C.wave, fr = lane & 15, g = lane >> 4;
    LAS float* sc = (LAS float*)C.lds; LAS float* red = sc + 1024; LAS float* sinv = red + 8192;
    const float* ck = a.in[I_CK] + (size_t)db * 256 * 1024 + h * 256; const float* cv = a.in[I_CV] + (size_t)db * 256 * 1024 + h * 256;
    const bf16* q = (const bf16*)(a.ws + WS_Q) + (size_t)(NTP + db * 4) * 1024 + h * 256; bf16* yc = (bf16*)(a.ws + WS_YA) + 3072 + (size_t)(NTP + db * 4) * DM + h * 256;
    bf16x8 qf[8];
#pragma unroll
    for (int ks = 0; ks < 8; ++ks) { const v4u z = {0u, 0u, 0u, 0u}; qf[ks] = __builtin_bit_cast(bf16x8, z); if (fr < 4) qf[ks] = *(const bf16x8*)(q + (size_t)fr * 1024 + 32 * ks + 8 * g); }
#pragma unroll
    for (int T2 = 0; T2 < 2; ++T2) { const int key = 32 * wave + 16 * T2 + fr; f32x4 s = {0.f, 0.f, 0.f, 0.f}; const float* kp = ck + (size_t)key * 1024 + 8 * g;
#pragma unroll
        for (int ks = 0; ks < 8; ++ks) { const f32x4 k0 = *(const f32x4*)(kp + 32 * ks), k1 = *(const f32x4*)(kp + 32 * ks + 4); s = __builtin_amdgcn_mfma_f32_16x16x32_bf16(pack8(k0, k1), qf[ks], s, 0, 0, 0); }
        if (fr < 4) *(LAS f32x4*)(sc + fr * 256 + 32 * wave + 16 * T2 + 4 * g) = s; }
    __syncthreads();
    if (wave < 4) { f32x4 v = *(LAS f32x4*)(sc + wave * 256 + 4 * lane); float mx = fmaxf(fmaxf(v[0], v[1]), fmaxf(v[2], v[3]));
#pragma unroll
        for (int o = 1; o < 64; o <<= 1) mx = fmaxf(mx, __shfl_xor(mx, o));
        float s = 0.f;
#pragma unroll
        for (int e = 0; e < 4; ++e) { v[e] = __builtin_amdgcn_exp2f(v[e] - mx); s += v[e]; }
        s = wave_sum(s); *(LAS f32x4*)(sc + wave * 256 + 4 * lane) = v; if (lane == 0) sinv[wave] = 1.0f / s; }
    __syncthreads();
    f32x4 o[4];
#pragma unroll
    for (int t = 0; t < 4; ++t) o[t] = (f32x4){0.f, 0.f, 0.f, 0.f};
#pragma unroll 2
    for (int kk = 0; kk < 32; kk += 4) { f32x4 p[4];
#pragma unroll
        for (int t = 0; t < 4; ++t) p[t] = *(LAS f32x4*)(sc + t * 256 + 32 * wave + kk);
#pragma unroll
        for (int e = 0; e < 4; ++e) { const f32x4 v = *(const f32x4*)(cv + (size_t)(32 * wave + kk + e) * 1024 + 4 * lane);
#pragma unroll
            for (int t = 0; t < 4; ++t) o[t] += v * p[t][e]; } }
#pragma unroll
    for (int t = 0; t < 4; ++t) *(LAS f32x4*)(red + (wave * 4 + t) * 256 + 4 * lane) = o[t];
    __syncthreads();
    { const int t = C.tid >> 7, d = (C.tid & 127) * 2; f32x2 s = {0.f, 0.f};
#pragma unroll
        for (int w = 0; w < 8; ++w) s += *(LAS f32x2*)(red + (w * 4 + t) * 256 + d);
        s = s * sinv[t]; *(unsigned*)(yc + (size_t)t * DM + d) = cvt_pk_bf16(s.x, s.y); }
    __syncthreads();
}

template <class E> __device__ __forceinline__ void tail_combine(const Ctx& C, const E& e, const float* slab, int M, int N, int bx) {
    pg8::StaticOrder so; so.init(M, N, C.G, 0); const int R = so.nwg / C.G, rem = so.nwg - R * C.G; if (rem == 0) return; const int split = C.G / rem;
    const int l = bx / split, q = bx % split; if (l >= rem || q >= 8) return;
    pg8::Unit u; pg8::TailSplitOrder::leftover(N, R, l, u);
    const int ai = q >> 2, m = q & 3, w = C.wave, wr = w >> 2, wc = w & 3, fr = C.lane & 15, fq = C.lane >> 4;
    epi::A4 v[2][2];
#pragma unroll
    for (int bj = 0; bj < 2; ++bj)
#pragma unroll
        for (int n = 0; n < 2; ++n) v[bj][n] = (epi::A4){0.f, 0.f, 0.f, 0.f};
#pragma unroll
    for (int part = 0; part < 8; ++part) { if (part >= split) break; const unsigned* p = (const unsigned*)slab + ((size_t)((l * split + part) * 8 + w) * 16 * 64 + C.lane) * 4;
#pragma unroll
        for (int bj = 0; bj < 2; ++bj) { const v4u x = *(const v4u*)(p + (size_t)(ai * 8 + bj * 4 + m) * 256);
            v[bj][0] += (epi::A4){bf_lo(x.x), bf_hi(x.x), bf_lo(x.y), bf_hi(x.y)}; v[bj][1] += (epi::A4){bf_lo(x.z), bf_hi(x.z), bf_lo(x.w), bf_hi(x.w)}; } }
    e.row_op(v, u.pm * 256 + ai * 128 + wr * 64 + m * 16 + fr, u.pn, wc, fq);
}

__device__ __forceinline__ void rstd_phase(const Ctx& C, const float* slots, float* rstd) {
    const int sub = C.lane >> 4, q = C.lane & 15;
    for (int m = C.gw * 4 + sub; m < MTOK; m += C.NGW * 4) {
        const f32x4 v = *(const f32x4*)(slots + (size_t)m * 64 + 4 * q);
        const float s = row16_sum(sum4(v));
        if (q == 0) rstd[m] = 1.0f / sqrtf(s * (1.0f / DM) + EPS);
    }
}
__device__ __forceinline__ void local_rstd(const Ctx& C, const float* slots, LAS float* loc, int pm) {
    const int sub = C.lane >> 4, q = C.lane & 15;
#pragma unroll 4
    for (int i = C.wave * 4 + sub; i < 768; i += NWAVES * 4) {
        const int row = i < 256 ? pm * 256 + i : NTP + (i - 256);
        const f32x4 v = *(const f32x4*)(slots + (size_t)row * 64 + 4 * q);
        const float s = row16_sum(sum4(v));
        if (q == 0) loc[i] = 1.0f / sqrtf(s * (1.0f / DM) + EPS);
    }
    __syncthreads();
}
__device__ __forceinline__ void lds_rstd_copy(const Ctx& C, const float* rstd, LAS float* rl, int pm) {
    for (int i = C.tid; i < 768; i += NWAVES * 64) rl[i] = rstd[i < 256 ? pm * 256 + i : NTP + (i - 256)];
    __syncthreads();
}

#ifndef MK_ONE_LAUNCH
#define MK_ONE_LAUNCH 1
#endif
constexpr int NPHASE = 16;
constexpr int CW_SKF = 32768;
constexpr int CW_BAR = 4096;

__global__ void __launch_bounds__(NWAVES * 64, 2) mk_fwd(Args args) {
    extern __shared__ __attribute__((aligned(16))) unsigned char lds_raw[];
    Ctx C; C.lds = (LAS unsigned char*)lds_raw; C.tid = threadIdx.x; C.lane = C.tid & 63; C.wave = __builtin_amdgcn_readfirstlane(C.tid >> 6);
    C.G = gridDim.x; { const int bx = blockIdx.x; C.vcu = (C.G % 8 == 0) ? (bx % 8) * (C.G / 8) + bx / 8 : bx; }
    C.gw = C.vcu * NWAVES + C.wave; C.NGW = C.G * NWAVES;
    const Args& a = args; unsigned char* ws = a.ws;
    volatile LAS unsigned* MISC = (volatile LAS unsigned*)(C.lds + MISC_OFF);
    for (int u = C.tid; u < (LDS_BYTES - LDSCTL_OFF) / 4; u += NWAVES * 64) ((LAS unsigned*)(C.lds + LDSCTL_OFF))[u] = 0u;
    __syncthreads();
#if MK_ONE_LAUNCH
    XcdBarrier bar = xcd_barrier_post((unsigned*)(ws + WS_CTL) + CW_BAR + a.li * XCD_BAR_WORDS, MISC + 8);
#define GRID_BAR() xcd_barrier(bar)
#else
#define GRID_BAR() do { } while (0)
#endif
    const int lo = a.ph_lo, hi = a.ph_hi;
#ifndef PH_MASK
#define PH_MASK 0xFFFF
#endif
#define IN(k) ((((PH_MASK) >> (k)) & 1) && lo <= (k) && (k) < hi)
#define SEAM(k) do { if (IN(k) && IN((k) + 1)) GRID_BAR(); } while (0)
    LAS unsigned char* ring = C.lds + RING_OFF;
    const int bx = blockIdx.x;

    if (IN(0)) { p0_prologue(C, a); } SEAM(0);

    if (IN(1)) {
        { pg8::Gemm g{(const bf16*)(ws + WS_XB), (const bf16*)(ws + WS_W1A), MTOK, 2 * DFF, DM, DM, DM}; pg8::XcdOrder S; S.init(2 * DFF, bx);
          LAS float* rl = (LAS float*)(C.lds + RING_BYTES); lds_rstd_copy(C, (const float*)(ws + WS_RSTD0), rl, (bx & 7) + 8 * ((bx >> 3) & 3));
          epi::SwiGLUL E{(bf16*)(ws + WS_ACT), nullptr, rl};
          pg8::gemm_phase<epi::SwiGLUL, pg8::XcdOrder, PG8_ALIGN, PG8_SP2>(ring, g, S, E); }
        { const int c0 = 112; const int gsub = C.G - c0;
          if (bx >= c0) { pg8::Gemm g{(const bf16*)(ws + WS_MEMB), (const bf16*)(ws + WS_WMEM), 1024, 2048, DM, DM, DM}; pg8::StaticOrder S; S.init(1024, 2048, gsub, bx - c0);
            epi::MemKV E{a.out + O_MK, a.out + O_MV, (bf16*)(ws + WS_KB), (bf16*)(ws + WS_VT), (const float*)(ws + WS_RSTDM)};
            pg8::gemm_phase<epi::MemKV, pg8::StaticOrder, PG8_ALIGN, PG8_SP2>(ring, g, S, E); }
          { const int c1 = c0 + 32; if (bx >= c1) { __syncthreads(); Ctx C2 = C; C2.gw = (bx - c1) * NWAVES + C.wave; C2.NGW = (C.G - c1) * NWAVES; int base = 0;
              cvt_matrix<0>(C2, a.in[I_WF1O], DFF, DM, nullptr, (bf16*)(ws + WS_W1B), base); } } }
    } SEAM(1);

    if (IN(2)) {
        pg8::Gemm g{(const bf16*)(ws + WS_ACT), (const bf16*)(ws + WS_W1B), MTOK, DM, DFF, DFF, DFF}; pg8::TailSplitOrder S; S.init(MTOK, DM, g.K, C.G, bx, (float*)(ws + WS_SLAB));
        epi::Resid<true, false> E{a.out + O_Y, a.out + O_Y, a.out + O_Y, (bf16*)(ws + WS_XB), (float*)(ws + WS_SLOT), 0.5f};
        pg8::gemm_phase<epi::Resid<true, false>, pg8::TailSplitOrder, PG8_ALIGN, PG8_SP2>(ring, g, S, E);
        GRID_BAR(); tail_combine(C, E, (const float*)(ws + WS_SLAB), MTOK, DM, bx);
        __syncthreads(); win_weights(C, a);
    } SEAM(2);

    if (IN(3)) { rstd_phase(C, (const float*)(ws + WS_SLOT), (float*)(ws + WS_RSTD1)); } SEAM(3);

    if (IN(4)) {
        pg8::Gemm g{(const bf16*)(ws + WS_XB), (const bf16*)(ws + WS_WIN), MTOK, NWIN, DM, DM, DM}; pg8::XcdOrder S; S.init(NWIN, bx);
        LAS float* rl = (LAS float*)(C.lds + RING_BYTES); lds_rstd_copy(C, (const float*)(ws + WS_RSTD1), rl, (bx & 7) + 8 * ((bx >> 3) & 3));
        epi::Win E{(bf16*)(ws + WS_PAF), (bf16*)(ws + WS_PB), (bf16*)(ws + WS_Q), (unsigned char*)(ws + WS_GATE), rl, a.out + O_SHP, a.out + O_SHS};
        pg8::gemm_phase<epi::Win, pg8::XcdOrder, PG8_ALIGN, PG8_SP2>(ring, g, S, E);
    } SEAM(4);

    if (IN(5)) { r1_phase(C, a); } SEAM(5);

    if (IN(6)) {
        { pg8::Gemm g{(const bf16*)(ws + WS_LIN), (const bf16*)(ws + WS_WLWA), MTOK, 4096, 256, 512, 256}; pg8::XcdOrder S; S.init(4096, bx);
          epi::LoraWA E{(bf16*)(ws + WS_WDEC), (bf16*)(ws + WS_AVAL), a.in[I_W0], a.in[I_A0]};
          pg8::gemm_phase<epi::LoraWA, pg8::XcdOrder, PG8_ALIGN, PG8_SP2>(ring, g, S, E); }
        { pg8::Gemm g{(const bf16*)(ws + WS_LIN) + 256, (const bf16*)(ws + WS_WLG), MTOK, 2048, 256, 512, 256}; pg8::XcdOrder S; S.init(2048, bx);
          epi::LoraG E{(bf16*)(ws + WS_G)};
          pg8::gemm_phase<epi::LoraG, pg8::XcdOrder, PG8_ALIGN, PG8_SP2>(ring, g, S, E); }
        { const int j = bx >> 3; if (j >= 4) conv_phase(a, ((bx & 7) * 28 + (j - 4)) * NWAVES + C.wave, 224 * NWAVES, C.lane); }
    } SEAM(6);


    if (IN(8)) {
        const int nscan = (C.G > 128) ? 128 : C.G / 2, nother = C.G - nscan;
#ifdef MK_P8_PROBE
        const int p8m = (a.li == 1) ? MK_P8_PROBE : 0;
#else
        const int p8m = 0;
#endif
        if (bx < nscan) {
            if (p8m != 2) for (int u = bx; u < 128; u += nscan) { const int b = u >> 5, h = u & 31; scan_unit(C, a, b * SEQ, SEQ, nullptr, nullptr, a.out + O_RWP + (size_t)u * 4096, h); }
        } else {
            const int r = bx - nscan;
            if (p8m != 1) {
            for (int u = r; u < NDB * HA; u += nother) { const int db = u >> 5, h = u & 31;
                scan_unit(C, a, NTP + db * DSEQ, DSEQ, a.in[I_SSH] + (size_t)db * PA, a.in[I_SRW] + (size_t)u * 4096, a.out + O_RWS + (size_t)u * 4096, h); }
            for (int u = r; u < 256; u += nother) attn_prompt_unit(a, u, C.wave, C.lane);
            for (int u = r; u < 512; u += nother) attn_sample_unit(C, a, u);
            { __syncthreads(); Ctx C2 = C; C2.gw = r * NWAVES + C.wave; C2.NGW = nother * NWAVES; late_weights(C2, a); }
            }
        }
    } SEAM(8);


    if (IN(10)) {
        pg8::Gemm g{(const bf16*)(ws + WS_YA), (const bf16*)(ws + WS_WBRA), MTOK, DM, DM, DM, DM}; pg8::TailSplitOrder S; S.init(MTOK, DM, g.K, C.G, bx, (float*)(ws + WS_SLAB));
        epi::GateCat E{(const unsigned char*)(ws + WS_GATE), (bf16*)(ws + WS_MRG)};
        pg8::gemm_phase<epi::GateCat, pg8::TailSplitOrder, PG8_ALIGN, PG8_SP2>(ring, g, S, E);
        GRID_BAR(); tail_combine(C, E, (const float*)(ws + WS_SLAB), MTOK, DM, bx);
    } SEAM(10);

    if (IN(11)) {
        pg8::Gemm g{(const bf16*)(ws + WS_MRG), (const bf16*)(ws + WS_WOUT), MTOK, DM, DM, DM, DM}; pg8::TailSplitOrder S; S.init(MTOK, DM, g.K, C.G, bx, (float*)(ws + WS_SLAB));
        epi::Resid<true, false> E{a.out + O_Y, a.out + O_Y, a.out + O_Y, (bf16*)(ws + WS_XB), (float*)(ws + WS_SLOT), 1.0f};
        pg8::gemm_phase<epi::Resid<true, false>, pg8::TailSplitOrder, PG8_ALIGN, PG8_SP2>(ring, g, S, E);
        GRID_BAR(); tail_combine(C, E, (const float*)(ws + WS_SLAB), MTOK, DM, bx);
    } SEAM(11);


    if (IN(13)) {
        pg8::Gemm g{(const bf16*)(ws + WS_XB), (const bf16*)(ws + WS_W2A), MTOK, 2 * DFF, DM, DM, DM}; pg8::XcdOrder S; S.init(2 * DFF, bx);
        LAS float* rl = (LAS float*)(C.lds + RING_BYTES);
        local_rstd(C, (const float*)(ws + WS_SLOT), rl, (bx & 7) + 8 * ((bx >> 3) & 3));
        epi::SwiGLUL E{(bf16*)(ws + WS_ACT), nullptr, rl};
        pg8::gemm_phase<epi::SwiGLUL, pg8::XcdOrder, PG8_ALIGN, PG8_SP2>(ring, g, S, E);
        { const int c1 = 112;
          if (bx >= c1) { __syncthreads(); Ctx C2 = C; C2.gw = (bx - c1) * NWAVES + C.wave; C2.NGW = (C.G - c1) * NWAVES; int base = 0; cvt_matrix<0>(C2, a.in[I_WF2O], DFF, DM, nullptr, (bf16*)(ws + WS_W2B), base); } }
    } SEAM(13);

    if (IN(14)) {
        pg8::Gemm g{(const bf16*)(ws + WS_ACT), (const bf16*)(ws + WS_W2B), MTOK, DM, DFF, DFF, DFF}; pg8::TailSplitOrder S; S.init(MTOK, DM, g.K, C.G, bx, (float*)(ws + WS_SLAB));
        epi::Resid<true, false> E{a.out + O_Y, a.out + O_Y, a.out + O_Y, (bf16*)(ws + WS_XB), (float*)(ws + WS_SLOT), 0.5f};
        pg8::gemm_phase<epi::Resid<true, false>, pg8::TailSplitOrder, PG8_ALIGN, PG8_SP2>(ring, g, S, E);
        GRID_BAR(); tail_combine(C, E, (const float*)(ws + WS_SLAB), MTOK, DM, bx);
        final_norm(C, a, 0, NTP);
    } SEAM(14);

    if (IN(15)) { final_norm(C, a, NTP, MTOK); }
#undef IN
#undef SEAM
}

extern "C" void kernel_launch(void* const* d_in, const int* in_sizes, int n_in, void* d_out, int out_size, void* d_ws, size_t ws_size, hipStream_t stream) {
    static int grid = 0;
    if (grid == 0) {
        if (n_in != 35 || (size_t)out_size != O_END || ws_size < WS_END) { fprintf(stderr, "kernel_launch: unexpected problem: n_in %d out_size %d ws_size %zu (need %zu)\n", n_in, out_size, ws_size, (size_t)WS_END); grid = -1; return; }
        int dev = 0, cus = 0;
        if (hipGetDevice(&dev) != hipSuccess || hipDeviceGetAttribute(&cus, hipDeviceAttributeMultiprocessorCount, dev) != hipSuccess) { grid = -1; return; }
        if (hipFuncSetAttribute((const void*)mk_fwd, hipFuncAttributeMaxDynamicSharedMemorySize, LDS_BYTES) != hipSuccess) { fprintf(stderr, "kernel_launch: hipFuncSetAttribute failed\n"); grid = -1; return; }
        int per_cu = 0;
        if (hipOccupancyMaxActiveBlocksPerMultiprocessor(&per_cu, (const void*)mk_fwd, NWAVES * 64, LDS_BYTES) != hipSuccess || per_cu < 1) fprintf(stderr, "kernel_launch: occupancy query says %d\n", per_cu);
        (void)hipGetLastError();
        if (cus != 256) { fprintf(stderr, "kernel_launch: built for a 256-CU device (unit orders and tail splits), found %d CUs\n", cus); grid = -1; return; }
        grid = cus;
    }
    if (grid < 0) return;
    (void)hipMemsetAsync((char*)d_ws + WS_CTL, 0, CTL_BYTES, stream);
    Args a{};
    for (int i = 0; i < 35; ++i) a.in[i] = (const float*)d_in[i];
    a.out = (float*)d_out; a.ws = (unsigned char*)d_ws;
#if MK_ONE_LAUNCH
#ifdef MK_DUP_PHASE
    a.ph_lo = 0; a.ph_hi = MK_DUP_PHASE + 1; a.li = 0; hipLaunchKernelGGL(mk_fwd, dim3(grid), dim3(NWAVES * 64), LDS_BYTES, stream, a);
    a.ph_lo = MK_DUP_PHASE; a.ph_hi = MK_DUP_PHASE + 1; a.li = 1; hipLaunchKernelGGL(mk_fwd, dim3(grid), dim3(NWAVES * 64), LDS_BYTES, stream, a);
    if (MK_DUP_PHASE + 1 < NPHASE) { a.ph_lo = MK_DUP_PHASE + 1; a.ph_hi = NPHASE; a.li = 2; hipLaunchKernelGGL(mk_fwd, dim3(grid), dim3(NWAVES * 64), LDS_BYTES, stream, a); }
#else
    a.ph_lo = 0; a.ph_hi = NPHASE; a.li = 0;
    hipLaunchKernelGGL(mk_fwd, dim3(grid), dim3(NWAVES * 64), LDS_BYTES, stream, a);
#endif
#else
#ifndef MK_LAST_PHASE
#define MK_LAST_PHASE (NPHASE - 1)
#endif
    for (int p = 0; p <= MK_LAST_PHASE; ++p) { a.ph_lo = p; a.ph_hi = p + 1; hipLaunchKernelGGL(mk_fwd, dim3(grid), dim3(NWAVES * 64), LDS_BYTES, stream, a); }
#endif
}
```
